# Optimizing an MI355X kernel written in HIP

```python
import jax, jax.numpy as jnp
from jax import lax
import numpy as np

D_MODEL = 4096
BATCH = 1
SEQ = 8192
DEPTH = 2

N_HEADS = 32
N_KV_HEADS = 8
HEAD_DIM = 128
Q_GROUP = N_HEADS // N_KV_HEADS
ATTN_WIDTH = N_HEADS * HEAD_DIM
KV_WIDTH = N_KV_HEADS * HEAD_DIM
AXIS_ROT_DIM = HEAD_DIM // 2
ROPE_THETA = 10000.0
Q_BLOCK = 128
GRID_W = 64

POOL_WINDOWS = (2, 4, 8, 16)
N_POOL_GROUPS = 4
POOL_WIDTH = 2048
POOL_GROUP_IN = POOL_WIDTH // N_POOL_GROUPS
POOL_GROUP_OUT = D_MODEL // N_POOL_GROUPS

IN_WIDTH = ATTN_WIDTH + 2 * KV_WIDTH + POOL_WIDTH + 2 * D_MODEL

D_FF = -(-8 * D_MODEL // (3 * 256)) * 256

D_PLE = 256

EPS = 1e-6

kernel_name = "hybrid_gqa_axialrope_multipool_swiglu_ple"


def rms_norm(x, g):
    xf = x.astype(jnp.float32)
    y = xf * lax.rsqrt(jnp.mean(xf * xf, axis=-1, keepdims=True) + EPS)
    return (y * g.astype(jnp.float32)).astype(x.dtype)


def axial_rope_tables(seq):
    rows = seq // GRID_W
    row = jnp.broadcast_to(jnp.arange(rows)[:, None], (rows, GRID_W)).reshape(seq)
    col = jnp.broadcast_to(jnp.arange(GRID_W)[None, :], (rows, GRID_W)).reshape(seq)
    inv_freq = ROPE_THETA ** (-jnp.arange(0, AXIS_ROT_DIM, 2, dtype=jnp.float32) / AXIS_ROT_DIM)
    pos = jnp.stack([row, col], axis=-1).astype(jnp.float32)
    ang = pos[:, :, None] * inv_freq[None, None, :]
    return jnp.cos(ang), jnp.sin(ang)


def apply_axial_rope(x, cos, sin):
    b, s, h, d = x.shape
    xf = x.astype(jnp.float32).reshape(b, s, h, 2, 2, AXIS_ROT_DIM // 2)
    x1, x2 = xf[..., 0, :], xf[..., 1, :]
    c, sn = cos[None, :, None], sin[None, :, None]
    out = jnp.stack([x1 * c - x2 * sn, x2 * c + x1 * sn], axis=-2)
    return out.reshape(b, s, h, d).astype(x.dtype)


def block_attention(q, k, v):
    b, s = q.shape[:2]
    nb = s // Q_BLOCK
    qb = q.reshape(b, nb, Q_BLOCK, N_KV_HEADS, Q_GROUP, HEAD_DIM).transpose(1, 0, 2, 3, 4, 5)
    scale = HEAD_DIM ** -0.5

    def one_block(qblk):
        sc = jnp.einsum('bqkgd,bskd->bkgqs', qblk, k,
                        preferred_element_type=jnp.float32) * scale
        pr = jax.nn.softmax(sc, axis=-1).astype(v.dtype)
        return jnp.einsum('bkgqs,bskd->bqkgd', pr, v)

    out = lax.map(one_block, qb)
    return out.transpose(1, 0, 2, 3, 4, 5).reshape(b, s, ATTN_WIDTH)


def multiscale_pool(u, w_pool, pool_scale):
    b, s, _ = u.shape
    ug = u.astype(jnp.float32).reshape(b, s, N_POOL_GROUPS, POOL_GROUP_IN)
    csum = jnp.concatenate([jnp.zeros((b, 1, N_POOL_GROUPS, POOL_GROUP_IN), jnp.float32),
                            jnp.cumsum(ug, axis=1)], axis=1)
    t = jnp.arange(s)[:, None]
    half = jnp.array(POOL_WINDOWS, dtype=jnp.int32)[None, :] // 2
    lo = jnp.clip(t - half, 0, s)
    hi = jnp.clip(t + half, 0, s)
    grp = jnp.arange(N_POOL_GROUPS)[None, :]
    window_sum = csum[:, hi, grp, :] - csum[:, lo, grp, :]
    count = (hi - lo).astype(jnp.float32)[None, :, :, None]
    delta = (window_sum / count - ug).astype(u.dtype)
    y = jnp.einsum('bsgc,gcd->bsgd', delta, w_pool).reshape(b, s, D_MODEL)
    return y * pool_scale


def hybrid_layer(x, p_i, w_in, q_norm, k_norm, w_pool, pool_scale, w_out,
                 norm_mix_pre, norm_mix_post, norm_ffn_pre, norm_ffn_post,
                 w_ffn_gate, w_ffn_up, w_ffn_down, w_ple_in, w_ple_gate, norm_ple, cos, sin):
    b, s, _ = x.shape
    h = rms_norm(x, norm_mix_pre)
    z = h @ w_in
    o1 = ATTN_WIDTH
    o2 = o1 + KV_WIDTH
    o3 = o2 + KV_WIDTH
    o4 = o3 + POOL_WIDTH
    o5 = o4 + D_MODEL
    q = z[..., :o1].reshape(b, s, N_HEADS, HEAD_DIM)
    k = z[..., o1:o2].reshape(b, s, N_KV_HEADS, HEAD_DIM)
    v = z[..., o2:o3].reshape(b, s, N_KV_HEADS, HEAD_DIM)
    u = z[..., o3:o4]
    gate_attn = jax.nn.sigmoid(z[..., o4:o5])
    gate_pool = jax.nn.sigmoid(z[..., o5:])

    q = apply_axial_rope(rms_norm(q, q_norm), cos, sin)
    k = apply_axial_rope(rms_norm(k, k_norm), cos, sin)
    attn = block_attention(q, k, v)
    pool = multiscale_pool(u, w_pool, pool_scale)

    merged = gate_attn * attn + gate_pool * pool
    x = x + rms_norm(merged @ w_out, norm_mix_post)

    h = rms_norm(x, norm_ffn_pre)
    f = (jax.nn.silu(h @ w_ffn_gate) * (h @ w_ffn_up)) @ w_ffn_down
    x = x + rms_norm(f, norm_ffn_post)

    e = p_i @ w_ple_in
    g = jax.nn.sigmoid(x @ w_ple_gate)
    x = x + rms_norm(g * e, norm_ple)
    return x


def setup_inputs(seed: int = 0) -> dict:
    key = jax.random.key(seed)
    ks = jax.random.split(key, 20)
    f32 = jnp.float32

    def w(k, shape, fan_in):
        return jax.random.normal(k, shape, f32) * (fan_in ** -0.5)

    def gain(k, shape):
        return 1.0 + 0.1 * jax.random.normal(k, shape, f32)

    return {
        "x": jax.random.normal(ks[0], (BATCH, SEQ, D_MODEL), f32),
        "p": jax.random.normal(ks[1], (DEPTH, BATCH, SEQ, D_PLE), f32),
        "w_in": w(ks[2], (DEPTH, D_MODEL, IN_WIDTH), D_MODEL),
        "q_norm": gain(ks[3], (DEPTH, HEAD_DIM)),
        "k_norm": gain(ks[4], (DEPTH, HEAD_DIM)),
        "w_pool": w(ks[5], (DEPTH, N_POOL_GROUPS, POOL_GROUP_IN, POOL_GROUP_OUT), POOL_GROUP_IN),
        "pool_scale": gain(ks[6], (DEPTH, D_MODEL)),
        "w_out": w(ks[7], (DEPTH, D_MODEL, D_MODEL), D_MODEL),
        "norm_mix_pre": gain(ks[8], (DEPTH, D_MODEL)),
        "norm_mix_post": gain(ks[9], (DEPTH, D_MODEL)),
        "norm_ffn_pre": gain(ks[10], (DEPTH, D_MODEL)),
        "norm_ffn_post": gain(ks[11], (DEPTH, D_MODEL)),
        "w_ffn_gate": w(ks[12], (DEPTH, D_MODEL, D_FF), D_MODEL),
        "w_ffn_up": w(ks[13], (DEPTH, D_MODEL, D_FF), D_MODEL),
        "w_ffn_down": w(ks[14], (DEPTH, D_FF, D_MODEL), D_FF),
        "w_ple_in": w(ks[15], (DEPTH, D_PLE, D_MODEL), D_PLE),
        "w_ple_gate": w(ks[16], (DEPTH, D_MODEL, D_MODEL), D_MODEL),
        "norm_ple": gain(ks[17], (DEPTH, D_MODEL)),
    }


def reference(x, p, w_in, q_norm, k_norm, w_pool, pool_scale, w_out,
              norm_mix_pre, norm_mix_post, norm_ffn_pre, norm_ffn_post,
              w_ffn_gate, w_ffn_up, w_ffn_down, w_ple_in, w_ple_gate, norm_ple):
    seq = x.shape[1]
    cos, sin = axial_rope_tables(seq)
    h = x
    for i in range(DEPTH):
        h = hybrid_layer(h, p[i], w_in[i], q_norm[i], k_norm[i], w_pool[i], pool_scale[i], w_out[i],
                         norm_mix_pre[i], norm_mix_post[i], norm_ffn_pre[i], norm_ffn_post[i],
                         w_ffn_gate[i], w_ffn_up[i], w_ffn_down[i],
                         w_ple_in[i], w_ple_gate[i], norm_ple[i], cos, sin)
    return h
```

```cpp
#include <hip/hip_runtime.h>
#include <cstdio>
#include <cstdint>

#ifndef MK_N_LAUNCHES
#define MK_N_LAUNCHES 23
#endif

#define LAS __attribute__((address_space(3)))
#define GAS __attribute__((address_space(1)))
typedef unsigned short bf16_t;
typedef short bf16x8 __attribute__((ext_vector_type(8)));
typedef short s16x4 __attribute__((ext_vector_type(4)));
typedef float f32x4 __attribute__((ext_vector_type(4)));
typedef float f32x2 __attribute__((ext_vector_type(2)));
typedef float f32x16 __attribute__((ext_vector_type(16)));
typedef unsigned u32x4 __attribute__((ext_vector_type(4)));
typedef unsigned u32x2 __attribute__((ext_vector_type(2)));

constexpr int S = 8192, DM = 4096, DEPTH = 2;
constexpr int NH = 32, NKV = 8, HD = 128;
constexpr int KVW = NKV * HD;
constexpr int POOLW = 2048, PGI = 512, PGO = 1024;
constexpr int INW = 16384;
constexpr int FF = 11008;
constexpr int DPLE = 256;
constexpr float EPS = 1e-6f;

__device__ __forceinline__ unsigned cvt_pk_bf16(float lo, float hi) { unsigned r; asm volatile("v_cvt_pk_bf16_f32 %0, %1, %2" : "=v"(r) : "v"(lo), "v"(hi)); return r; }
__device__ __forceinline__ float bf_lo(unsigned w) { return __uint_as_float(w << 16); }
__device__ __forceinline__ float bf_hi(unsigned w) { return __uint_as_float(w & 0xffff0000u); }
__device__ __forceinline__ float sigmoid_f(float v) { return __builtin_amdgcn_rcpf(1.0f + __builtin_amdgcn_exp2f(v * -1.4426950408889634f)); }

namespace pg8 {
constexpr int BM = 256, BK = 64, HALF = 128, HTB = HALF * BK * 2  , STAGE_BYTES = 8 * HTB, NXCD = 8, WGM = 8;

__host__ __device__ __forceinline__ int lds_byte(int r, int c) { const int st = (r >> 4) * 2 + (c >> 5), rr = r & 15, cc = c & 31, ob = rr * 64 + cc * 2; return st * 1024 + (ob ^ (((ob >> 9) & 1) << 5)); }
__host__ __device__ __forceinline__ void stage_rc(int b, int& R, int& C) { const int st = b / 1024, sb = b % 1024, swz = sb ^ (((sb >> 9) & 1) << 5); R = (st >> 1) * 16 + swz / 64; C = (st & 1) * 32 + (swz % 64) / 2; }
__host__ __device__ __forceinline__ int perm32(int rho) { const int n = rho >> 4, i = rho & 15; return 8 * (i >> 2) + 4 * n + (i & 3); }

struct Unit { int pm, pn; };
struct Gemm { const bf16_t* A; const bf16_t* Bt; int M, N, K, lda, ldb, agrp; };

struct StaticOrder {
    int nM, nN, nwg, G, c;
    __host__ __device__ void init(int M, int N, int G_, int c_) { nM = M / BM; nN = N / BM; nwg = nM * nN; G = G_; c = c_; }
    __host__ __device__ bool next(int i, Unit& u) const {
        const long L = (long)i * G + c; if (L >= nwg) return false;
        int wgid = (int)L; { const int q = nwg / NXCD, r = nwg % NXCD, xcd = wgid % NXCD, off = wgid / NXCD; wgid = (xcd < r ? xcd * (q + 1) : r * (q + 1) + (xcd - r) * q) + off; }
        const int nig = WGM * nN, gid = wgid / nig, fm = gid * WGM, gsz = (nM - fm) < WGM ? (nM - fm) : WGM;
        u.pm = fm + ((wgid % nig) % gsz); u.pn = (wgid % nig) / gsz; return true;
    }
    __device__ __forceinline__ void a_ready(const Unit&) const {}
    __device__ __forceinline__ void done(const Unit&) const {}
};

__device__ __forceinline__ u32x4 pack8(const f32x4 v0, const f32x4 v1) { u32x4 w; w.x = cvt_pk_bf16(v0[0], v0[1]); w.y = cvt_pk_bf16(v0[2], v0[3]); w.z = cvt_pk_bf16(v1[0], v1[1]); w.w = cvt_pk_bf16(v1[2], v1[3]); return w; }

struct EpiPlain {
    static constexpr bool PERM = true, AFTER_DRAIN = false;
    bf16_t* O; int ldc;
    __device__ __forceinline__ void operator()(const f32x4 (&acc)[2][2][4][2], const Unit& u, int wr, int wc, int fr, int fq) const {
        const int row0 = u.pm * BM + wr * 64 + fr, col0 = u.pn * BM + wc * 32 + 8 * fq;
#pragma unroll
        for (int ai = 0; ai < 2; ++ai)
#pragma unroll
            for (int m = 0; m < 4; ++m) { bf16_t* rowp = O + (size_t)(row0 + ai * HALF + m * 16) * ldc + col0;
#pragma unroll
                for (int bj = 0; bj < 2; ++bj) *(u32x4*)(rowp + bj * HALF) = pack8(acc[ai][bj][m][0], acc[ai][bj][m][1]); }
    }
};
struct EpiZ {
    static constexpr bool PERM = true, AFTER_DRAIN = false;
    bf16_t *Q, *Kb, *Vb, *U, *GA, *GP;
    __device__ __forceinline__ void operator()(const f32x4 (&acc)[2][2][4][2], const Unit& u, int wr, int wc, int fr, int fq) const {
        const int pn = u.pn; bf16_t* base; int ldc, ct; bool sg = false;
        if (pn < 16)      { base = Q;  ldc = DM;    ct = pn; }
        else if (pn < 20) { base = Kb; ldc = KVW;   ct = pn - 16; }
        else if (pn < 24) { base = Vb; ldc = KVW;   ct = pn - 20; }
        else if (pn < 32) { base = U;  ldc = POOLW; ct = pn - 24; }
        else if (pn < 48) { base = GA; ldc = DM;    ct = pn - 32; sg = true; }
        else              { base = GP; ldc = DM;    ct = pn - 48; sg = true; }
        const int row0 = u.pm * BM + wr * 64 + fr, col0 = ct * BM + wc * 32 + 8 * fq;
#pragma unroll
        for (int ai = 0; ai < 2; ++ai)
#pragma unroll
            for (int m = 0; m < 4; ++m) { bf16_t* rowp = base + (size_t)(row0 + ai * HALF + m * 16) * ldc + col0;
#pragma unroll
                for (int bj = 0; bj < 2; ++bj) { f32x4 v0 = acc[ai][bj][m][0], v1 = acc[ai][bj][m][1];
                    if (sg) {
#pragma unroll
                        for (int j = 0; j < 4; ++j) { v0[j] = sigmoid_f(v0[j]); v1[j] = sigmoid_f(v1[j]); } }
                    *(u32x4*)(rowp + bj * HALF) = pack8(v0, v1); } }
    }
};
struct EpiSwiglu {
    static constexpr bool PERM = true, AFTER_DRAIN = false;
    bf16_t* F; int ldc;
    __device__ __forceinline__ void operator()(const f32x4 (&acc)[2][2][4][2], const Unit& u, int wr, int wc, int fr, int fq) const {
        const int row0 = u.pm * BM + wr * 64 + fr, col0 = u.pn * HALF + wc * 32 + 8 * fq;
#pragma unroll
        for (int ai = 0; ai < 2; ++ai)
#pragma unroll
            for (int m = 0; m < 4; ++m) { bf16_t* rowp = F + (size_t)(row0 + ai * HALF + m * 16) * ldc + col0;
                f32x4 v0, v1;
#pragma unroll
                for (int j = 0; j < 4; ++j) { const float g0 = acc[ai][0][m][0][j], g1 = acc[ai][0][m][1][j];
                    v0[j] = g0 * sigmoid_f(g0) * acc[ai][1][m][0][j]; v1[j] = g1 * sigmoid_f(g1) * acc[ai][1][m][1][j]; }
                *(u32x4*)rowp = pack8(v0, v1); }
    }
};
__device__ __forceinline__ void unpack8(const u32x4 w, f32x4& a, f32x4& b) { a[0] = bf_lo(w.x); a[1] = bf_hi(w.x); a[2] = bf_lo(w.y); a[3] = bf_hi(w.y); b[0] = bf_lo(w.z); b[1] = bf_hi(w.z); b[2] = bf_lo(w.w); b[3] = bf_hi(w.w); }
struct EpiPle {
    static constexpr bool PERM = true, AFTER_DRAIN = false;
    bf16_t* Y; const bf16_t* E; int ldc;
    __device__ __forceinline__ void operator()(const f32x4 (&acc)[2][2][4][2], const Unit& u, int wr, int wc, int fr, int fq) const {
        const int row0 = u.pm * BM + wr * 64 + fr, col0 = u.pn * BM + wc * 32 + 8 * fq;
#pragma unroll
        for (int ai = 0; ai < 2; ++ai)
#pragma unroll
            for (int m = 0; m < 4; ++m) { const size_t off = (size_t)(row0 + ai * HALF + m * 16) * ldc + col0;
#pragma unroll
                for (int bj = 0; bj < 2; ++bj) { const u32x4 ew = *(const u32x4*)(E + off + bj * HALF); f32x4 e0, e1; unpack8(ew, e0, e1);
                    f32x4 v0 = acc[ai][bj][m][0], v1 = acc[ai][bj][m][1];
#pragma unroll
                    for (int j = 0; j < 4; ++j) { v0[j] = sigmoid_f(v0[j]) * e0[j]; v1[j] = sigmoid_f(v1[j]) * e1[j]; }
                    *(u32x4*)(Y + off + bj * HALF) = pack8(v0, v1); }
                asm volatile("" ::: "memory"); }
    }
};
struct EpiPool {
    static constexpr bool PERM = true, AFTER_DRAIN = false;
    bf16_t* MG; const bf16_t *O, *GA, *GP; const float* ps; int ldc;
    __device__ __forceinline__ void operator()(const f32x4 (&acc)[2][2][4][2], const Unit& u, int wr, int wc, int fr, int fq) const {
        const int row0 = u.pm * BM + wr * 64 + fr, col0 = u.pn * BM + wc * 32 + 8 * fq;
        f32x4 pv[2][2];
#pragma unroll
        for (int bj = 0; bj < 2; ++bj)
#pragma unroll
            for (int n = 0; n < 2; ++n) pv[bj][n] = *(const f32x4*)(ps + col0 + bj * HALF + 4 * n);
#pragma unroll
        for (int ai = 0; ai < 2; ++ai)
#pragma unroll
            for (int m = 0; m < 4; ++m) { const size_t off = (size_t)(row0 + ai * HALF + m * 16) * ldc + col0;
#pragma unroll
                for (int bj = 0; bj < 2; ++bj) {
                    const u32x4 ow = *(const u32x4*)(O + off + bj * HALF), aw = *(const u32x4*)(GA + off + bj * HALF), pw = *(const u32x4*)(GP + off + bj * HALF);
                    f32x4 o0, o1, a0, a1, p0, p1; unpack8(ow, o0, o1); unpack8(aw, a0, a1); unpack8(pw, p0, p1);
                    const f32x4 v0 = a0 * o0 + p0 * (acc[ai][bj][m][0] * pv[bj][0]), v1 = a1 * o1 + p1 * (acc[ai][bj][m][1] * pv[bj][1]);
                    *(u32x4*)(MG + off + bj * HALF) = pack8(v0, v1); }
                asm volatile("" ::: "memory"); }
    }
};

template <class Epi, class Sched, bool ALIGN_EPI = false, bool SP2 = false>
__device__ __forceinline__ void gemm_phase(LAS unsigned char* lds, const Gemm g, const Sched& S, const Epi& E) {
    int tid_ = threadIdx.x; asm volatile("" : "+v"(tid_));
    const int tid = tid_, wid = __builtin_amdgcn_readfirstlane(tid >> 6), lane = tid & 63, wr = wid >> 2, wc = wid & 3, fr = lane & 15, fq = lane >> 4;
    const int K = g.K, nt = K / BK;
    unsigned voffA[2], voffB[2];
#pragma unroll
    for (int i = 0; i < 2; ++i) { int R, C; stage_rc(tid * 16 + i * 8192, R, C); const int Rb = Epi::PERM ? ((R & ~31) + perm32(R & 31)) : R;
        voffA[i] = (unsigned)(R * g.lda + C) * 2u; voffB[i] = (unsigned)(Rb * g.ldb + C) * 2u; }
    const size_t kstep = (size_t)(BK * 2);
    const size_t hstepA = (size_t)HALF * g.lda * 2, hstepB = (size_t)HALF * g.ldb * 2;
    const size_t tstepA = 2 * hstepA, tstepB = 2 * hstepB;
    const unsigned ldsw = (unsigned)wid * 1024u;
    const int aoff = lds_byte(wr * 64 + fr, fq * 8), boff = lds_byte(wc * 32 + fr, fq * 8);
#define PG8_SA(b, h) (((b) * 2 + (h)) * HTB)
#define PG8_SB(b, h) ((4 + (b) * 2 + (h)) * HTB)
#define PG8_STAGE(bufoff, gbase, voff) do { _Pragma("unroll") for (int _i = 0; _i < 2; ++_i) \
        __builtin_amdgcn_global_load_lds((const unsigned*)((const char*)(gbase) + (voff)[_i]), (LAS unsigned*)(lds + (bufoff) + ldsw + _i * 8192), 16, 0, 0); } while (0)
#define PG8_LDA(dst, b, h) do { _Pragma("unroll") for (int m = 0; m < 4; ++m) _Pragma("unroll") for (int k = 0; k < 2; ++k) dst[m][k] = *(const LAS bf16x8*)(lds + PG8_SA(b, h) + aoff + m * 2048 + k * 1024); } while (0)
#define PG8_LDB(dst, b, h) do { _Pragma("unroll") for (int n = 0; n < 2; ++n) _Pragma("unroll") for (int k = 0; k < 2; ++k) dst[n][k] = *(const LAS bf16x8*)(lds + PG8_SB(b, h) + boff + n * 2048 + k * 1024); } while (0)
#define PG8_MMA(ai, bj, At, Bt) do { __builtin_amdgcn_s_setprio(1); _Pragma("unroll") for (int m = 0; m < 4; ++m) _Pragma("unroll") for (int n = 0; n < 2; ++n) _Pragma("unroll") for (int k = 0; k < 2; ++k) \
        acc[ai][bj][m][n] = __builtin_amdgcn_mfma_f32_16x16x32_bf16(Bt[n][k], At[m][k], acc[ai][bj][m][n], 0, 0, 0); __builtin_amdgcn_s_setprio(0); } while (0)
#define PG8_WAIT_V(n) asm volatile("s_waitcnt vmcnt(" #n ")" ::: "memory")
#define PG8_WAIT_L(n) asm volatile("s_waitcnt lgkmcnt(" #n ")" ::: "memory")
#define PG8_BAR __builtin_amdgcn_s_barrier()
#define PG8_SCHED __builtin_amdgcn_sched_barrier(0)
    Unit cur, nxt; int ui = 0;
    if (!S.next(0, cur)) return;
    f32x4 acc[2][2][4][2];
#pragma unroll
    for (int a = 0; a < 2; ++a)
#pragma unroll
        for (int b = 0; b < 2; ++b)
#pragma unroll
            for (int m = 0; m < 4; ++m)
#pragma unroll
                for (int n = 0; n < 2; ++n) acc[a][b][m][n] = (f32x4){0.f, 0.f, 0.f, 0.f};
    bf16x8 At[4][2], B0[2][2], B1[2][2];
    const char* cA = (const char*)g.A + (size_t)cur.pm * tstepA + (size_t)(cur.pn >> 2) * g.agrp * 2; const char* cB = (const char*)g.Bt + (size_t)cur.pn * tstepB;
    S.a_ready(cur);
    if constexpr (SP2) {
        PG8_STAGE(PG8_SB(0, 0), cB, voffB); PG8_STAGE(PG8_SB(0, 1), cB + hstepB, voffB); PG8_STAGE(PG8_SA(0, 0), cA, voffA); PG8_STAGE(PG8_SA(0, 1), cA + hstepA, voffA);
        if (wr == 1) PG8_BAR;
        PG8_WAIT_V(2); PG8_BAR;
        PG8_STAGE(PG8_SB(1, 0), cB + kstep, voffB); PG8_STAGE(PG8_SA(1, 0), cA + kstep, voffA); PG8_STAGE(PG8_SB(1, 1), cB + hstepB + kstep, voffB);
        PG8_WAIT_V(6); PG8_BAR;
    } else {
        PG8_STAGE(PG8_SB(0, 0), cB, voffB); PG8_STAGE(PG8_SA(0, 0), cA, voffA); PG8_STAGE(PG8_SB(0, 1), cB + hstepB, voffB); PG8_STAGE(PG8_SA(0, 1), cA + hstepA, voffA);
        if (wr == 1) PG8_BAR;
        PG8_WAIT_V(4); PG8_BAR;
        PG8_STAGE(PG8_SB(1, 0), cB + kstep, voffB); PG8_STAGE(PG8_SA(1, 0), cA + kstep, voffA); PG8_STAGE(PG8_SB(1, 1), cB + hstepB + kstep, voffB);
        PG8_WAIT_V(6); PG8_BAR;
    }
    for (;;) {
        const bool has_next = S.next(ui + 1, nxt);
        const char* nA = has_next ? (const char*)g.A + (size_t)nxt.pm * tstepA + (size_t)(nxt.pn >> 2) * g.agrp * 2 : cA; const char* nB = has_next ? (const char*)g.Bt + (size_t)nxt.pn * tstepB : cB;
        for (int t = 0; t < nt; t += 2) {
            const bool last = (t == nt - 2);
            const char* a1 = cA + (size_t)(t + 1) * kstep;
            const char* a2 = last ? nA : cA + (size_t)(t + 2) * kstep; const char* b2 = last ? nB : cB + (size_t)(t + 2) * kstep;
            const char* a3 = a2 + kstep; const char* b3 = b2 + kstep;
            if (last && has_next) S.a_ready(nxt);
            if constexpr (SP2) {
            PG8_LDB(B0, 0, 0); PG8_LDB(B1, 0, 1); PG8_SCHED; PG8_LDA(At, 0, 0); PG8_STAGE(PG8_SA(1, 1), a1 + hstepA, voffA);
            PG8_WAIT_V(8); PG8_WAIT_L(0); PG8_BAR; PG8_MMA(0, 0, At, B0); PG8_MMA(0, 1, At, B1); PG8_BAR; PG8_SCHED;
            PG8_LDA(At, 0, 1); PG8_STAGE(PG8_SB(0, 0), b2, voffB); PG8_STAGE(PG8_SB(0, 1), b2 + hstepB, voffB); PG8_STAGE(PG8_SA(0, 0), a2, voffA);
            PG8_WAIT_V(8); PG8_WAIT_L(0); PG8_BAR; PG8_MMA(1, 0, At, B0); PG8_MMA(1, 1, At, B1); PG8_BAR; PG8_SCHED;
            PG8_LDB(B0, 1, 0); PG8_LDB(B1, 1, 1); PG8_SCHED; PG8_LDA(At, 1, 0); PG8_STAGE(PG8_SA(0, 1), a2 + hstepA, voffA);
            PG8_WAIT_V(8); PG8_WAIT_L(0); PG8_BAR; PG8_MMA(0, 0, At, B0); PG8_MMA(0, 1, At, B1); PG8_BAR; PG8_SCHED;
            PG8_LDA(At, 1, 1); PG8_STAGE(PG8_SB(1, 0), b3, voffB); PG8_STAGE(PG8_SB(1, 1), b3 + hstepB, voffB); PG8_STAGE(PG8_SA(1, 0), a3, voffA);
            PG8_WAIT_V(8); PG8_WAIT_L(0); PG8_BAR; PG8_MMA(1, 0, At, B0); PG8_MMA(1, 1, At, B1); PG8_BAR; PG8_SCHED;
            } else {
            PG8_LDB(B0, 0, 0); PG8_SCHED; PG8_LDA(At, 0, 0); PG8_STAGE(PG8_SA(1, 1), a1 + hstepA, voffA);
            PG8_WAIT_L(8); PG8_BAR; PG8_WAIT_L(0); PG8_MMA(0, 0, At, B0); PG8_BAR; PG8_SCHED;
            PG8_LDB(B1, 0, 1); PG8_STAGE(PG8_SB(0, 0), b2, voffB);
            PG8_BAR; PG8_WAIT_L(0); PG8_MMA(0, 1, At, B1); PG8_BAR;
            PG8_LDA(At, 0, 1); PG8_STAGE(PG8_SA(0, 0), a2, voffA);
            PG8_BAR; PG8_WAIT_L(0); PG8_MMA(1, 0, At, B0); PG8_BAR; PG8_SCHED;
            PG8_STAGE(PG8_SB(0, 1), b2 + hstepB, voffB);
            PG8_WAIT_V(6); PG8_BAR; PG8_MMA(1, 1, At, B1); PG8_BAR;
            PG8_LDB(B0, 1, 0); PG8_SCHED; PG8_LDA(At, 1, 0); PG8_STAGE(PG8_SA(0, 1), a2 + hstepA, voffA);
            PG8_WAIT_L(8); PG8_BAR; PG8_WAIT_L(0); PG8_MMA(0, 0, At, B0); PG8_BAR; PG8_SCHED;
            PG8_LDB(B1, 1, 1); PG8_STAGE(PG8_SB(1, 0), b3, voffB);
            PG8_BAR; PG8_WAIT_L(0); PG8_MMA(0, 1, At, B1); PG8_BAR;
            PG8_LDA(At, 1, 1); PG8_STAGE(PG8_SA(1, 0), a3, voffA);
            PG8_BAR; PG8_WAIT_L(0); PG8_MMA(1, 0, At, B0); PG8_BAR; PG8_SCHED;
            PG8_STAGE(PG8_SB(1, 1), b3 + hstepB, voffB);
            PG8_WAIT_V(6); PG8_BAR; PG8_MMA(1, 1, At, B1); PG8_BAR;
            }
        }
        if constexpr (ALIGN_EPI) { if (wr == 0) PG8_BAR; }
        E(acc, cur, wr, wc, fr, fq); S.done(cur);
        if (!has_next) break;
#pragma unroll
        for (int a = 0; a < 2; ++a)
#pragma unroll
            for (int b = 0; b < 2; ++b)
#pragma unroll
                for (int m = 0; m < 4; ++m)
#pragma unroll
                    for (int n = 0; n < 2; ++n) acc[a][b][m][n] = (f32x4){0.f, 0.f, 0.f, 0.f};
        cur = nxt; cA = nA; cB = nB; ++ui;
        if constexpr (ALIGN_EPI) { if (wr == 1) PG8_BAR; }
    }
    PG8_WAIT_V(0);
    if constexpr (!ALIGN_EPI) { if (wr == 0) PG8_BAR; }
    PG8_BAR;
#undef PG8_SA
#undef PG8_SB
#undef PG8_STAGE
#undef PG8_LDA
#undef PG8_LDB
#undef PG8_MMA
#undef PG8_WAIT_V
#undef PG8_WAIT_L
#undef PG8_BAR
#undef PG8_SCHED
}
}

namespace att {
constexpr int D = 128, NW = 8, QBLK = 32, KVBLK = 64;
constexpr float SCALE = 0.088388347648318440f;
constexpr float THR = 8.f;
constexpr int LDQ = DM, LDK = KVW, LDO = DM;
constexpr int SHM_V = KVBLK * D * 2, SHM_K = KVBLK * D * 2, SHM_ATTN = 2 * SHM_V + 2 * SHM_K + NW * 64 * 4;
#define KSWZ(row, colB) ((row) * 256 + ((colB) ^ (((row) & 7) << 4)))
#define SBAR() __builtin_amdgcn_sched_barrier(0)
__device__ __forceinline__ int crow(int r, int hi) { return (r & 3) + 8 * (r >> 2) + 4 * hi; }
__device__ __forceinline__ unsigned cvtpk(float lo, float hi) { unsigned r; asm volatile("v_cvt_pk_bf16_f32 %0, %1, %2" : "=v"(r) : "v"(lo), "v"(hi)); return r; }

__device__ __forceinline__ void partialSM(f32x16& p0, f32x16& p1, float& m_reg, float& mn, float& alpha) {
  constexpr float C = SCALE * 1.4426950408889634f;
  float pmax = p0[0];
#pragma unroll
  for (int r = 1; r < 16; ++r) pmax = fmaxf(pmax, p0[r]);
#pragma unroll
  for (int r = 0; r < 16; ++r) pmax = fmaxf(pmax, p1[r]);
  { auto rr = __builtin_amdgcn_permlane32_swap(__float_as_uint(pmax), __float_as_uint(pmax), false, false);
    pmax = fmaxf(__uint_as_float(rr[0]), __uint_as_float(rr[1])); }
  if (__builtin_expect(__all(pmax - m_reg <= THR / SCALE), 1)) { mn = m_reg; alpha = 1.f; }
  else { mn = fmaxf(m_reg, pmax); alpha = __builtin_amdgcn_exp2f((m_reg - mn) * C); m_reg = mn; }
  float mnC = -mn * C;
#pragma unroll
  for (int r = 0; r < 16; ++r) p0[r] = fmaf(p0[r], C, mnC);
#pragma unroll
  for (int r = 0; r < 16; ++r) p1[r] = fmaf(p1[r], C, mnC);
#pragma unroll
  for (int r = 0; r < 16; ++r) p0[r] = __builtin_amdgcn_exp2f(p0[r]);
}
__device__ __forceinline__ void finishSM(f32x16& p0, f32x16& p1, float alpha, float& l_reg, bf16x8& pa0, bf16x8& pa1, bf16x8& pa2, bf16x8& pa3) {
#pragma unroll
  for (int r = 0; r < 16; ++r) p1[r] = __builtin_amdgcn_exp2f(p1[r]);
  float ps = 0;
#pragma unroll
  for (int r = 0; r < 16; ++r) ps += p0[r];
#pragma unroll
  for (int r = 0; r < 16; ++r) ps += p1[r];
  { auto rr = __builtin_amdgcn_permlane32_swap(__float_as_uint(ps), __float_as_uint(ps), false, false);
    ps = __uint_as_float(rr[0]) + __uint_as_float(rr[1]); }
  l_reg = l_reg * alpha + ps;
#define PK4(P, BASE, OUT) do { unsigned a0 = cvtpk(P[BASE + 0], P[BASE + 1]), a1 = cvtpk(P[BASE + 2], P[BASE + 3]);   \
    unsigned b0 = cvtpk(P[BASE + 4], P[BASE + 5]), b1 = cvtpk(P[BASE + 6], P[BASE + 7]);                              \
    auto r0 = __builtin_amdgcn_permlane32_swap(a0, b0, false, false); auto r1 = __builtin_amdgcn_permlane32_swap(a1, b1, false, false); \
    u32x4 w = {r0[0], r1[0], r0[1], r1[1]}; OUT = *reinterpret_cast<bf16x8*>(&w); } while (0)
  PK4(p0, 0, pa0); PK4(p0, 8, pa1); PK4(p1, 0, pa2); PK4(p1, 8, pa3);
#undef PK4
}
__device__ __forceinline__ void qkt(f32x16& p0, f32x16& p1, const LAS char* Ks, const bf16x8* qr, int r32, int hi) {
  p0 = f32x16{}; p1 = f32x16{};
#pragma unroll
  for (int d0 = 0; d0 < 8; ++d0) { int cb = (d0 * 16 + hi * 8) * 2;
    bf16x8 b0 = *reinterpret_cast<const LAS bf16x8*>(Ks + KSWZ(r32, cb));
    bf16x8 b1 = *reinterpret_cast<const LAS bf16x8*>(Ks + KSWZ(32 + r32, cb));
    p0 = __builtin_amdgcn_mfma_f32_32x32x16_bf16(b0, qr[d0], p0, 0, 0, 0);
    p1 = __builtin_amdgcn_mfma_f32_32x32x16_bf16(b1, qr[d0], p1, 0, 0, 0); }
}
__device__ __forceinline__ int v_st(int k, int c) { const int kk = (k & ~0xC) | ((k & 4) << 1) | ((k & 8) >> 1); return ((kk >> 3) * 4 + (c >> 5)) * 512 + ((kk & 7) * 32 + (c & 31)) * 2; }
__device__ __forceinline__ int v_rd_base(int lane) { return ((lane & 3) << 3) | (((lane >> 2) & 3) << 6) | (((lane >> 4) & 1) << 5) | (((lane >> 5) & 1) << 8); }
constexpr int v_rd_off(int d0, int ks, int half) { return d0 * 512 + ks * 4096 + half * 2048; }
template <int OFF> __device__ __forceinline__ s16x4 tr_read(int vb) {
  s16x4 r; asm volatile("ds_read_b64_tr_b16 %0, %1 offset:%2" : "=&v"(r) : "v"(vb), "i"(OFF) : "memory"); return r;
}
template <int D0> __device__ __forceinline__ void pv_one(f32x16& od, int vb, bf16x8 pa0, bf16x8 pa1, bf16x8 pa2, bf16x8 pa3) {
  const s16x4 l0 = tr_read<v_rd_off(D0, 0, 0)>(vb), h0 = tr_read<v_rd_off(D0, 0, 1)>(vb), l1 = tr_read<v_rd_off(D0, 1, 0)>(vb), h1 = tr_read<v_rd_off(D0, 1, 1)>(vb);
  const s16x4 l2 = tr_read<v_rd_off(D0, 2, 0)>(vb), h2 = tr_read<v_rd_off(D0, 2, 1)>(vb), l3 = tr_read<v_rd_off(D0, 3, 0)>(vb), h3 = tr_read<v_rd_off(D0, 3, 1)>(vb);
  asm volatile("s_waitcnt lgkmcnt(0)" ::: "memory"); SBAR();
#define PK(L, H) (bf16x8){L[0], L[1], L[2], L[3], H[0], H[1], H[2], H[3]}
  od = __builtin_amdgcn_mfma_f32_32x32x16_bf16(pa0, PK(l0, h0), od, 0, 0, 0);
  od = __builtin_amdgcn_mfma_f32_32x32x16_bf16(pa1, PK(l1, h1), od, 0, 0, 0);
  od = __builtin_amdgcn_mfma_f32_32x32x16_bf16(pa2, PK(l2, h2), od, 0, 0, 0);
  od = __builtin_amdgcn_mfma_f32_32x32x16_bf16(pa3, PK(l3, h3), od, 0, 0, 0);
#undef PK
}
__device__ __forceinline__ void pv_d0(f32x16* o, int vb, bf16x8 pa0, bf16x8 pa1, bf16x8 pa2, bf16x8 pa3) {
  pv_one<0>(o[0], vb, pa0, pa1, pa2, pa3); pv_one<1>(o[1], vb, pa0, pa1, pa2, pa3); pv_one<2>(o[2], vb, pa0, pa1, pa2, pa3); pv_one<3>(o[3], vb, pa0, pa1, pa2, pa3);
}
__device__ __forceinline__ void attn_dense_body(const bf16_t* __restrict__ Qb, const bf16_t* __restrict__ Kh, const bf16_t* __restrict__ Vh, bf16_t* __restrict__ Ob, int seq, LAS char* lds) {
  int tid_ = threadIdx.x; asm volatile("" : "+v"(tid_));
  const int tid = tid_, wid = tid >> 6, lane = tid & 63, r32 = lane & 31, hi = lane >> 5;
  LAS char* V_lds = lds; LAS char* K_lds = lds + 2 * SHM_V;
  LAS float* ws = (LAS float*)(lds + 2 * SHM_V + 2 * SHM_K) + wid * 64; LAS float* li_l = ws; LAS float* al_l = ws + 32;
  float m_reg = -1e30f, l_reg = 0; f32x16 o[4] = {}; bf16x8 qr[8];
  const bf16_t* Qw = Qb + (long)(wid * QBLK + r32) * LDQ + hi * 8;
#pragma unroll
  for (int d0 = 0; d0 < 8; ++d0) qr[d0] = *reinterpret_cast<const bf16x8*>(Qw + d0 * 16);
  const int sr = tid >> 4, sc = (tid & 15) * 8, vst0 = v_st(sr, sc), vst1 = v_st(32 + sr, sc);
  const int vb0 = (int)(unsigned)(uintptr_t)V_lds + v_rd_base(lane);
  struct { bf16x8 vs0, vs1, ks0, ks1; } sr_[2];
#define SLOAD(i, k0) do { sr_[i].vs0 = *reinterpret_cast<const bf16x8*>(&Vh[(long)((k0) + sr) * LDK + sc]); sr_[i].vs1 = *reinterpret_cast<const bf16x8*>(&Vh[(long)((k0) + 32 + sr) * LDK + sc]); \
    sr_[i].ks0 = *reinterpret_cast<const bf16x8*>(&Kh[(long)((k0) + sr) * LDK + sc]); sr_[i].ks1 = *reinterpret_cast<const bf16x8*>(&Kh[(long)((k0) + 32 + sr) * LDK + sc]); } while (0)
#define SWRITE(b, i) do { *(LAS bf16x8*)(V_lds + (b) * SHM_V + vst0) = sr_[i].vs0;          \
    *(LAS bf16x8*)(V_lds + (b) * SHM_V + vst1) = sr_[i].vs1; int kc = sc * 2;               \
    *(LAS bf16x8*)(K_lds + (b) * SHM_K + KSWZ(sr, kc)) = sr_[i].ks0;                       \
    *(LAS bf16x8*)(K_lds + (b) * SHM_K + KSWZ(32 + sr, kc)) = sr_[i].ks1; } while (0)
#define SWAIT() asm volatile("s_waitcnt vmcnt(4)" ::: "memory")
#define RESC(a) do { if (__any((a) < 1.f)) { if (hi == 0) al_l[r32] = (a); asm volatile("s_waitcnt lgkmcnt(0)" ::: "memory"); \
    _Pragma("unroll") for (int d = 0; d < 4; ++d) _Pragma("unroll") for (int r = 0; r < 16; ++r) o[d][r] *= al_l[crow(r, hi)]; } } while (0)
  f32x16 pA0, pA1, pB0, pB1; float mnA, mnB, alA, alB; bf16x8 pa0, pa1, pa2, pa3; const int NT = seq / KVBLK;
  constexpr int SE = 0, SO = 1;
  SLOAD(SE, 0); asm volatile("s_waitcnt vmcnt(0)" ::: "memory"); SWRITE(0, SE); __syncthreads();
  qkt(pA0, pA1, K_lds, qr, r32, hi); partialSM(pA0, pA1, m_reg, mnA, alA);
  SLOAD(SO, KVBLK); if (2 < NT) SLOAD(SE, 2 * KVBLK);
  SWAIT(); SWRITE(1, SO); __syncthreads();
  for (int j = 1; j + 1 < NT; j += 2) {
    SBAR(); qkt(pB0, pB1, K_lds + SHM_K, qr, r32, hi);
    finishSM(pA0, pA1, alA, l_reg, pa0, pa1, pa2, pa3); SBAR();
    SLOAD(SO, (j + 2) * KVBLK); SBAR();
    pv_d0(o, vb0, pa0, pa1, pa2, pa3); partialSM(pB0, pB1, m_reg, mnB, alB);
    __syncthreads(); SWAIT(); SWRITE(0, SE);
    RESC(alB); __syncthreads();
    SBAR(); qkt(pA0, pA1, K_lds, qr, r32, hi);
    finishSM(pB0, pB1, alB, l_reg, pa0, pa1, pa2, pa3); SBAR();
    if (j + 3 < NT) SLOAD(SE, (j + 3) * KVBLK); SBAR();
    pv_d0(o, vb0 + SHM_V, pa0, pa1, pa2, pa3); partialSM(pA0, pA1, m_reg, mnA, alA);
    __syncthreads(); SWAIT(); SWRITE(1, SO);
    RESC(alA); __syncthreads();
  }
  SBAR(); qkt(pB0, pB1, K_lds + SHM_K, qr, r32, hi);
  finishSM(pA0, pA1, alA, l_reg, pa0, pa1, pa2, pa3); SBAR();
  pv_d0(o, vb0, pa0, pa1, pa2, pa3); partialSM(pB0, pB1, m_reg, mnB, alB);
  __syncthreads(); RESC(alB);
  finishSM(pB0, pB1, alB, l_reg, pa0, pa1, pa2, pa3); SBAR();
  pv_d0(o, vb0 + SHM_V, pa0, pa1, pa2, pa3);
  if (hi == 0) li_l[r32] = l_reg; asm volatile("s_waitcnt lgkmcnt(0)" ::: "memory");
  float rli[16];
#pragma unroll
  for (int r = 0; r < 16; ++r) rli[r] = __builtin_amdgcn_rcpf(li_l[crow(r, hi)]);
  bf16_t* Ow = Ob + (long)(wid * QBLK) * LDO;
#pragma unroll
  for (int r = 0; r < 16; ++r) { const int orow = crow(r, hi);
#pragma unroll
    for (int d0 = 0; d0 < 4; ++d0) { const unsigned w = cvtpk(o[d0][r] * rli[r], 0.f); Ow[(long)orow * LDO + d0 * 32 + r32] = (bf16_t)(w & 0xffffu); } }
#undef SLOAD
#undef SWRITE
#undef SWAIT
#undef RESC
}
#undef SBAR
}

constexpr int NWAVES = 8;
constexpr int N_PHASES = 1 + 11 * DEPTH;
constexpr int N_LAUNCHES = MK_N_LAUNCHES;
static_assert(N_LAUNCHES == 1 || N_LAUNCHES == N_PHASES, "MK_N_LAUNCHES is 1 or 23");

constexpr size_t MiB = 1u << 20;
constexpr size_t WS_CTL = 0, CTL_ZERO_BYTES = 1 * MiB;
constexpr size_t WS_ROPE = 1 * MiB;
constexpr size_t WS_PB = 2 * MiB;
constexpr size_t WS_W = 16 * MiB;
constexpr size_t LW_IN = 0, LW_POOL = 128 * MiB, LW_OUT = 132 * MiB, LW_GU = 164 * MiB, LW_DOWN = 336 * MiB, LW_PIN = 422 * MiB, LW_PG = 424 * MiB, LW_BYTES = 456 * MiB;
constexpr size_t WS_ACT = WS_W + 2 * LW_BYTES;
constexpr size_t WS_H = WS_ACT;
constexpr size_t WS_Q = WS_H + 64 * MiB;
constexpr size_t WS_K = WS_Q + 64 * MiB;
constexpr size_t WS_V = WS_K + 16 * MiB;
constexpr size_t WS_U = WS_V + 16 * MiB;
constexpr size_t WS_GA = WS_U + 32 * MiB;
constexpr size_t WS_GP = WS_GA + 64 * MiB;
constexpr size_t WS_Q2 = WS_GP + 64 * MiB;
constexpr size_t WS_K2 = WS_Q2 + 64 * MiB;
constexpr size_t WS_DL = WS_K2 + 16 * MiB;
constexpr size_t WS_O = WS_DL + 32 * MiB;
constexpr size_t WS_MG = WS_O + 64 * MiB;
constexpr size_t WS_Y = WS_MG + 64 * MiB;
constexpr size_t WS_F = WS_Y + 64 * MiB;
constexpr size_t WS_E = WS_F + 172 * MiB;
constexpr size_t WS_END = WS_E + 128 * MiB;
static_assert(WS_END <= 2048 * MiB, "workspace map");

constexpr int CW_TMO = 0, CW_CODE = 1;
constexpr int CW_BAR = 4096;

constexpr int RING_OFF = 0, RING_BYTES = 131072;
constexpr int LDSCTL_OFF = RING_BYTES, MISC_OFF = LDSCTL_OFF + 320;
constexpr int LDS_BYTES = 147456;

typedef GAS unsigned gu32;
#define RLX_AGENT __ATOMIC_RELAXED, __HIP_MEMORY_SCOPE_AGENT
#define LDS_WAIT() asm volatile("s_waitcnt lgkmcnt(0)" ::: "memory")
#define VM_WAIT() asm volatile("s_waitcnt vmcnt(0)" ::: "memory")
__device__ __forceinline__ unsigned f2bf(float f) { unsigned u = __builtin_bit_cast(unsigned, f); return (u + 0x7fffu + ((u >> 16) & 1u)) >> 16; }
__device__ __forceinline__ unsigned pk2(float lo, float hi) { return f2bf(lo) | (f2bf(hi) << 16); }

#define XB_TMO      128
#define XB_XCNT(j)  (256  + 64 * (j))
#define XB_XSUB(j)  (1280 + 64 * (j))
#define XB_XGEN(j)  (2304 + 64 * (j))
#define XB_TOP      3328
#define XB_TOPGEN   3392
#define XCD_BAR_WORDS 3456
#define XB_SPIN_CAP (1u << 18)

__device__ __forceinline__ unsigned xb_ld(unsigned* p)              { return __hip_atomic_load(p, __ATOMIC_RELAXED, __HIP_MEMORY_SCOPE_AGENT); }
__device__ __forceinline__ unsigned xb_add(unsigned* p, unsigned v) { return __hip_atomic_fetch_add(p, v, __ATOMIC_RELAXED, __HIP_MEMORY_SCOPE_AGENT); }
__device__ __forceinline__ unsigned xb_xcc_id() { return (unsigned)__builtin_amdgcn_s_getreg((3 << 11) | 20) & 0xFu; }
#define XB_SPIN(cond, bar) do { unsigned _sp = 0; while (cond) { __builtin_amdgcn_s_sleep(1); \
    if ((++_sp & 255u) == 0u) { if (xb_ld(&(bar)[XB_TMO])) break; if (_sp > XB_SPIN_CAP) { atomicAdd(&(bar)[XB_TMO], 1u); break; } } } } while (0)

struct XcdBarrier {
    unsigned* bar; unsigned x;
    volatile LAS unsigned* st;
};
__device__ __forceinline__ XcdBarrier xcd_barrier_post(unsigned* bar, volatile LAS unsigned* st) {
    XcdBarrier b; b.bar = bar; b.x = xb_xcc_id(); b.st = st;
    if (threadIdx.x == 0) (void)xb_add(&bar[XB_XCNT(b.x)], 1u);
    return b;
}
__device__ __forceinline__ void xcd_barrier_complete(unsigned* bar, unsigned x, unsigned& nloc, unsigned& nx) {
    const unsigned G = gridDim.x * gridDim.y * gridDim.z;
    unsigned sum, cnt, mine, sp = 0u;
    for (;;) {
        sum = 0u; cnt = 0u; mine = 0u;
#pragma unroll
        for (unsigned j = 0; j < 16; ++j) { const unsigned c = xb_ld(&bar[XB_XCNT(j)]); sum += c; cnt += (c > 0u) ? 1u : 0u; mine = (j == x) ? c : mine; }
        if (sum == G) break;
        __builtin_amdgcn_s_sleep(1);
        if ((++sp & 255u) == 0u) { if (xb_ld(&bar[XB_TMO])) break; if (sp > XB_SPIN_CAP) { atomicAdd(&bar[XB_TMO], 1u); break; } }
    }
    nloc = mine > 0u ? mine : 1u; nx = cnt > 0u ? cnt : 1u;
}
__device__ __forceinline__ void xcd_barrier(const XcdBarrier& b) {
    asm volatile("s_waitcnt vmcnt(0)" ::: "memory");
    __syncthreads();
    if (threadIdx.x == 0) {
        unsigned* bar = b.bar; asm volatile("" : "+s"(bar));
        __builtin_amdgcn_s_waitcnt(0);
        unsigned nloc = b.st[0], nx = b.st[1];
        if (nloc == 0u) { xcd_barrier_complete(bar, b.x, nloc, nx); b.st[0] = nloc; b.st[1] = nx; }
        const unsigned old = xb_add(&bar[XB_XSUB(b.x)], 1u);
        const unsigned gen = old / nloc;
        if (old + 1u == (gen + 1u) * nloc) {
            __builtin_amdgcn_fence(__ATOMIC_RELEASE, "agent");
            asm volatile("s_waitcnt vmcnt(0)" ::: "memory");
            const unsigned og = xb_add(&bar[XB_TOP], 1u);
            const unsigned tg = og / nx;
            if (og + 1u == (tg + 1u) * nx) xb_add(&bar[XB_TOPGEN], 1u);
            else XB_SPIN(xb_ld(&bar[XB_TOPGEN]) == tg, bar);
            __builtin_amdgcn_fence(__ATOMIC_ACQUIRE, "agent");
            xb_add(&bar[XB_XGEN(b.x)], 1u);
            asm volatile("s_waitcnt vmcnt(0)" ::: "memory");
        } else {
            XB_SPIN(xb_ld(&bar[XB_XGEN(b.x)]) == gen, bar);
            __builtin_amdgcn_fence(__ATOMIC_ACQUIRE, "agent");
            asm volatile("s_waitcnt vmcnt(0)" ::: "memory");
        }
    }
    __syncthreads();
}

struct Frame {
    LAS unsigned char* lds;
    int tid, lane, wave;
    int vcu, G, bx;
};
__device__ __forceinline__ Frame make_frame(LAS unsigned char* lds) {
    Frame F; int t = threadIdx.x; asm volatile("" : "+v"(t)); int bx = blockIdx.x; asm volatile("" : "+s"(bx)); int G = gridDim.x; asm volatile("" : "+s"(G));
    F.lds = lds; F.tid = t; F.lane = t & 63; F.wave = __builtin_amdgcn_readfirstlane(t >> 6); F.G = G; F.bx = bx;
    F.vcu = (G % 8 == 0) ? (bx % 8) * (G / 8) + bx / 8 : bx;
    return F;
}

__device__ __forceinline__ float wave_sum(float v) {
#pragma unroll
    for (int o = 1; o < 64; o <<= 1) v += __shfl_xor(v, o);
    return v;
}

template <int MAP>
__device__ __forceinline__ void p0_transpose_item(const float* W, int K, int N, bf16_t* WT, int row_off, LAS float* scr, int item, int lane) {
    const int nblk = N / 32, kb = item / nblk, nb = item % nblk, k0 = 64 * kb, n0 = 32 * nb;
    const int r0 = (MAP == 0) ? (row_off + n0) : (256 * (n0 >> 7) + (n0 & 127) + row_off);
#pragma unroll 8
    for (int i = 0; i < 32; ++i) { const int kk = 2 * i + (lane >> 5); scr[kk * 33 + (lane & 31)] = W[(size_t)(k0 + kk) * N + n0 + (lane & 31)]; }
    LDS_WAIT(); asm volatile("" ::: "memory");
    const int c = lane & 7;
#pragma unroll
    for (int j = 0; j < 4; ++j) { const int n = (lane >> 3) + 8 * j; const LAS float* s = scr + (8 * c) * 33 + n;
        u32x4 o; o.x = pk2(s[0 * 33], s[1 * 33]); o.y = pk2(s[2 * 33], s[3 * 33]); o.z = pk2(s[4 * 33], s[5 * 33]); o.w = pk2(s[6 * 33], s[7 * 33]);
        *(GAS u32x4*)(WT + (size_t)(r0 + n) * K + k0 + 8 * c) = o; }
    LDS_WAIT(); asm volatile("" ::: "memory");
}

struct Args { const float* in[18]; float* out; unsigned char* ws; int ph_lo, ph_hi; };

__device__ __forceinline__ void norm_row(int lane, const float* xin, float* xout, const bf16_t* y, const LAS float* gpost, const LAS float* gpre, bf16_t* h, int hmode) {
    const GAS f32x4* xr = (const GAS f32x4*)xin + lane;
    f32x4 v[16];
#pragma unroll
    for (int j = 0; j < 16; ++j) v[j] = xr[64 * j];
    if (y) {
        const GAS u32x2* yr = (const GAS u32x2*)y + lane; f32x4 yv[16]; float s = 0.f;
#pragma unroll
        for (int j = 0; j < 16; ++j) { const u32x2 w = yr[64 * j]; yv[j] = (f32x4){bf_lo(w.x), bf_hi(w.x), bf_lo(w.y), bf_hi(w.y)}; s += (yv[j].x * yv[j].x + yv[j].y * yv[j].y) + (yv[j].z * yv[j].z + yv[j].w * yv[j].w); }
        const float rstd = 1.0f / sqrtf(wave_sum(s) * (1.f / DM) + EPS);
#pragma unroll
        for (int j = 0; j < 16; ++j) { const f32x4 g = *(const LAS f32x4*)(gpost + 4 * lane + 256 * j); v[j] = v[j] + yv[j] * rstd * g; }
    }
    if (xout) { GAS f32x4* xo = (GAS f32x4*)xout + lane;
#pragma unroll
        for (int j = 0; j < 16; ++j) xo[64 * j] = v[j]; }
    if (hmode) {
        float rstd = 1.f;
        if (hmode == 2) { float s = 0.f;
#pragma unroll
            for (int j = 0; j < 16; ++j) s += (v[j].x * v[j].x + v[j].y * v[j].y) + (v[j].z * v[j].z + v[j].w * v[j].w);
            rstd = 1.0f / sqrtf(wave_sum(s) * (1.f / DM) + EPS); }
        GAS u32x2* ho = (GAS u32x2*)h + lane;
#pragma unroll
        for (int j = 0; j < 16; ++j) { f32x4 t = v[j] * rstd; if (hmode == 2) { const f32x4 g = *(const LAS f32x4*)(gpre + 4 * lane + 256 * j); t = t * g; }
            u32x2 w; w.x = cvt_pk_bf16(t.x, t.y); w.y = cvt_pk_bf16(t.z, t.w); ho[64 * j] = w; }
    }
}
__device__ __forceinline__ void norm_pass(Frame& F, const float* xin, float* xout, const bf16_t* y, const float* gpost, const float* gpre, bf16_t* h, int hmode) {
    LAS float* gl = (LAS float*)(F.lds + RING_OFF);
    __syncthreads();
    for (int i = F.tid; i < DM; i += NWAVES * 64) { gl[i] = gpost ? gpost[i] : 0.f; gl[DM + i] = gpre ? gpre[i] : 0.f; }
    __syncthreads();
    const int gw = F.vcu * NWAVES + F.wave, NGW = F.G * NWAVES;
    for (int m = gw; m < S; m += NGW)
        norm_row(F.lane, xin + (size_t)m * DM, xout ? xout + (size_t)m * DM : nullptr, y ? y + (size_t)m * DM : nullptr, gl, gl + DM, h ? h + (size_t)m * DM : nullptr, hmode);
    __syncthreads();
}

__device__ __forceinline__ void qk_norm_rope_pass(Frame& F, const bf16_t* Qr, const bf16_t* Kr, bf16_t* Q2, bf16_t* K2, const float* qn, const float* kn, const float* rope) {
    const int gw = F.vcu * NWAVES + F.wave, NGW = F.G * NWAVES;
    const int g16 = F.lane >> 4, s = F.lane & 15;
    constexpr int NITEM = S * (NH + NKV);
    const int dsub = 8 * s;
    const int axis = s >> 3, half = (s >> 2) & 1, i0 = 8 * (s & 3);
    for (int it = 4 * gw + g16; it < NITEM; it += 4 * NGW) {
        const int row = it / (NH + NKV), hh = it % (NH + NKV);
        const bool isq = hh < NH;
        const bf16_t* src = isq ? Qr + (size_t)row * DM + hh * HD + dsub : Kr + (size_t)row * KVW + (hh - NH) * HD + dsub;
        bf16_t* dst = isq ? Q2 + (size_t)row * DM + hh * HD + dsub : K2 + (size_t)row * KVW + (hh - NH) * HD + dsub;
        const float* gn = isq ? qn : kn;
        const u32x4 w = *(const GAS u32x4*)src;
        float x[8] = {bf_lo(w.x), bf_hi(w.x), bf_lo(w.y), bf_hi(w.y), bf_lo(w.z), bf_hi(w.z), bf_lo(w.w), bf_hi(w.w)};
        float ss = 0.f;
#pragma unroll
        for (int j = 0; j < 8; ++j) ss += x[j] * x[j];
        ss += __shfl_xor(ss, 1); ss += __shfl_xor(ss, 2); ss += __shfl_xor(ss, 4); ss += __shfl_xor(ss, 8);
        const float rstd = 1.0f / sqrtf(ss * (1.f / HD) + EPS);
        const f32x4 ga = *(const f32x4*)(gn + dsub), gb = *(const f32x4*)(gn + dsub + 4);
        const float g[8] = {ga.x, ga.y, ga.z, ga.w, gb.x, gb.y, gb.z, gb.w};
#pragma unroll
        for (int j = 0; j < 8; ++j) x[j] = x[j] * rstd * g[j];
        float xp[8];
#pragma unroll
        for (int j = 0; j < 8; ++j) xp[j] = __shfl_xor(x[j], 4);
        const int pos = axis ? (row & 63) : (row >> 6);
        const f32x4* tp = (const f32x4*)(rope + ((size_t)pos * 32 + i0) * 2);
        float o[8];
#pragma unroll
        for (int jj = 0; jj < 4; ++jj) { const f32x4 cs = tp[jj];
            o[2 * jj]     = half ? (x[2 * jj] * cs.x + xp[2 * jj] * cs.y)         : (x[2 * jj] * cs.x - xp[2 * jj] * cs.y);
            o[2 * jj + 1] = half ? (x[2 * jj + 1] * cs.z + xp[2 * jj + 1] * cs.w) : (x[2 * jj + 1] * cs.z - xp[2 * jj + 1] * cs.w); }
        u32x4 ow; ow.x = cvt_pk_bf16(o[0], o[1]); ow.y = cvt_pk_bf16(o[2], o[3]); ow.z = cvt_pk_bf16(o[4], o[5]); ow.w = cvt_pk_bf16(o[6], o[7]);
        *(GAS u32x4*)dst = ow;
    }
}
__device__ __forceinline__ void pool_delta_pass(Frame& F, const bf16_t* U, bf16_t* DL) {
    const int gt = F.vcu * (NWAVES * 64) + F.tid, NT = F.G * NWAVES * 64;
    for (int it = gt; it < S * (POOLW / 8); it += NT) {
        const int t = it >> 8, c = it & 255, g = c >> 6, hw = 1 << g;
        const int lo = (t - hw) < 0 ? 0 : (t - hw), hi = (t + hw) > S ? S : (t + hw);
        float acc[8] = {0.f, 0.f, 0.f, 0.f, 0.f, 0.f, 0.f, 0.f};
        for (int r = lo; r < hi; ++r) { const u32x4 w = *(const GAS u32x4*)(U + (size_t)r * POOLW + 8 * c);
            acc[0] += bf_lo(w.x); acc[1] += bf_hi(w.x); acc[2] += bf_lo(w.y); acc[3] += bf_hi(w.y); acc[4] += bf_lo(w.z); acc[5] += bf_hi(w.z); acc[6] += bf_lo(w.w); acc[7] += bf_hi(w.w); }
        const u32x4 w = *(const GAS u32x4*)(U + (size_t)t * POOLW + 8 * c);
        const float inv = 1.0f / (float)(hi - lo);
        const float me[8] = {bf_lo(w.x), bf_hi(w.x), bf_lo(w.y), bf_hi(w.y), bf_lo(w.z), bf_hi(w.z), bf_lo(w.w), bf_hi(w.w)};
        float d[8];
#pragma unroll
        for (int j = 0; j < 8; ++j) d[j] = acc[j] * inv - me[j];
        u32x4 ow; ow.x = cvt_pk_bf16(d[0], d[1]); ow.y = cvt_pk_bf16(d[2], d[3]); ow.z = cvt_pk_bf16(d[4], d[5]); ow.w = cvt_pk_bf16(d[6], d[7]);
        *(GAS u32x4*)(DL + (size_t)t * POOLW + 8 * c) = ow;
    }
}

__device__ __forceinline__ double inv_freq_of(int i) {
    const double step = 0.74989420933245582730;
    double r = 1.0; for (int k = 0; k < i; ++k) r *= step; return r;
}

typedef const __attribute__((address_space(4))) Args CArgs;
__device__ __forceinline__ CArgs* fresh_args() { CArgs* p = (CArgs*)__builtin_amdgcn_kernarg_segment_ptr(); asm volatile("" : "+s"(p)); return p; }
#define WSP(off) ((bf16_t*)(ws + (off)))

__global__ void __launch_bounds__(NWAVES * 64, 2) fwd_kernel(Args args) {
    extern __shared__ __attribute__((aligned(16))) unsigned char lds[];
    LAS unsigned char* const L = (LAS unsigned char*)lds;
    for (int u = threadIdx.x; u < (LDS_BYTES - LDSCTL_OFF) / 4; u += NWAVES * 64) ((LAS unsigned*)(L + LDSCTL_OFF))[u] = 0u;
    __syncthreads();
    unsigned* const barw = (unsigned*)(args.ws + WS_CTL) + CW_BAR;
    XcdBarrier bar; bar.bar = barw; bar.x = 0; bar.st = nullptr;
    if (N_LAUNCHES == 1) bar = xcd_barrier_post(barw, (volatile LAS unsigned*)(L + MISC_OFF) + 8);
#define GRID_BAR() do { if (N_LAUNCHES == 1) xcd_barrier(bar); } while (0)
    const int lo = args.ph_lo, hi = args.ph_hi;
#define IN(k) (lo <= (k) && (k) < hi)
#define SEAM(k) do { if (IN(k) && IN((k) + 1)) GRID_BAR(); } while (0)

    if (IN(0)) {
        CArgs* ap = fresh_args(); unsigned char* ws = ap->ws; Frame F = make_frame(L);
        LAS float* scr = (LAS float*)(F.lds + RING_OFF + F.wave * 16384);
        const int gw = F.vcu * NWAVES + F.wave, NGW = F.G * NWAVES;
        constexpr int I_IN = (DM / 64) * (INW / 32), I_POOL = (PGI / 64) * (PGO / 32), I_OUT = (DM / 64) * (DM / 32), I_GU = (DM / 64) * (FF / 32), I_DOWN = (FF / 64) * (DM / 32), I_PIN = (DPLE / 64) * (DM / 32);
        constexpr int I_LAYER = I_IN + 4 * I_POOL + I_OUT + 2 * I_GU + I_DOWN + I_PIN + I_OUT;
        for (int it = gw; it < DEPTH * I_LAYER; it += NGW) {
            const int l = it / I_LAYER; int r = it % I_LAYER;
            unsigned char* wl = ws + WS_W + (size_t)l * LW_BYTES;
            if (r < I_IN) { p0_transpose_item<0>(ap->in[2] + (size_t)l * DM * INW, DM, INW, (bf16_t*)(wl + LW_IN), 0, scr, r, F.lane); continue; } r -= I_IN;
            if (r < 4 * I_POOL) { const int g = r / I_POOL; p0_transpose_item<0>(ap->in[5] + ((size_t)l * 4 + g) * PGI * PGO, PGI, PGO, (bf16_t*)(wl + LW_POOL), g * PGO, scr, r % I_POOL, F.lane); continue; } r -= 4 * I_POOL;
            if (r < I_OUT) { p0_transpose_item<0>(ap->in[7] + (size_t)l * DM * DM, DM, DM, (bf16_t*)(wl + LW_OUT), 0, scr, r, F.lane); continue; } r -= I_OUT;
            if (r < I_GU) { p0_transpose_item<1>(ap->in[12] + (size_t)l * DM * FF, DM, FF, (bf16_t*)(wl + LW_GU), 0, scr, r, F.lane); continue; } r -= I_GU;
            if (r < I_GU) { p0_transpose_item<1>(ap->in[13] + (size_t)l * DM * FF, DM, FF, (bf16_t*)(wl + LW_GU), 128, scr, r, F.lane); continue; } r -= I_GU;
            if (r < I_DOWN) { p0_transpose_item<0>(ap->in[14] + (size_t)l * FF * DM, FF, DM, (bf16_t*)(wl + LW_DOWN), 0, scr, r, F.lane); continue; } r -= I_DOWN;
            if (r < I_PIN) { p0_transpose_item<0>(ap->in[15] + (size_t)l * DPLE * DM, DPLE, DM, (bf16_t*)(wl + LW_PIN), 0, scr, r, F.lane); continue; } r -= I_PIN;
            p0_transpose_item<0>(ap->in[16] + (size_t)l * DM * DM, DM, DM, (bf16_t*)(wl + LW_PG), 0, scr, r, F.lane);
        }
        { const int gt = F.vcu * (NWAVES * 64) + F.tid, NT = F.G * NWAVES * 64;
          const float* p_in = ap->in[1]; bf16_t* PB = WSP(WS_PB); float* rope = (float*)(ws + WS_ROPE);
          for (int i = gt; i < DEPTH * S * DPLE / 8; i += NT) { const f32x4 a = *(const GAS f32x4*)(p_in + (size_t)i * 8), b = *(const GAS f32x4*)(p_in + (size_t)i * 8 + 4);
              u32x4 o; o.x = cvt_pk_bf16(a.x, a.y); o.y = cvt_pk_bf16(a.z, a.w); o.z = cvt_pk_bf16(b.x, b.y); o.w = cvt_pk_bf16(b.z, b.w); *(GAS u32x4*)(PB + (size_t)i * 8) = o; }
          for (int i = gt; i < 128 * 32; i += NT) { const int pos = i >> 5, fi = i & 31;
              const double ang = (double)pos * inv_freq_of(fi); const double k = __builtin_rint(ang * 0.15915494309189533577); const double r = ang - k * 6.283185307179586476925;
              const float rf = (float)r; rope[2 * i] = cosf(rf); rope[2 * i + 1] = sinf(rf); }
        }
        norm_pass(F, ap->in[0], nullptr, nullptr, nullptr, ap->in[8], WSP(WS_H), 2);
    }
    SEAM(0);

    for (int l = 0; l < DEPTH; ++l) {
        const int pb = 1 + 11 * l;
        if (IN(pb + 0)) {
            CArgs* ap = fresh_args(); unsigned char* ws = ap->ws; Frame F = make_frame(L); unsigned char* wl = ws + WS_W + (size_t)l * LW_BYTES;
            { pg8::Gemm g{WSP(WS_H), (const bf16_t*)(wl + LW_IN), S, INW, DM, DM, DM, 0}; pg8::StaticOrder So; So.init(S, INW, F.G, F.bx);
              pg8::EpiZ E{WSP(WS_Q), WSP(WS_K), WSP(WS_V), WSP(WS_U), WSP(WS_GA), WSP(WS_GP)};
              pg8::gemm_phase<pg8::EpiZ, pg8::StaticOrder, true, true>(F.lds + RING_OFF, g, So, E); }
            if (l == 0) {
                for (int l2 = 0; l2 < DEPTH; ++l2) {
                    pg8::Gemm g2{WSP(WS_PB) + (size_t)l2 * S * DPLE, (const bf16_t*)(ws + WS_W + (size_t)l2 * LW_BYTES + LW_PIN), S, DM, DPLE, DPLE, DPLE, 0}; pg8::StaticOrder S2; S2.init(S, DM, F.G, F.bx);
                    pg8::EpiPlain E2{WSP(WS_E) + (size_t)l2 * S * DM, DM};
                    pg8::gemm_phase<pg8::EpiPlain, pg8::StaticOrder, true, true>(F.lds + RING_OFF, g2, S2, E2);
                }
            }
        }
        SEAM(pb + 0);
        if (IN(pb + 1)) {
            CArgs* ap = fresh_args(); unsigned char* ws = ap->ws; Frame F = make_frame(L);
            qk_norm_rope_pass(F, WSP(WS_Q), WSP(WS_K), WSP(WS_Q2), WSP(WS_K2), ap->in[3] + l * HD, ap->in[4] + l * HD, (const float*)(ws + WS_ROPE));
            pool_delta_pass(F, WSP(WS_U), WSP(WS_DL));
        }
        SEAM(pb + 1);
        if (IN(pb + 2)) {
            CArgs* ap = fresh_args(); unsigned char* ws = ap->ws; Frame F = make_frame(L);
            for (int U0 = F.vcu; U0 < NH * (S / 256); U0 += F.G) {
                const int a = U0 >> 8, b = (U0 >> 5) & 7, c = U0 & 31, h = 4 * b + a, qb = c, kvh = h >> 2;
                att::attn_dense_body(WSP(WS_Q2) + (size_t)qb * 256 * DM + h * HD, WSP(WS_K2) + kvh * HD, WSP(WS_V) + kvh * HD, WSP(WS_O) + (size_t)qb * 256 * DM + h * HD, S, (LAS char*)(F.lds + RING_OFF));
                __syncthreads();
            }
        }
        SEAM(pb + 2);
        if (IN(pb + 3)) {
            CArgs* ap = fresh_args(); unsigned char* ws = ap->ws; Frame F = make_frame(L); unsigned char* wl = ws + WS_W + (size_t)l * LW_BYTES;
            pg8::Gemm g{WSP(WS_DL), (const bf16_t*)(wl + LW_POOL), S, DM, PGI, POOLW, PGI, PGI}; pg8::StaticOrder So; So.init(S, DM, F.G, F.bx);
            pg8::EpiPool E{WSP(WS_MG), WSP(WS_O), WSP(WS_GA), WSP(WS_GP), ap->in[6] + (size_t)l * DM, DM};
            pg8::gemm_phase<pg8::EpiPool, pg8::StaticOrder, true, true>(F.lds + RING_OFF, g, So, E);
        }
        SEAM(pb + 3);
        if (IN(pb + 4)) {
            CArgs* ap = fresh_args(); unsigned char* ws = ap->ws; Frame F = make_frame(L); unsigned char* wl = ws + WS_W + (size_t)l * LW_BYTES;
            pg8::Gemm g{WSP(WS_MG), (const bf16_t*)(wl + LW_OUT), S, DM, DM, DM, DM, 0}; pg8::StaticOrder So; So.init(S, DM, F.G, F.bx);
            pg8::EpiPlain E{WSP(WS_Y), DM};
            pg8::gemm_phase<pg8::EpiPlain, pg8::StaticOrder, true, true>(F.lds + RING_OFF, g, So, E);
        }
        SEAM(pb + 4);
        if (IN(pb + 5)) {
            CArgs* ap = fresh_args(); unsigned char* ws = ap->ws; Frame F = make_frame(L);
            norm_pass(F, l == 0 ? ap->in[0] : (const float*)ap->out, ap->out, WSP(WS_Y), ap->in[9] + (size_t)l * DM, ap->in[10] + (size_t)l * DM, WSP(WS_H), 2);
        }
        SEAM(pb + 5);
        if (IN(pb + 6)) {
            CArgs* ap = fresh_args(); unsigned char* ws = ap->ws; Frame F = make_frame(L); unsigned char* wl = ws + WS_W + (size_t)l * LW_BYTES;
            pg8::Gemm g{WSP(WS_H), (const bf16_t*)(wl + LW_GU), S, 2 * FF, DM, DM, DM, 0}; pg8::StaticOrder So; So.init(S, 2 * FF, F.G, F.bx);
            pg8::EpiSwiglu E{WSP(WS_F), FF};
            pg8::gemm_phase<pg8::EpiSwiglu, pg8::StaticOrder, true, true>(F.lds + RING_OFF, g, So, E);
        }
        SEAM(pb + 6);
        if (IN(pb + 7)) {
            CArgs* ap = fresh_args(); unsigned char* ws = ap->ws; Frame F = make_frame(L); unsigned char* wl = ws + WS_W + (size_t)l * LW_BYTES;
            pg8::Gemm g{WSP(WS_F), (const bf16_t*)(wl + LW_DOWN), S, DM, FF, FF, FF, 0}; pg8::StaticOrder So; So.init(S, DM, F.G, F.bx);
            pg8::EpiPlain E{WSP(WS_Y), DM};
            pg8::gemm_phase<pg8::EpiPlain, pg8::StaticOrder, true, true>(F.lds + RING_OFF, g, So, E);
        }
        SEAM(pb + 7);
        if (IN(pb + 8)) {
            CArgs* ap = fresh_args(); unsigned char* ws = ap->ws; Frame F = make_frame(L);
            norm_pass(F, ap->out, ap->out, WSP(WS_Y), ap->in[11] + (size_t)l * DM, nullptr, WSP(WS_H), 1);
        }
        SEAM(pb + 8);
        if (IN(pb + 9)) {
            CArgs* ap = fresh_args(); unsigned char* ws = ap->ws; Frame F = make_frame(L); unsigned char* wl = ws + WS_W + (size_t)l * LW_BYTES;
            pg8::Gemm g{WSP(WS_H), (const bf16_t*)(wl + LW_PG), S, DM, DM, DM, DM, 0}; pg8::StaticOrder So; So.init(S, DM, F.G, F.bx);
            pg8::EpiPle E{WSP(WS_Y), WSP(WS_E) + (size_t)l * S * DM, DM};
            pg8::gemm_phase<pg8::EpiPle, pg8::StaticOrder, true, true>(F.lds + RING_OFF, g, So, E);
        }
        SEAM(pb + 9);
        if (IN(pb + 10)) {
            CArgs* ap = fresh_args(); unsigned char* ws = ap->ws; Frame F = make_frame(L);
            if (l + 1 < DEPTH) norm_pass(F, ap->out, ap->out, WSP(WS_Y), ap->in[17] + (size_t)l * DM, ap->in[8] + (size_t)(l + 1) * DM, WSP(WS_H), 2);
            else norm_pass(F, ap->out, ap->out, WSP(WS_Y), ap->in[17] + (size_t)l * DM, nullptr, nullptr, 0);
        }
        SEAM(pb + 10);
    }
#undef IN
#undef SEAM
#undef GRID_BAR
}

extern "C" void kernel_launch(void* const* d_in, const int* in_sizes, int n_in, void* d_out, int out_size, void* d_ws, size_t ws_size, hipStream_t stream) {
    static int grid = 0;
    if (grid == 0) {
        if (n_in != 18 || in_sizes[0] != S * DM || out_size != S * DM || ws_size < WS_END) { fprintf(stderr, "kernel_launch: shape/workspace mismatch: n_in %d in0 %d out %d ws %zu (need %zu)\n", n_in, n_in > 0 ? in_sizes[0] : -1, out_size, ws_size, (size_t)WS_END); grid = -1; return; }
        int dev = 0, cus = 0, per_cu = 0;
        if (hipGetDevice(&dev) != hipSuccess || hipDeviceGetAttribute(&cus, hipDeviceAttributeMultiprocessorCount, dev) != hipSuccess) { grid = -1; return; }
        if (hipFuncSetAttribute((const void*)fwd_kernel, hipFuncAttributeMaxDynamicSharedMemorySize, LDS_BYTES) != hipSuccess) { fprintf(stderr, "kernel_launch: hipFuncSetAttribute failed\n"); grid = -1; return; }
        if (hipOccupancyMaxActiveBlocksPerMultiprocessor(&per_cu, (const void*)fwd_kernel, NWAVES * 64, LDS_BYTES) != hipSuccess || per_cu < 1) { fprintf(stderr, "kernel_launch: occupancy query says %d blocks per CU\n", per_cu); }
        (void)hipGetLastError();
        grid = cus;
    }
    if (grid < 0) return;
    if (hipMemsetAsync((char*)d_ws + WS_CTL, 0, CTL_ZERO_BYTES, stream) != hipSuccess) return;
    Args a{};
    for (int i = 0; i < 18; ++i) a.in[i] = (const float*)d_in[i];
    a.out = (float*)d_out; a.ws = (unsigned char*)d_ws;
    for (int li = 0; li < N_LAUNCHES; ++li) {
        a.ph_lo = (N_LAUNCHES == 1) ? 0 : li; a.ph_hi = (N_LAUNCHES == 1) ? N_PHASES : li + 1;
        hipLaunchKernelGGL(fwd_kernel, dim3(grid), dim3(NWAVES * 64), LDS_BYTES, stream, a);
        const hipError_t le = hipPeekAtLastError();
        if (le != hipSuccess) { fprintf(stderr, "kernel_launch: launch %d failed: %s\n", li, hipGetErrorName(le)); break; }
    }
}
```

```cpp
#include <hip/hip_runtime.h>
#include <cstdio>
#include <cstdint>

#ifndef MK_N_LAUNCHES
#define MK_N_LAUNCHES 1
#endif

#define LAS __attribute__((address_space(3)))
#define GAS __attribute__((address_space(1)))
typedef unsigned short bf16_t;
typedef short bf16x8 __attribute__((ext_vector_type(8)));
typedef short s16x4 __attribute__((ext_vector_type(4)));
typedef float f32x4 __attribute__((ext_vector_type(4)));
typedef float f32x2 __attribute__((ext_vector_type(2)));
typedef float f32x16 __attribute__((ext_vector_type(16)));
typedef unsigned u32x4 __attribute__((ext_vector_type(4)));
typedef unsigned u32x2 __attribute__((ext_vector_type(2)));

constexpr int S = 8192, DM = 4096, DEPTH = 2;
constexpr int NH = 32, NKV = 8, HD = 128;
constexpr int KVW = NKV * HD;
constexpr int POOLW = 2048, PGI = 512, PGO = 1024;
constexpr int INW = 16384;
constexpr int FF = 11008;
constexpr int DPLE = 256;
constexpr float EPS = 1e-6f;

__device__ __forceinline__ unsigned cvt_pk_bf16(float lo, float hi) { unsigned r; asm volatile("v_cvt_pk_bf16_f32 %0, %1, %2" : "=v"(r) : "v"(lo), "v"(hi)); return r; }
__device__ __forceinline__ float bf_lo(unsigned w) { return __uint_as_float(w << 16); }
__device__ __forceinline__ float bf_hi(unsigned w) { return __uint_as_float(w & 0xffff0000u); }
__device__ __forceinline__ float sigmoid_f(float v) { return __builtin_amdgcn_rcpf(1.0f + __builtin_amdgcn_exp2f(v * -1.4426950408889634f)); }

namespace pg8 {
constexpr int BM = 256, BK = 64, HALF = 128, HTB = HALF * BK * 2  , STAGE_BYTES = 8 * HTB, NXCD = 8, WGM = 8;

__host__ __device__ __forceinline__ int lds_byte(int r, int c) { const int st = (r >> 4) * 2 + (c >> 5), rr = r & 15, cc = c & 31, ob = rr * 64 + cc * 2; return st * 1024 + (ob ^ (((ob >> 9) & 1) << 5)); }
__host__ __device__ __forceinline__ void stage_rc(int b, int& R, int& C) { const int st = b / 1024, sb = b % 1024, swz = sb ^ (((sb >> 9) & 1) << 5); R = (st >> 1) * 16 + swz / 64; C = (st & 1) * 32 + (swz % 64) / 2; }
__host__ __device__ __forceinline__ int perm32(int rho) { const int n = rho >> 4, i = rho & 15; return 8 * (i >> 2) + 4 * n + (i & 3); }

struct Unit { int pm, pn; };
struct Gemm { const bf16_t* A; const bf16_t* Bt; int M, N, K, lda, ldb, agrp; };

struct StaticOrder {
    int nM, nN, nwg, G, c;
    __host__ __device__ void init(int M, int N, int G_, int c_) { nM = M / BM; nN = N / BM; nwg = nM * nN; G = G_; c = c_; }
    __host__ __device__ bool next(int i, Unit& u) const {
        const long L = (long)i * G + c; if (L >= nwg) return false;
        int wgid = (int)L; { const int q = nwg / NXCD, r = nwg % NXCD, xcd = wgid % NXCD, off = wgid / NXCD; wgid = (xcd < r ? xcd * (q + 1) : r * (q + 1) + (xcd - r) * q) + off; }
        const int nig = WGM * nN, gid = wgid / nig, fm = gid * WGM, gsz = (nM - fm) < WGM ? (nM - fm) : WGM;
        u.pm = fm + ((wgid % nig) % gsz); u.pn = (wgid % nig) / gsz; return true;
    }
    __device__ __forceinline__ void a_ready(const Unit&) const {}
    __device__ __forceinline__ void done(const Unit&) const {}
};

__device__ __forceinline__ u32x4 pack8(const f32x4 v0, const f32x4 v1) { u32x4 w; w.x = cvt_pk_bf16(v0[0], v0[1]); w.y = cvt_pk_bf16(v0[2], v0[3]); w.z = cvt_pk_bf16(v1[0], v1[1]); w.w = cvt_pk_bf16(v1[2], v1[3]); return w; }

struct EpiPlain {
    static constexpr bool PERM = true, AFTER_DRAIN = false;
    bf16_t* O; int ldc;
    __device__ __forceinline__ void operator()(const f32x4 (&acc)[2][2][4][2], const Unit& u, int wr, int wc, int fr, int fq) const {
        const int row0 = u.pm * BM + wr * 64 + fr, col0 = u.pn * BM + wc * 32 + 8 * fq;
#pragma unroll
        for (int ai = 0; ai < 2; ++ai)
#pragma unroll
            for (int m = 0; m < 4; ++m) { bf16_t* rowp = O + (size_t)(row0 + ai * HALF + m * 16) * ldc + col0;
#pragma unroll
                for (int bj = 0; bj < 2; ++bj) *(u32x4*)(rowp + bj * HALF) = pack8(acc[ai][bj][m][0], acc[ai][bj][m][1]); }
    }
};
struct EpiZ {
    static constexpr bool PERM = true, AFTER_DRAIN = false;
    bf16_t *Q, *Kb, *Vb, *U, *GA, *GP;
    __device__ __forceinline__ void operator()(const f32x4 (&acc)[2][2][4][2], const Unit& u, int wr, int wc, int fr, int fq) const {
        const int pn = u.pn; bf16_t* base; int ldc, ct; bool sg = false;
        if (pn < 16)      { base = Q;  ldc = DM;    ct = pn; }
        else if (pn < 20) { base = Kb; ldc = KVW;   ct = pn - 16; }
        else if (pn < 24) { base = Vb; ldc = KVW;   ct = pn - 20; }
        else if (pn < 32) { base = U;  ldc = POOLW; ct = pn - 24; }
        else if (pn < 48) { base = GA; ldc = DM;    ct = pn - 32; sg = true; }
        else              { base = GP; ldc = DM;    ct = pn - 48; sg = true; }
        const int row0 = u.pm * BM + wr * 64 + fr, col0 = ct * BM + wc * 32 + 8 * fq;
#pragma unroll
        for (int ai = 0; ai < 2; ++ai)
#pragma unroll
            for (int m = 0; m < 4; ++m) { bf16_t* rowp = base + (size_t)(row0 + ai * HALF + m * 16) * ldc + col0;
#pragma unroll
                for (int bj = 0; bj < 2; ++bj) { f32x4 v0 = acc[ai][bj][m][0], v1 = acc[ai][bj][m][1];
                    if (sg) {
#pragma unroll
                        for (int j = 0; j < 4; ++j) { v0[j] = sigmoid_f(v0[j]); v1[j] = sigmoid_f(v1[j]); } }
                    *(u32x4*)(rowp + bj * HALF) = pack8(v0, v1); } }
    }
};
struct EpiSwiglu {
    static constexpr bool PERM = true, AFTER_DRAIN = false;
    bf16_t* F; int ldc;
    __device__ __forceinline__ void operator()(const f32x4 (&acc)[2][2][4][2], const Unit& u, int wr, int wc, int fr, int fq) const {
        const int row0 = u.pm * BM + wr * 64 + fr, col0 = u.pn * HALF + wc * 32 + 8 * fq;
#pragma unroll
        for (int ai = 0; ai < 2; ++ai)
#pragma unroll
            for (int m = 0; m < 4; ++m) { bf16_t* rowp = F + (size_t)(row0 + ai * HALF + m * 16) * ldc + col0;
                f32x4 v0, v1;
#pragma unroll
                for (int j = 0; j < 4; ++j) { const float g0 = acc[ai][0][m][0][j], g1 = acc[ai][0][m][1][j];
                    v0[j] = g0 * sigmoid_f(g0) * acc[ai][1][m][0][j]; v1[j] = g1 * sigmoid_f(g1) * acc[ai][1][m][1][j]; }
                *(u32x4*)rowp = pack8(v0, v1); }
    }
};
__device__ __forceinline__ void unpack8(const u32x4 w, f32x4& a, f32x4& b) { a[0] = bf_lo(w.x); a[1] = bf_hi(w.x); a[2] = bf_lo(w.y); a[3] = bf_hi(w.y); b[0] = bf_lo(w.z); b[1] = bf_hi(w.z); b[2] = bf_lo(w.w); b[3] = bf_hi(w.w); }
struct EpiPle {
    static constexpr bool PERM = true, AFTER_DRAIN = false;
    bf16_t* Y; const bf16_t* E; int ldc;
    __device__ __forceinline__ void operator()(const f32x4 (&acc)[2][2][4][2], const Unit& u, int wr, int wc, int fr, int fq) const {
        const int row0 = u.pm * BM + wr * 64 + fr, col0 = u.pn * BM + wc * 32 + 8 * fq;
#pragma unroll
        for (int ai = 0; ai < 2; ++ai)
#pragma unroll
            for (int m = 0; m < 4; ++m) { const size_t off = (size_t)(row0 + ai * HALF + m * 16) * ldc + col0;
#pragma unroll
                for (int bj = 0; bj < 2; ++bj) { const u32x4 ew = *(const u32x4*)(E + off + bj * HALF); f32x4 e0, e1; unpack8(ew, e0, e1);
                    f32x4 v0 = acc[ai][bj][m][0], v1 = acc[ai][bj][m][1];
#pragma unroll
                    for (int j = 0; j < 4; ++j) { v0[j] = sigmoid_f(v0[j]) * e0[j]; v1[j] = sigmoid_f(v1[j]) * e1[j]; }
                    *(u32x4*)(Y + off + bj * HALF) = pack8(v0, v1); }
                asm volatile("" ::: "memory"); }
    }
};
struct EpiPool {
    static constexpr bool PERM = true, AFTER_DRAIN = false;
    bf16_t* MG; const bf16_t *O, *GA, *GP; const float* ps; int ldc;
    __device__ __forceinline__ void operator()(const f32x4 (&acc)[2][2][4][2], const Unit& u, int wr, int wc, int fr, int fq) const {
        const int row0 = u.pm * BM + wr * 64 + fr, col0 = u.pn * BM + wc * 32 + 8 * fq;
        f32x4 pv[2][2];
#pragma unroll
        for (int bj = 0; bj < 2; ++bj)
#pragma unroll
            for (int n = 0; n < 2; ++n) pv[bj][n] = *(const f32x4*)(ps + col0 + bj * HALF + 4 * n);
#pragma unroll
        for (int ai = 0; ai < 2; ++ai)
#pragma unroll
            for (int m = 0; m < 4; ++m) { const size_t off = (size_t)(row0 + ai * HALF + m * 16) * ldc + col0;
#pragma unroll
                for (int bj = 0; bj < 2; ++bj) {
                    const u32x4 ow = *(const u32x4*)(O + off + bj * HALF), aw = *(const u32x4*)(GA + off + bj * HALF), pw = *(const u32x4*)(GP + off + bj * HALF);
                    f32x4 o0, o1, a0, a1, p0, p1; unpack8(ow, o0, o1); unpack8(aw, a0, a1); unpack8(pw, p0, p1);
                    const f32x4 v0 = a0 * o0 + p0 * (acc[ai][bj][m][0] * pv[bj][0]), v1 = a1 * o1 + p1 * (acc[ai][bj][m][1] * pv[bj][1]);
                    *(u32x4*)(MG + off + bj * HALF) = pack8(v0, v1); }
                asm volatile("" ::: "memory"); }
    }
};

template <class Epi, class Sched, bool ALIGN_EPI = false, bool SP2 = false>
__device__ __forceinline__ void gemm_phase(LAS unsigned char* lds, const Gemm g, const Sched& S, const Epi& E) {
    int tid_ = threadIdx.x; asm volatile("" : "+v"(tid_));
    const int tid = tid_, wid = __builtin_amdgcn_readfirstlane(tid >> 6), lane = tid & 63, wr = wid >> 2, wc = wid & 3, fr = lane & 15, fq = lane >> 4;
    const int K = g.K, nt = K / BK;
    unsigned voffA[2], voffB[2];
#pragma unroll
    for (int i = 0; i < 2; ++i) { int R, C; stage_rc(tid * 16 + i * 8192, R, C); const int Rb = Epi::PERM ? ((R & ~31) + perm32(R & 31)) : R;
        voffA[i] = (unsigned)(R * g.lda + C) * 2u; voffB[i] = (unsigned)(Rb * g.ldb + C) * 2u; }
    const size_t kstep = (size_t)(BK * 2);
    const size_t hstepA = (size_t)HALF * g.lda * 2, hstepB = (size_t)HALF * g.ldb * 2;
    const size_t tstepA = 2 * hstepA, tstepB = 2 * hstepB;
    const unsigned ldsw = (unsigned)wid * 1024u;
    const int aoff = lds_byte(wr * 64 + fr, fq * 8), boff = lds_byte(wc * 32 + fr, fq * 8);
#define PG8_SA(b, h) (((b) * 2 + (h)) * HTB)
#define PG8_SB(b, h) ((4 + (b) * 2 + (h)) * HTB)
#define PG8_STAGE(bufoff, gbase, voff) do { _Pragma("unroll") for (int _i = 0; _i < 2; ++_i) \
        __builtin_amdgcn_global_load_lds((const unsigned*)((const char*)(gbase) + (voff)[_i]), (LAS unsigned*)(lds + (bufoff) + ldsw + _i * 8192), 16, 0, 0); } while (0)
#define PG8_LDA(dst, b, h) do { _Pragma("unroll") for (int m = 0; m < 4; ++m) _Pragma("unroll") for (int k = 0; k < 2; ++k) dst[m][k] = *(const LAS bf16x8*)(lds + PG8_SA(b, h) + aoff + m * 2048 + k * 1024); } while (0)
#define PG8_LDB(dst, b, h) do { _Pragma("unroll") for (int n = 0; n < 2; ++n) _Pragma("unroll") for (int k = 0; k < 2; ++k) dst[n][k] = *(const LAS bf16x8*)(lds + PG8_SB(b, h) + boff + n * 2048 + k * 1024); } while (0)
#define PG8_MMA(ai, bj, At, Bt) do { __builtin_amdgcn_s_setprio(1); _Pragma("unroll") for (int m = 0; m < 4; ++m) _Pragma("unroll") for (int n = 0; n < 2; ++n) _Pragma("unroll") for (int k = 0; k < 2; ++k) \
        acc[ai][bj][m][n] = __builtin_amdgcn_mfma_f32_16x16x32_bf16(Bt[n][k], At[m][k], acc[ai][bj][m][n], 0, 0, 0); __builtin_amdgcn_s_setprio(0); } while (0)
#define PG8_WAIT_V(n) asm volatile("s_waitcnt vmcnt(" #n ")" ::: "memory")
#define PG8_WAIT_L(n) asm volatile("s_waitcnt lgkmcnt(" #n ")" ::: "memory")
#define PG8_BAR __builtin_amdgcn_s_barrier()
#define PG8_SCHED __builtin_amdgcn_sched_barrier(0)
    Unit cur, nxt; int ui = 0;
    if (!S.next(0, cur)) return;
    f32x4 acc[2][2][4][2];
#pragma unroll
    for (int a = 0; a < 2; ++a)
#pragma unroll
        for (int b = 0; b < 2; ++b)
#pragma unroll
            for (int m = 0; m < 4; ++m)
#pragma unroll
                for (int n = 0; n < 2; ++n) acc[a][b][m][n] = (f32x4){0.f, 0.f, 0.f, 0.f};
    bf16x8 At[4][2], B0[2][2], B1[2][2];
    const char* cA = (const char*)g.A + (size_t)cur.pm * tstepA + (size_t)(cur.pn >> 2) * g.agrp * 2; const char* cB = (const char*)g.Bt + (size_t)cur.pn * tstepB;
    S.a_ready(cur);
    if constexpr (SP2) {
        PG8_STAGE(PG8_SB(0, 0), cB, voffB); PG8_STAGE(PG8_SB(0, 1), cB + hstepB, voffB); PG8_STAGE(PG8_SA(0, 0), cA, voffA); PG8_STAGE(PG8_SA(0, 1), cA + hstepA, voffA);
        if (wr == 1) PG8_BAR;
        PG8_WAIT_V(2); PG8_BAR;
        PG8_STAGE(PG8_SB(1, 0), cB + kstep, voffB); PG8_STAGE(PG8_SA(1, 0), cA + kstep, voffA); PG8_STAGE(PG8_SB(1, 1), cB + hstepB + kstep, voffB);
        PG8_WAIT_V(6); PG8_BAR;
    } else {
        PG8_STAGE(PG8_SB(0, 0), cB, voffB); PG8_STAGE(PG8_SA(0, 0), cA, voffA); PG8_STAGE(PG8_SB(0, 1), cB + hstepB, voffB); PG8_STAGE(PG8_SA(0, 1), cA + hstepA, voffA);
        if (wr == 1) PG8_BAR;
        PG8_WAIT_V(4); PG8_BAR;
        PG8_STAGE(PG8_SB(1, 0), cB + kstep, voffB); PG8_STAGE(PG8_SA(1, 0), cA + kstep, voffA); PG8_STAGE(PG8_SB(1, 1), cB + hstepB + kstep, voffB);
        PG8_WAIT_V(6); PG8_BAR;
    }
    for (;;) {
        const bool has_next = S.next(ui + 1, nxt);
        const char* nA = has_next ? (const char*)g.A + (size_t)nxt.pm * tstepA + (size_t)(nxt.pn >> 2) * g.agrp * 2 : cA; const char* nB = has_next ? (const char*)g.Bt + (size_t)nxt.pn * tstepB : cB;
        for (int t = 0; t < nt; t += 2) {
            const bool last = (t == nt - 2);
            const char* a1 = cA + (size_t)(t + 1) * kstep;
            const char* a2 = last ? nA : cA + (size_t)(t + 2) * kstep; const char* b2 = last ? nB : cB + (size_t)(t + 2) * kstep;
            const char* a3 = a2 + kstep; const char* b3 = b2 + kstep;
            if (last && has_next) S.a_ready(nxt);
            if constexpr (SP2) {
            PG8_LDB(B0, 0, 0); PG8_LDB(B1, 0, 1); PG8_SCHED; PG8_LDA(At, 0, 0); PG8_STAGE(PG8_SA(1, 1), a1 + hstepA, voffA);
            PG8_WAIT_V(8); PG8_WAIT_L(0); PG8_BAR; PG8_MMA(0, 0, At, B0); PG8_MMA(0, 1, At, B1); PG8_BAR; PG8_SCHED;
            PG8_LDA(At, 0, 1); PG8_STAGE(PG8_SB(0, 0), b2, voffB); PG8_STAGE(PG8_SB(0, 1), b2 + hstepB, voffB); PG8_STAGE(PG8_SA(0, 0), a2, voffA);
            PG8_WAIT_V(8); PG8_WAIT_L(0); PG8_BAR; PG8_MMA(1, 0, At, B0); PG8_MMA(1, 1, At, B1); PG8_BAR; PG8_SCHED;
            PG8_LDB(B0, 1, 0); PG8_LDB(B1, 1, 1); PG8_SCHED; PG8_LDA(At, 1, 0); PG8_STAGE(PG8_SA(0, 1), a2 + hstepA, voffA);
            PG8_WAIT_V(8); PG8_WAIT_L(0); PG8_BAR; PG8_MMA(0, 0, At, B0); PG8_MMA(0, 1, At, B1); PG8_BAR; PG8_SCHED;
            PG8_LDA(At, 1, 1); PG8_STAGE(PG8_SB(1, 0), b3, voffB); PG8_STAGE(PG8_SB(1, 1), b3 + hstepB, voffB); PG8_STAGE(PG8_SA(1, 0), a3, voffA);
            PG8_WAIT_V(8); PG8_WAIT_L(0); PG8_BAR; PG8_MMA(1, 0, At, B0); PG8_MMA(1, 1, At, B1); PG8_BAR; PG8_SCHED;
            } else {
            PG8_LDB(B0, 0, 0); PG8_SCHED; PG8_LDA(At, 0, 0); PG8_STAGE(PG8_SA(1, 1), a1 + hstepA, voffA);
            PG8_WAIT_L(8); PG8_BAR; PG8_WAIT_L(0); PG8_MMA(0, 0, At, B0); PG8_BAR; PG8_SCHED;
            PG8_LDB(B1, 0, 1); PG8_STAGE(PG8_SB(0, 0), b2, voffB);
            PG8_BAR; PG8_WAIT_L(0); PG8_MMA(0, 1, At, B1); PG8_BAR;
            PG8_LDA(At, 0, 1); PG8_STAGE(PG8_SA(0, 0), a2, voffA);
            PG8_BAR; PG8_WAIT_L(0); PG8_MMA(1, 0, At, B0); PG8_BAR; PG8_SCHED;
            PG8_STAGE(PG8_SB(0, 1), b2 + hstepB, voffB);
            PG8_WAIT_V(6); PG8_BAR; PG8_MMA(1, 1, At, B1); PG8_BAR;
            PG8_LDB(B0, 1, 0); PG8_SCHED; PG8_LDA(At, 1, 0); PG8_STAGE(PG8_SA(0, 1), a2 + hstepA, voffA);
            PG8_WAIT_L(8); PG8_BAR; PG8_WAIT_L(0); PG8_MMA(0, 0, At, B0); PG8_BAR; PG8_SCHED;
            PG8_LDB(B1, 1, 1); PG8_STAGE(PG8_SB(1, 0), b3, voffB);
            PG8_BAR; PG8_WAIT_L(0); PG8_MMA(0, 1, At, B1); PG8_BAR;
            PG8_LDA(At, 1, 1); PG8_STAGE(PG8_SA(1, 0), a3, voffA);
            PG8_BAR; PG8_WAIT_L(0); PG8_MMA(1, 0, At, B0); PG8_BAR; PG8_SCHED;
            PG8_STAGE(PG8_SB(1, 1), b3 + hstepB, voffB);
            PG8_WAIT_V(6); PG8_BAR; PG8_MMA(1, 1, At, B1); PG8_BAR;
            }
        }
        if constexpr (ALIGN_EPI) { if (wr == 0) PG8_BAR; }
        E(acc, cur, wr, wc, fr, fq); S.done(cur);
        if (!has_next) break;
#pragma unroll
        for (int a = 0; a < 2; ++a)
#pragma unroll
            for (int b = 0; b < 2; ++b)
#pragma unroll
                for (int m = 0; m < 4; ++m)
#pragma unroll
                    for (int n = 0; n < 2; ++n) acc[a][b][m][n] = (f32x4){0.f, 0.f, 0.f, 0.f};
        cur = nxt; cA = nA; cB = nB; ++ui;
        if constexpr (ALIGN_EPI) { if (wr == 1) PG8_BAR; }
    }
    PG8_WAIT_V(0);
    if constexpr (!ALIGN_EPI) { if (wr == 0) PG8_BAR; }
    PG8_BAR;
#undef PG8_SA
#undef PG8_SB
#undef PG8_STAGE
#undef PG8_LDA
#undef PG8_LDB
#undef PG8_MMA
#undef PG8_WAIT_V
#undef PG8_WAIT_L
#undef PG8_BAR
#undef PG8_SCHED
}
}

namespace att {
constexpr int D = 128, NW = 8, QBLK = 32, KVBLK = 64;
constexpr float SCALE = 0.088388347648318440f;
constexpr float THR = 8.f;
constexpr int LDQ = DM, LDK = KVW, LDO = DM;
constexpr int SHM_V = KVBLK * D * 2, SHM_K = KVBLK * D * 2, SHM_ATTN = 2 * SHM_V + 2 * SHM_K + NW * 64 * 4;
#define KSWZ(row, colB) ((row) * 256 + ((colB) ^ (((row) & 7) << 4)))
#define SBAR() __builtin_amdgcn_sched_barrier(0)
__device__ __forceinline__ int crow(int r, int hi) { return (r & 3) + 8 * (r >> 2) + 4 * hi; }
__device__ __forceinline__ unsigned cvtpk(float lo, float hi) { unsigned r; asm volatile("v_cvt_pk_bf16_f32 %0, %1, %2" : "=v"(r) : "v"(lo), "v"(hi)); return r; }

__device__ __forceinline__ void partialSM(f32x16& p0, f32x16& p1, float& m_reg, float& mn, float& alpha) {
  constexpr float C = SCALE * 1.4426950408889634f;
  float pmax = p0[0];
#pragma unroll
  for (int r = 1; r < 16; ++r) pmax = fmaxf(pmax, p0[r]);
#pragma unroll
  for (int r = 0; r < 16; ++r) pmax = fmaxf(pmax, p1[r]);
  { auto rr = __builtin_amdgcn_permlane32_swap(__float_as_uint(pmax), __float_as_uint(pmax), false, false);
    pmax = fmaxf(__uint_as_float(rr[0]), __uint_as_float(rr[1])); }
  if (__builtin_expect(__all(pmax - m_reg <= THR / SCALE), 1)) { mn = m_reg; alpha = 1.f; }
  else { mn = fmaxf(m_reg, pmax); alpha = __builtin_amdgcn_exp2f((m_reg - mn) * C); m_reg = mn; }
  float mnC = -mn * C;
#pragma unroll
  for (int r = 0; r < 16; ++r) p0[r] = fmaf(p0[r], C, mnC);
#pragma unroll
  for (int r = 0; r < 16; ++r) p1[r] = fmaf(p1[r], C, mnC);
#pragma unroll
  for (int r = 0; r < 16; ++r) p0[r] = __builtin_amdgcn_exp2f(p0[r]);
}
__device__ __forceinline__ void finishSM(f32x16& p0, f32x16& p1, float alpha, float& l_reg, bf16x8& pa0, bf16x8& pa1, bf16x8& pa2, bf16x8& pa3) {
#pragma unroll
  for (int r = 0; r < 16; ++r) p1[r] = __builtin_amdgcn_exp2f(p1[r]);
  float ps = 0;
#pragma unroll
  for (int r = 0; r < 16; ++r) ps += p0[r];
#pragma unroll
  for (int r = 0; r < 16; ++r) ps += p1[r];
  { auto rr = __builtin_amdgcn_permlane32_swap(__float_as_uint(ps), __float_as_uint(ps), false, false);
    ps = __uint_as_float(rr[0]) + __uint_as_float(rr[1]); }
  l_reg = l_reg * alpha + ps;
#define PK4(P, BASE, OUT) do { unsigned a0 = cvtpk(P[BASE + 0], P[BASE + 1]), a1 = cvtpk(P[BASE + 2], P[BASE + 3]);   \
    unsigned b0 = cvtpk(P[BASE + 4], P[BASE + 5]), b1 = cvtpk(P[BASE + 6], P[BASE + 7]);                              \
    auto r0 = __builtin_amdgcn_permlane32_swap(a0, b0, false, false); auto r1 = __builtin_amdgcn_permlane32_swap(a1, b1, false, false); \
    u32x4 w = {r0[0], r1[0], r0[1], r1[1]}; OUT = *reinterpret_cast<bf16x8*>(&w); } while (0)
  PK4(p0, 0, pa0); PK4(p0, 8, pa1); PK4(p1, 0, pa2); PK4(p1, 8, pa3);
#undef PK4
}
__device__ __forceinline__ void qkt(f32x16& p0, f32x16& p1, const LAS char* Ks, const bf16x8* qr, int r32, int hi) {
  p0 = f32x16{}; p1 = f32x16{};
#pragma unroll
  for (int d0 = 0; d0 < 8; ++d0) { int cb = (d0 * 16 + hi * 8) * 2;
    bf16x8 b0 = *reinterpret_cast<const LAS bf16x8*>(Ks + KSWZ(r32, cb));
    bf16x8 b1 = *reinterpret_cast<const LAS bf16x8*>(Ks + KSWZ(32 + r32, cb));
    p0 = __builtin_amdgcn_mfma_f32_32x32x16_bf16(b0, qr[d0], p0, 0, 0, 0);
    p1 = __builtin_amdgcn_mfma_f32_32x32x16_bf16(b1, qr[d0], p1, 0, 0, 0); }
}
__device__ __forceinline__ int v_st(int k, int c) { const int kk = (k & ~0xC) | ((k & 4) << 1) | ((k & 8) >> 1); return ((kk >> 3) * 4 + (c >> 5)) * 512 + ((kk & 7) * 32 + (c & 31)) * 2; }
__device__ __forceinline__ int v_rd_base(int lane) { return ((lane & 3) << 3) | (((lane >> 2) & 3) << 6) | (((lane >> 4) & 1) << 5) | (((lane >> 5) & 1) << 8); }
constexpr int v_rd_off(int d0, int ks, int half) { return d0 * 512 + ks * 4096 + half * 2048; }
template <int OFF> __device__ __forceinline__ s16x4 tr_read(int vb) {
  s16x4 r; asm volatile("ds_read_b64_tr_b16 %0, %1 offset:%2" : "=&v"(r) : "v"(vb), "i"(OFF) : "memory"); return r;
}
template <int D0> __device__ __forceinline__ void pv_one(f32x16& od, int vb, bf16x8 pa0, bf16x8 pa1, bf16x8 pa2, bf16x8 pa3) {
  const s16x4 l0 = tr_read<v_rd_off(D0, 0, 0)>(vb), h0 = tr_read<v_rd_off(D0, 0, 1)>(vb), l1 = tr_read<v_rd_off(D0, 1, 0)>(vb), h1 = tr_read<v_rd_off(D0, 1, 1)>(vb);
  const s16x4 l2 = tr_read<v_rd_off(D0, 2, 0)>(vb), h2 = tr_read<v_rd_off(D0, 2, 1)>(vb), l3 = tr_read<v_rd_off(D0, 3, 0)>(vb), h3 = tr_read<v_rd_off(D0, 3, 1)>(vb);
  asm volatile("s_waitcnt lgkmcnt(0)" ::: "memory"); SBAR();
#define PK(L, H) (bf16x8){L[0], L[1], L[2], L[3], H[0], H[1], H[2], H[3]}
  od = __builtin_amdgcn_mfma_f32_32x32x16_bf16(pa0, PK(l0, h0), od, 0, 0, 0);
  od = __builtin_amdgcn_mfma_f32_32x32x16_bf16(pa1, PK(l1, h1), od, 0, 0, 0);
  od = __builtin_amdgcn_mfma_f32_32x32x16_bf16(pa2, PK(l2, h2), od, 0, 0, 0);
  od = __builtin_amdgcn_mfma_f32_32x32x16_bf16(pa3, PK(l3, h3), od, 0, 0, 0);
#undef PK
}
__device__ __forceinline__ void pv_d0(f32x16* o, int vb, bf16x8 pa0, bf16x8 pa1, bf16x8 pa2, bf16x8 pa3) {
  pv_one<0>(o[0], vb, pa0, pa1, pa2, pa3); pv_one<1>(o[1], vb, pa0, pa1, pa2, pa3); pv_one<2>(o[2], vb, pa0, pa1, pa2, pa3); pv_one<3>(o[3], vb, pa0, pa1, pa2, pa3);
}
__device__ __forceinline__ void attn_dense_body(const bf16_t* __restrict__ Qb, const bf16_t* __restrict__ Kh, const bf16_t* __restrict__ Vh, bf16_t* __restrict__ Ob, int seq, LAS char* lds) {
  int tid_ = threadIdx.x; asm volatile("" : "+v"(tid_));
  const int tid = tid_, wid = tid >> 6, lane = tid & 63, r32 = lane & 31, hi = lane >> 5;
  LAS char* V_lds = lds; LAS char* K_lds = lds + 2 * SHM_V;
  LAS float* ws = (LAS float*)(lds + 2 * SHM_V + 2 * SHM_K) + wid * 64; LAS float* li_l = ws; LAS float* al_l = ws + 32;
  float m_reg = -1e30f, l_reg = 0; f32x16 o[4] = {}; bf16x8 qr[8];
  const bf16_t* Qw = Qb + (long)(wid * QBLK + r32) * LDQ + hi * 8;
#pragma unroll
  for (int d0 = 0; d0 < 8; ++d0) qr[d0] = *reinterpret_cast<const bf16x8*>(Qw + d0 * 16);
  const int sr = tid >> 4, sc = (tid & 15) * 8, vst0 = v_st(sr, sc), vst1 = v_st(32 + sr, sc);
  const int vb0 = (int)(unsigned)(uintptr_t)V_lds + v_rd_base(lane);
  struct { bf16x8 vs0, vs1, ks0, ks1; } sr_[2];
#define SLOAD(i, k0) do { sr_[i].vs0 = *reinterpret_cast<const bf16x8*>(&Vh[(long)((k0) + sr) * LDK + sc]); sr_[i].vs1 = *reinterpret_cast<const bf16x8*>(&Vh[(long)((k0) + 32 + sr) * LDK + sc]); \
    sr_[i].ks0 = *reinterpret_cast<const bf16x8*>(&Kh[(long)((k0) + sr) * LDK + sc]); sr_[i].ks1 = *reinterpret_cast<const bf16x8*>(&Kh[(long)((k0) + 32 + sr) * LDK + sc]); } while (0)
#define SWRITE(b, i) do { *(LAS bf16x8*)(V_lds + (b) * SHM_V + vst0) = sr_[i].vs0;          \
    *(LAS bf16x8*)(V_lds + (b) * SHM_V + vst1) = sr_[i].vs1; int kc = sc * 2;               \
    *(LAS bf16x8*)(K_lds + (b) * SHM_K + KSWZ(sr, kc)) = sr_[i].ks0;                       \
    *(LAS bf16x8*)(K_lds + (b) * SHM_K + KSWZ(32 + sr, kc)) = sr_[i].ks1; } while (0)
#define SWAIT() asm volatile("s_waitcnt vmcnt(4)" ::: "memory")
#define RESC(a) do { if (__any((a) < 1.f)) { if (hi == 0) al_l[r32] = (a); asm volatile("s_waitcnt lgkmcnt(0)" ::: "memory"); \
    _Pragma("unroll") for (int d = 0; d < 4; ++d) _Pragma("unroll") for (int r = 0; r < 16; ++r) o[d][r] *= al_l[crow(r, hi)]; } } while (0)
  f32x16 pA0, pA1, pB0, pB1; float mnA, mnB, alA, alB; bf16x8 pa0, pa1, pa2, pa3; const int NT = seq / KVBLK;
  constexpr int SE = 0, SO = 1;
  SLOAD(SE, 0); asm volatile("s_waitcnt vmcnt(0)" ::: "memory"); SWRITE(0, SE); __syncthreads();
  qkt(pA0, pA1, K_lds, qr, r32, hi); partialSM(pA0, pA1, m_reg, mnA, alA);
  SLOAD(SO, KVBLK); if (2 < NT) SLOAD(SE, 2 * KVBLK);
  SWAIT(); SWRITE(1, SO); __syncthreads();
  for (int j = 1; j + 1 < NT; j += 2) {
    SBAR(); qkt(pB0, pB1, K_lds + SHM_K, qr, r32, hi);
    finishSM(pA0, pA1, alA, l_reg, pa0, pa1, pa2, pa3); SBAR();
    SLOAD(SO, (j + 2) * KVBLK); SBAR();
    pv_d0(o, vb0, pa0, pa1, pa2, pa3); partialSM(pB0, pB1, m_reg, mnB, alB);
    __syncthreads(); SWAIT(); SWRITE(0, SE);
    RESC(alB); __syncthreads();
    SBAR(); qkt(pA0, pA1, K_lds, qr, r32, hi);
    finishSM(pB0, pB1, alB, l_reg, pa0, pa1, pa2, pa3); SBAR();
    if (j + 3 < NT) SLOAD(SE, (j + 3) * KVBLK); SBAR();
    pv_d0(o, vb0 + SHM_V, pa0, pa1, pa2, pa3); partialSM(pA0, pA1, m_reg, mnA, alA);
    __syncthreads(); SWAIT(); SWRITE(1, SO);
    RESC(alA); __syncthreads();
  }
  SBAR(); qkt(pB0, pB1, K_lds + SHM_K, qr, r32, hi);
  finishSM(pA0, pA1, alA, l_reg, pa0, pa1, pa2, pa3); SBAR();
  pv_d0(o, vb0, pa0, pa1, pa2, pa3); partialSM(pB0, pB1, m_reg, mnB, alB);
  __syncthreads(); RESC(alB);
  finishSM(pB0, pB1, alB, l_reg, pa0, pa1, pa2, pa3); SBAR();
  pv_d0(o, vb0 + SHM_V, pa0, pa1, pa2, pa3);
  if (hi == 0) li_l[r32] = l_reg; asm volatile("s_waitcnt lgkmcnt(0)" ::: "memory");
  float rli[16];
#pragma unroll
  for (int r = 0; r < 16; ++r) rli[r] = __builtin_amdgcn_rcpf(li_l[crow(r, hi)]);
  bf16_t* Ow = Ob + (long)(wid * QBLK) * LDO;
#pragma unroll
  for (int r = 0; r < 16; ++r) { const int orow = crow(r, hi);
#pragma unroll
    for (int d0 = 0; d0 < 4; ++d0) { const unsigned w = cvtpk(o[d0][r] * rli[r], 0.f); Ow[(long)orow * LDO + d0 * 32 + r32] = (bf16_t)(w & 0xffffu); } }
#undef SLOAD
#undef SWRITE
#undef SWAIT
#undef RESC
}
#undef SBAR
}

constexpr int NWAVES = 8;
constexpr int N_PHASES = 1 + 11 * DEPTH;
constexpr int N_LAUNCHES = MK_N_LAUNCHES;
static_assert(N_LAUNCHES == 1 || N_LAUNCHES == N_PHASES, "MK_N_LAUNCHES is 1 or 23");

constexpr size_t MiB = 1u << 20;
constexpr size_t WS_CTL = 0, CTL_ZERO_BYTES = 1 * MiB;
constexpr size_t WS_ROPE = 1 * MiB;
constexpr size_t WS_PB = 2 * MiB;
constexpr size_t WS_W = 16 * MiB;
constexpr size_t LW_IN = 0, LW_POOL = 128 * MiB, LW_OUT = 132 * MiB, LW_GU = 164 * MiB, LW_DOWN = 336 * MiB, LW_PIN = 422 * MiB, LW_PG = 424 * MiB, LW_BYTES = 456 * MiB;
constexpr size_t WS_ACT = WS_W + 2 * LW_BYTES;
constexpr size_t WS_H = WS_ACT;
constexpr size_t WS_Q = WS_H + 64 * MiB;
constexpr size_t WS_K = WS_Q + 64 * MiB;
constexpr size_t WS_V = WS_K + 16 * MiB;
constexpr size_t WS_U = WS_V + 16 * MiB;
constexpr size_t WS_GA = WS_U + 32 * MiB;
constexpr size_t WS_GP = WS_GA + 64 * MiB;
constexpr size_t WS_Q2 = WS_GP + 64 * MiB;
constexpr size_t WS_K2 = WS_Q2 + 64 * MiB;
constexpr size_t WS_DL = WS_K2 + 16 * MiB;
constexpr size_t WS_O = WS_DL + 32 * MiB;
constexpr size_t WS_MG = WS_O + 64 * MiB;
constexpr size_t WS_Y = WS_MG + 64 * MiB;
constexpr size_t WS_F = WS_Y + 64 * MiB;
constexpr size_t WS_E = WS_F + 172 * MiB;
constexpr size_t WS_END = WS_E + 128 * MiB;
static_assert(WS_END <= 2048 * MiB, "workspace map");

constexpr int CW_TMO = 0, CW_CODE = 1;
constexpr int CW_BAR = 4096;

constexpr int RING_OFF = 0, RING_BYTES = 131072;
constexpr int LDSCTL_OFF = RING_BYTES, MISC_OFF = LDSCTL_OFF + 320;
constexpr int LDS_BYTES = 147456;

typedef GAS unsigned gu32;
#define RLX_AGENT __ATOMIC_RELAXED, __HIP_MEMORY_SCOPE_AGENT
#define LDS_WAIT() asm volatile("s_waitcnt lgkmcnt(0)" ::: "memory")
#define VM_WAIT() asm volatile("s_waitcnt vmcnt(0)" ::: "memory")
__device__ __forceinline__ unsigned f2bf(float f) { unsigned u = __builtin_bit_cast(unsigned, f); return (u + 0x7fffu + ((u >> 16) & 1u)) >> 16; }
__device__ __forceinline__ unsigned pk2(float lo, float hi) { return f2bf(lo) | (f2bf(hi) << 16); }

#define XB_TMO      128
#define XB_XCNT(j)  (256  + 64 * (j))
#define XB_XSUB(j)  (1280 + 64 * (j))
#define XB_XGEN(j)  (2304 + 64 * (j))
#define XB_TOP      3328
#define XB_TOPGEN   3392
#define XCD_BAR_WORDS 3456
#define XB_SPIN_CAP (1u << 18)

__device__ __forceinline__ unsigned xb_ld(unsigned* p)              { return __hip_atomic_load(p, __ATOMIC_RELAXED, __HIP_MEMORY_SCOPE_AGENT); }
__device__ __forceinline__ unsigned xb_add(unsigned* p, unsigned v) { return __hip_atomic_fetch_add(p, v, __ATOMIC_RELAXED, __HIP_MEMORY_SCOPE_AGENT); }
__device__ __forceinline__ unsigned xb_xcc_id() { return (unsigned)__builtin_amdgcn_s_getreg((3 << 11) | 20) & 0xFu; }
#define XB_SPIN(cond, bar) do { unsigned _sp = 0; while (cond) { __builtin_amdgcn_s_sleep(1); \
    if ((++_sp & 255u) == 0u) { if (xb_ld(&(bar)[XB_TMO])) break; if (_sp > XB_SPIN_CAP) { atomicAdd(&(bar)[XB_TMO], 1u); break; } } } } while (0)

struct XcdBarrier {
    unsigned* bar; unsigned x;
    volatile LAS unsigned* st;
};
__device__ __forceinline__ XcdBarrier xcd_barrier_post(unsigned* bar, volatile LAS unsigned* st) {
    XcdBarrier b; b.bar = bar; b.x = xb_xcc_id(); b.st = st;
    if (threadIdx.x == 0) (void)xb_add(&bar[XB_XCNT(b.x)], 1u);
    return b;
}
__device__ __forceinline__ void xcd_barrier_complete(unsigned* bar, unsigned x, unsigned& nloc, unsigned& nx) {
    const unsigned G = gridDim.x * gridDim.y * gridDim.z;
    unsigned sum, cnt, mine, sp = 0u;
    for (;;) {
        sum = 0u; cnt = 0u; mine = 0u;
#pragma unroll
        for (unsigned j = 0; j < 16; ++j) { const unsigned c = xb_ld(&bar[XB_XCNT(j)]); sum += c; cnt += (c > 0u) ? 1u : 0u; mine = (j == x) ? c : mine; }
        if (sum == G) break;
        __builtin_amdgcn_s_sleep(1);
        if ((++sp & 255u) == 0u) { if (xb_ld(&bar[XB_TMO])) break; if (sp > XB_SPIN_CAP) { atomicAdd(&bar[XB_TMO], 1u); break; } }
    }
    nloc = mine > 0u ? mine : 1u; nx = cnt > 0u ? cnt : 1u;
}
__device__ __forceinline__ void xcd_barrier(const XcdBarrier& b) {
    asm volatile("s_waitcnt vmcnt(0)" ::: "memory");
    __syncthreads();
    if (threadIdx.x == 0) {
        unsigned* bar = b.bar; asm volatile("" : "+s"(bar));
        __builtin_amdgcn_s_waitcnt(0);
        unsigned nloc = b.st[0], nx = b.st[1];
        if (nloc == 0u) { xcd_barrier_complete(bar, b.x, nloc, nx); b.st[0] = nloc; b.st[1] = nx; }
        const unsigned old = xb_add(&bar[XB_XSUB(b.x)], 1u);
        const unsigned gen = old / nloc;
        if (old + 1u == (gen + 1u) * nloc) {
            __builtin_amdgcn_fence(__ATOMIC_RELEASE, "agent");
            asm volatile("s_waitcnt vmcnt(0)" ::: "memory");
            const unsigned og = xb_add(&bar[XB_TOP], 1u);
            const unsigned tg = og / nx;
            if (og + 1u == (tg + 1u) * nx) xb_add(&bar[XB_TOPGEN], 1u);
            else XB_SPIN(xb_ld(&bar[XB_TOPGEN]) == tg, bar);
            __builtin_amdgcn_fence(__ATOMIC_ACQUIRE, "agent");
            xb_add(&bar[XB_XGEN(b.x)], 1u);
            asm volatile("s_waitcnt vmcnt(0)" ::: "memory");
        } else {
            XB_SPIN(xb_ld(&bar[XB_XGEN(b.x)]) == gen, bar);
            __builtin_amdgcn_fence(__ATOMIC_ACQUIRE, "agent");
            asm volatile("s_waitcnt vmcnt(0)" ::: "memory");
        }
    }
    __syncthreads();
}

struct Frame {
    LAS unsigned char* lds;
    int tid, lane, wave;
    int vcu, G, bx;
};
__device__ __forceinline__ Frame make_frame(LAS unsigned char* lds) {
    Frame F; int t = threadIdx.x; asm volatile("" : "+v"(t)); int bx = blockIdx.x; asm volatile("" : "+s"(bx)); int G = gridDim.x; asm volatile("" : "+s"(G));
    F.lds = lds; F.tid = t; F.lane = t & 63; F.wave = __builtin_amdgcn_readfirstlane(t >> 6); F.G = G; F.bx = bx;
    F.vcu = (G % 8 == 0) ? (bx % 8) * (G / 8) + bx / 8 : bx;
    return F;
}

__device__ __forceinline__ float wave_sum(float v) {
#pragma unroll
    for (int o = 1; o < 64; o <<= 1) v += __shfl_xor(v, o);
    return v;
}

template <int MAP>
__device__ __forceinline__ void p0_transpose_item(const float* W, int K, int N, bf16_t* WT, int row_off, LAS float* scr, int item, int lane) {
    const int nblk = N / 32, kb = item / nblk, nb = item % nblk, k0 = 64 * kb, n0 = 32 * nb;
    const int r0 = (MAP == 0) ? (row_off + n0) : (256 * (n0 >> 7) + (n0 & 127) + row_off);
#pragma unroll 8
    for (int i = 0; i < 32; ++i) { const int kk = 2 * i + (lane >> 5); scr[kk * 33 + (lane & 31)] = W[(size_t)(k0 + kk) * N + n0 + (lane & 31)]; }
    LDS_WAIT(); asm volatile("" ::: "memory");
    const int c = lane & 7;
#pragma unroll
    for (int j = 0; j < 4; ++j) { const int n = (lane >> 3) + 8 * j; const LAS float* s = scr + (8 * c) * 33 + n;
        u32x4 o; o.x = pk2(s[0 * 33], s[1 * 33]); o.y = pk2(s[2 * 33], s[3 * 33]); o.z = pk2(s[4 * 33], s[5 * 33]); o.w = pk2(s[6 * 33], s[7 * 33]);
        *(GAS u32x4*)(WT + (size_t)(r0 + n) * K + k0 + 8 * c) = o; }
    LDS_WAIT(); asm volatile("" ::: "memory");
}

struct Args { const float* in[18]; float* out; unsigned char* ws; int ph_lo, ph_hi; };

__device__ __forceinline__ void norm_row(int lane, const float* xin, float* xout, const bf16_t* y, const LAS float* gpost, const LAS float* gpre, bf16_t* h, int hmode) {
    const GAS f32x4* xr = (const GAS f32x4*)xin + lane;
    f32x4 v[16];
#pragma unroll
    for (int j = 0; j < 16; ++j) v[j] = xr[64 * j];
    if (y) {
        const GAS u32x2* yr = (const GAS u32x2*)y + lane; f32x4 yv[16]; float s = 0.f;
#pragma unroll
        for (int j = 0; j < 16; ++j) { const u32x2 w = yr[64 * j]; yv[j] = (f32x4){bf_lo(w.x), bf_hi(w.x), bf_lo(w.y), bf_hi(w.y)}; s += (yv[j].x * yv[j].x + yv[j].y * yv[j].y) + (yv[j].z * yv[j].z + yv[j].w * yv[j].w); }
        const float rstd = 1.0f / sqrtf(wave_sum(s) * (1.f / DM) + EPS);
#pragma unroll
        for (int j = 0; j < 16; ++j) { const f32x4 g = *(const LAS f32x4*)(gpost + 4 * lane + 256 * j); v[j] = v[j] + yv[j] * rstd * g; }
    }
    if (xout) { GAS f32x4* xo = (GAS f32x4*)xout + lane;
#pragma unroll
        for (int j = 0; j < 16; ++j) xo[64 * j] = v[j]; }
    if (hmode) {
        float rstd = 1.f;
        if (hmode == 2) { float s = 0.f;
#pragma unroll
            for (int j = 0; j < 16; ++j) s += (v[j].x * v[j].x + v[j].y * v[j].y) + (v[j].z * v[j].z + v[j].w * v[j].w);
            rstd = 1.0f / sqrtf(wave_sum(s) * (1.f / DM) + EPS); }
        GAS u32x2* ho = (GAS u32x2*)h + lane;
#pragma unroll
        for (int j = 0; j < 16; ++j) { f32x4 t = v[j] * rstd; if (hmode == 2) { const f32x4 g = *(const LAS f32x4*)(gpre + 4 * lane + 256 * j); t = t * g; }
            u32x2 w; w.x = cvt_pk_bf16(t.x, t.y); w.y = cvt_pk_bf16(t.z, t.w); ho[64 * j] = w; }
    }
}
__device__ __forceinline__ void norm_pass(Frame& F, const float* xin, float* xout, const bf16_t* y, const float* gpost, const float* gpre, bf16_t* h, int hmode) {
    LAS float* gl = (LAS float*)(F.lds + RING_OFF);
    __syncthreads();
    for (int i = F.tid; i < DM; i += NWAVES * 64) { gl[i] = gpost ? gpost[i] : 0.f; gl[DM + i] = gpre ? gpre[i] : 0.f; }
    __syncthreads();
    const int gw = F.vcu * NWAVES + F.wave, NGW = F.G * NWAVES;
    for (int m = gw; m < S; m += NGW)
        norm_row(F.lane, xin + (size_t)m * DM, xout ? xout + (size_t)m * DM : nullptr, y ? y + (size_t)m * DM : nullptr, gl, gl + DM, h ? h + (size_t)m * DM : nullptr, hmode);
    __syncthreads();
}

__device__ __forceinline__ void qk_norm_rope_pass(Frame& F, const bf16_t* Qr, const bf16_t* Kr, bf16_t* Q2, bf16_t* K2, const float* qn, const float* kn, const float* rope) {
    const int gw = F.vcu * NWAVES + F.wave, NGW = F.G * NWAVES;
    const int g16 = F.lane >> 4, s = F.lane & 15;
    constexpr int NITEM = S * (NH + NKV);
    const int dsub = 8 * s;
    const int axis = s >> 3, half = (s >> 2) & 1, i0 = 8 * (s & 3);
    for (int it = 4 * gw + g16; it < NITEM; it += 4 * NGW) {
        const int row = it / (NH + NKV), hh = it % (NH + NKV);
        const bool isq = hh < NH;
        const bf16_t* src = isq ? Qr + (size_t)row * DM + hh * HD + dsub : Kr + (size_t)row * KVW + (hh - NH) * HD + dsub;
        bf16_t* dst = isq ? Q2 + (size_t)row * DM + hh * HD + dsub : K2 + (size_t)row * KVW + (hh - NH) * HD + dsub;
        const float* gn = isq ? qn : kn;
        const u32x4 w = *(const GAS u32x4*)src;
        float x[8] = {bf_lo(w.x), bf_hi(w.x), bf_lo(w.y), bf_hi(w.y), bf_lo(w.z), bf_hi(w.z), bf_lo(w.w), bf_hi(w.w)};
        float ss = 0.f;
#pragma unroll
        for (int j = 0; j < 8; ++j) ss += x[j] * x[j];
        ss += __shfl_xor(ss, 1); ss += __shfl_xor(ss, 2); ss += __shfl_xor(ss, 4); ss += __shfl_xor(ss, 8);
        const float rstd = 1.0f / sqrtf(ss * (1.f / HD) + EPS);
        const f32x4 ga = *(const f32x4*)(gn + dsub), gb = *(const f32x4*)(gn + dsub + 4);
        const float g[8] = {ga.x, ga.y, ga.z, ga.w, gb.x, gb.y, gb.z, gb.w};
#pragma unroll
        for (int j = 0; j < 8; ++j) x[j] = x[j] * rstd * g[j];
        float xp[8];
#pragma unroll
        for (int j = 0; j < 8; ++j) xp[j] = __shfl_xor(x[j], 4);
        const int pos = axis ? (row & 63) : (row >> 6);
        const f32x4* tp = (const f32x4*)(rope + ((size_t)pos * 32 + i0) * 2);
        float o[8];
#pragma unroll
        for (int jj = 0; jj < 4; ++jj) { const f32x4 cs = tp[jj];
            o[2 * jj]     = half ? (x[2 * jj] * cs.x + xp[2 * jj] * cs.y)         : (x[2 * jj] * cs.x - xp[2 * jj] * cs.y);
            o[2 * jj + 1] = half ? (x[2 * jj + 1] * cs.z + xp[2 * jj + 1] * cs.w) : (x[2 * jj + 1] * cs.z - xp[2 * jj + 1] * cs.w); }
        u32x4 ow; ow.x = cvt_pk_bf16(o[0], o[1]); ow.y = cvt_pk_bf16(o[2], o[3]); ow.z = cvt_pk_bf16(o[4], o[5]); ow.w = cvt_pk_bf16(o[6], o[7]);
        *(GAS u32x4*)dst = ow;
    }
}
__device__ __forceinline__ void pool_delta_pass(Frame& F, const bf16_t* U, bf16_t* DL) {
    const int gt = F.vcu * (NWAVES * 64) + F.tid, NT = F.G * NWAVES * 64;
    for (int it = gt; it < S * (POOLW / 8); it += NT) {
        const int t = it >> 8, c = it & 255, g = c >> 6, hw = 1 << g;
        const int lo = (t - hw) < 0 ? 0 : (t - hw), hi = (t + hw) > S ? S : (t + hw);
        float acc[8] = {0.f, 0.f, 0.f, 0.f, 0.f, 0.f, 0.f, 0.f};
        for (int r = lo; r < hi; ++r) { const u32x4 w = *(const GAS u32x4*)(U + (size_t)r * POOLW + 8 * c);
            acc[0] += bf_lo(w.x); acc[1] += bf_hi(w.x); acc[2] += bf_lo(w.y); acc[3] += bf_hi(w.y); acc[4] += bf_lo(w.z); acc[5] += bf_hi(w.z); acc[6] += bf_lo(w.w); acc[7] += bf_hi(w.w); }
        const u32x4 w = *(const GAS u32x4*)(U + (size_t)t * POOLW + 8 * c);
        const float inv = 1.0f / (float)(hi - lo);
        const float me[8] = {bf_lo(w.x), bf_hi(w.x), bf_lo(w.y), bf_hi(w.y), bf_lo(w.z), bf_hi(w.z), bf_lo(w.w), bf_hi(w.w)};
        float d[8];
#pragma unroll
        for (int j = 0; j < 8; ++j) d[j] = acc[j] * inv - me[j];
        u32x4 ow; ow.x = cvt_pk_bf16(d[0], d[1]); ow.y = cvt_pk_bf16(d[2], d[3]); ow.z = cvt_pk_bf16(d[4], d[5]); ow.w = cvt_pk_bf16(d[6], d[7]);
        *(GAS u32x4*)(DL + (size_t)t * POOLW + 8 * c) = ow;
    }
}

__device__ __forceinline__ double inv_freq_of(int i) {
    const double step = 0.74989420933245582730;
    double r = 1.0; for (int k = 0; k < i; ++k) r *= step; return r;
}

typedef const __attribute__((address_space(4))) Args CArgs;
__device__ __forceinline__ CArgs* fresh_args() { CArgs* p = (CArgs*)__builtin_amdgcn_kernarg_segment_ptr(); asm volatile("" : "+s"(p)); return p; }
#define WSP(off) ((bf16_t*)(ws + (off)))

__global__ void __launch_bounds__(NWAVES * 64, 2) fwd_kernel(Args args) {
    extern __shared__ __attribute__((aligned(16))) unsigned char lds[];
    LAS unsigned char* const L = (LAS unsigned char*)lds;
    for (int u = threadIdx.x; u < (LDS_BYTES - LDSCTL_OFF) / 4; u += NWAVES * 64) ((LAS unsigned*)(L + LDSCTL_OFF))[u] = 0u;
    __syncthreads();
    unsigned* const barw = (unsigned*)(args.ws + WS_CTL) + CW_BAR;
    XcdBarrier bar; bar.bar = barw; bar.x = 0; bar.st = nullptr;
    if (N_LAUNCHES == 1) bar = xcd_barrier_post(barw, (volatile LAS unsigned*)(L + MISC_OFF) + 8);
#define GRID_BAR() do { if (N_LAUNCHES == 1) xcd_barrier(bar); } while (0)
    const int lo = args.ph_lo, hi = args.ph_hi;
#define IN(k) (lo <= (k) && (k) < hi)
#define SEAM(k) do { if (IN(k) && IN((k) + 1)) GRID_BAR(); } while (0)

    if (IN(0)) {
        CArgs* ap = fresh_args(); unsigned char* ws = ap->ws; Frame F = make_frame(L);
        LAS float* scr = (LAS float*)(F.lds + RING_OFF + F.wave * 16384);
        const int gw = F.vcu * NWAVES + F.wave, NGW = F.G * NWAVES;
        constexpr int I_IN = (DM / 64) * (INW / 32), I_POOL = (PGI / 64) * (PGO / 32), I_OUT = (DM / 64) * (DM / 32), I_GU = (DM / 64) * (FF / 32), I_DOWN = (FF / 64) * (DM / 32), I_PIN = (DPLE / 64) * (DM / 32);
        constexpr int I_LAYER = I_IN + 4 * I_POOL + I_OUT + 2 * I_GU + I_DOWN + I_PIN + I_OUT;
        for (int it = gw; it < DEPTH * I_LAYER; it += NGW) {
            const int l = it / I_LAYER; int r = it % I_LAYER;
            unsigned char* wl = ws + WS_W + (size_t)l * LW_BYTES;
            if (r < I_IN) { p0_transpose_item<0>(ap->in[2] + (size_t)l * DM * INW, DM, INW, (bf16_t*)(wl + LW_IN), 0, scr, r, F.lane); continue; } r -= I_IN;
            if (r < 4 * I_POOL) { const int g = r / I_POOL; p0_transpose_item<0>(ap->in[5] + ((size_t)l * 4 + g) * PGI * PGO, PGI, PGO, (bf16_t*)(wl + LW_POOL), g * PGO, scr, r % I_POOL, F.lane); continue; } r -= 4 * I_POOL;
            if (r < I_OUT) { p0_transpose_item<0>(ap->in[7] + (size_t)l * DM * DM, DM, DM, (bf16_t*)(wl + LW_OUT), 0, scr, r, F.lane); continue; } r -= I_OUT;
            if (r < I_GU) { p0_transpose_item<1>(ap->in[12] + (size_t)l * DM * FF, DM, FF, (bf16_t*)(wl + LW_GU), 0, scr, r, F.lane); continue; } r -= I_GU;
            if (r < I_GU) { p0_transpose_item<1>(ap->in[13] + (size_t)l * DM * FF, DM, FF, (bf16_t*)(wl + LW_GU), 128, scr, r, F.lane); continue; } r -= I_GU;
            if (r < I_DOWN) { p0_transpose_item<0>(ap->in[14] + (size_t)l * FF * DM, FF, DM, (bf16_t*)(wl + LW_DOWN), 0, scr, r, F.lane); continue; } r -= I_DOWN;
            if (r < I_PIN) { p0_transpose_item<0>(ap->in[15] + (size_t)l * DPLE * DM, DPLE, DM, (bf16_t*)(wl + LW_PIN), 0, scr, r, F.lane); continue; } r -= I_PIN;
            p0_transpose_item<0>(ap->in[16] + (size_t)l * DM * DM, DM, DM, (bf16_t*)(wl + LW_PG), 0, scr, r, F.lane);
        }
        { const int gt = F.vcu * (NWAVES * 64) + F.tid, NT = F.G * NWAVES * 64;
          const float* p_in = ap->in[1]; bf16_t* PB = WSP(WS_PB); float* rope = (float*)(ws + WS_ROPE);
          for (int i = gt; i < DEPTH * S * DPLE / 8; i += NT) { const f32x4 a = *(const GAS f32x4*)(p_in + (size_t)i * 8), b = *(const GAS f32x4*)(p_in + (size_t)i * 8 + 4);
              u32x4 o; o.x = cvt_pk_bf16(a.x, a.y); o.y = cvt_pk_bf16(a.z, a.w); o.z = cvt_pk_bf16(b.x, b.y); o.w = cvt_pk_bf16(b.z, b.w); *(GAS u32x4*)(PB + (size_t)i * 8) = o; }
          for (int i = gt; i < 128 * 32; i += NT) { const int pos = i >> 5, fi = i & 31;
              const double ang = (double)pos * inv_freq_of(fi); const double k = __builtin_rint(ang * 0.15915494309189533577); const double r = ang - k * 6.283185307179586476925;
              const float rf = (float)r; rope[2 * i] = cosf(rf); rope[2 * i + 1] = sinf(rf); }
        }
        norm_pass(F, ap->in[0], nullptr, nullptr, nullptr, ap->in[8], WSP(WS_H), 2);
    }
    SEAM(0);

    for (int l = 0; l < DEPTH; ++l) {
        const int pb = 1 + 11 * l;
        if (IN(pb + 0)) {
            CArgs* ap = fresh_args(); unsigned char* ws = ap->ws; Frame F = make_frame(L); unsigned char* wl = ws + WS_W + (size_t)l * LW_BYTES;
            { pg8::Gemm g{WSP(WS_H), (const bf16_t*)(wl + LW_IN), S, INW, DM, DM, DM, 0}; pg8::StaticOrder So; So.init(S, INW, F.G, F.bx);
              pg8::EpiZ E{WSP(WS_Q), WSP(WS_K), WSP(WS_V), WSP(WS_U), WSP(WS_GA), WSP(WS_GP)};
              pg8::gemm_phase<pg8::EpiZ, pg8::StaticOrder, true, true>(F.lds + RING_OFF, g, So, E); }
            if (l == 0) {
                for (int l2 = 0; l2 < DEPTH; ++l2) {
                    pg8::Gemm g2{WSP(WS_PB) + (size_t)l2 * S * DPLE, (const bf16_t*)(ws + WS_W + (size_t)l2 * LW_BYTES + LW_PIN), S, DM, DPLE, DPLE, DPLE, 0}; pg8::StaticOrder S2; S2.init(S, DM, F.G, F.bx);
                    pg8::EpiPlain E2{WSP(WS_E) + (size_t)l2 * S * DM, DM};
                    pg8::gemm_phase<pg8::EpiPlain, pg8::StaticOrder, true, true>(F.lds + RING_OFF, g2, S2, E2);
                }
            }
        }
        SEAM(pb + 0);
        if (IN(pb + 1)) {
            CArgs* ap = fresh_args(); unsigned char* ws = ap->ws; Frame F = make_frame(L);
            qk_norm_rope_pass(F, WSP(WS_Q), WSP(WS_K), WSP(WS_Q2), WSP(WS_K2), ap->in[3] + l * HD, ap->in[4] + l * HD, (const float*)(ws + WS_ROPE));
            pool_delta_pass(F, WSP(WS_U), WSP(WS_DL));
        }
        SEAM(pb + 1);
        if (IN(pb + 2)) {
            CArgs* ap = fresh_args(); unsigned char* ws = ap->ws; Frame F = make_frame(L);
            for (int U0 = F.vcu; U0 < NH * (S / 256); U0 += F.G) {
                const int a = U0 >> 8, b = (U0 >> 5) & 7, c = U0 & 31, h = 4 * b + a, qb = c, kvh = h >> 2;
                att::attn_dense_body(WSP(WS_Q2) + (size_t)qb * 256 * DM + h * HD, WSP(WS_K2) + kvh * HD, WSP(WS_V) + kvh * HD, WSP(WS_O) + (size_t)qb * 256 * DM + h * HD, S, (LAS char*)(F.lds + RING_OFF));
                __syncthreads();
            }
        }
        SEAM(pb + 2);
        if (IN(pb + 3)) {
            CArgs* ap = fresh_args(); unsigned char* ws = ap->ws; Frame F = make_frame(L); unsigned char* wl = ws + WS_W + (size_t)l * LW_BYTES;
            pg8::Gemm g{WSP(WS_DL), (const bf16_t*)(wl + LW_POOL), S, DM, PGI, POOLW, PGI, PGI}; pg8::StaticOrder So; So.init(S, DM, F.G, F.bx);
            pg8::EpiPool E{WSP(WS_MG), WSP(WS_O), WSP(WS_GA), WSP(WS_GP), ap->in[6] + (size_t)l * DM, DM};
            pg8::gemm_phase<pg8::EpiPool, pg8::StaticOrder, true, true>(F.lds + RING_OFF, g, So, E);
        }
        SEAM(pb + 3);
        if (IN(pb + 4)) {
            CArgs* ap = fresh_args(); unsigned char* ws = ap->ws; Frame F = make_frame(L); unsigned char* wl = ws + WS_W + (size_t)l * LW_BYTES;
            pg8::Gemm g{WSP(WS_MG), (const bf16_t*)(wl + LW_OUT), S, DM, DM, DM, DM, 0}; pg8::StaticOrder So; So.init(S, DM, F.G, F.bx);
            pg8::EpiPlain E{WSP(WS_Y), DM};
            pg8::gemm_phase<pg8::EpiPlain, pg8::StaticOrder, true, true>(F.lds + RING_OFF, g, So, E);
        }
        SEAM(pb + 4);
        if (IN(pb + 5)) {
            CArgs* ap = fresh_args(); unsigned char* ws = ap->ws; Frame F = make_frame(L);
            norm_pass(F, l == 0 ? ap->in[0] : (const float*)ap->out, ap->out, WSP(WS_Y), ap->in[9] + (size_t)l * DM, ap->in[10] + (size_t)l * DM, WSP(WS_H), 2);
        }
        SEAM(pb + 5);
        if (IN(pb + 6)) {
            CArgs* ap = fresh_args(); unsigned char* ws = ap->ws; Frame F = make_frame(L); unsigned char* wl = ws + WS_W + (size_t)l * LW_BYTES;
            pg8::Gemm g{WSP(WS_H), (const bf16_t*)(wl + LW_GU), S, 2 * FF, DM, DM, DM, 0}; pg8::StaticOrder So; So.init(S, 2 * FF, F.G, F.bx);
            pg8::EpiSwiglu E{WSP(WS_F), FF};
            pg8::gemm_phase<pg8::EpiSwiglu, pg8::StaticOrder, true, true>(F.lds + RING_OFF, g, So, E);
        }
        SEAM(pb + 6);
        if (IN(pb + 7)) {
            CArgs* ap = fresh_args(); unsigned char* ws = ap->ws; Frame F = make_frame(L); unsigned char* wl = ws + WS_W + (size_t)l * LW_BYTES;
            pg8::Gemm g{WSP(WS_F), (const bf16_t*)(wl + LW_DOWN), S, DM, FF, FF, FF, 0}; pg8::StaticOrder So; So.init(S, DM, F.G, F.bx);
            pg8::EpiPlain E{WSP(WS_Y), DM};
            pg8::gemm_phase<pg8::EpiPlain, pg8::StaticOrder, true, true>(F.lds + RING_OFF, g, So, E);
        }
        SEAM(pb + 7);
        if (IN(pb + 8)) {
            CArgs* ap = fresh_args(); unsigned char* ws = ap->ws; Frame F = make_frame(L);
            norm_pass(F, ap->out, ap->out, WSP(WS_Y), ap->in[11] + (size_t)l * DM, nullptr, WSP(WS_H), 1);
        }
        SEAM(pb + 8);
        if (IN(pb + 9)) {
            CArgs* ap = fresh_args(); unsigned char* ws = ap->ws; Frame F = make_frame(L); unsigned char* wl = ws + WS_W + (size_t)l * LW_BYTES;
            pg8::Gemm g{WSP(WS_H), (const bf16_t*)(wl + LW_PG), S, DM, DM, DM, DM, 0}; pg8::StaticOrder So; So.init(S, DM, F.G, F.bx);
            pg8::EpiPle E{WSP(WS_Y), WSP(WS_E) + (size_t)l * S * DM, DM};
            pg8::gemm_phase<pg8::EpiPle, pg8::StaticOrder, true, true>(F.lds + RING_OFF, g, So, E);
        }
        SEAM(pb + 9);
        if (IN(pb + 10)) {
            CArgs* ap = fresh_args(); unsigned char* ws = ap->ws; Frame F = make_frame(L);
            if (l + 1 < DEPTH) norm_pass(F, ap->out, ap->out, WSP(WS_Y), ap->in[17] + (size_t)l * DM, ap->in[8] + (size_t)(l + 1) * DM, WSP(WS_H), 2);
            else norm_pass(F, ap->out, ap->out, WSP(WS_Y), ap->in[17] + (size_t)l * DM, nullptr, nullptr, 0);
        }
        SEAM(pb + 10);
    }
#undef IN
#undef SEAM
#undef GRID_BAR
}

extern "C" void kernel_launch(void* const* d_in, const int* in_sizes, int n_in, void* d_out, int out_size, void* d_ws, size_t ws_size, hipStream_t stream) {
    static int grid = 0;
    if (grid == 0) {
        if (n_in != 18 || in_sizes[0] != S * DM || out_size != S * DM || ws_size < WS_END) { fprintf(stderr, "kernel_launch: shape/workspace mismatch: n_in %d in0 %d out %d ws %zu (need %zu)\n", n_in, n_in > 0 ? in_sizes[0] : -1, out_size, ws_size, (size_t)WS_END); grid = -1; return; }
        int dev = 0, cus = 0, per_cu = 0;
        if (hipGetDevice(&dev) != hipSuccess || hipDeviceGetAttribute(&cus, hipDeviceAttributeMultiprocessorCount, dev) != hipSuccess) { grid = -1; return; }
        if (hipFuncSetAttribute((const void*)fwd_kernel, hipFuncAttributeMaxDynamicSharedMemorySize, LDS_BYTES) != hipSuccess) { fprintf(stderr, "kernel_launch: hipFuncSetAttribute failed\n"); grid = -1; return; }
        if (hipOccupancyMaxActiveBlocksPerMultiprocessor(&per_cu, (const void*)fwd_kernel, NWAVES * 64, LDS_BYTES) != hipSuccess || per_cu < 1) { fprintf(stderr, "kernel_launch: occupancy query says %d blocks per CU\n", per_cu); }
        (void)hipGetLastError();
        grid = cus;
    }
    if (grid < 0) return;
    if (hipMemsetAsync((char*)d_ws + WS_CTL, 0, CTL_ZERO_BYTES, stream) != hipSuccess) return;
    Args a{};
    for (int i = 0; i < 18; ++i) a.in[i] = (const float*)d_in[i];
    a.out = (float*)d_out; a.ws = (unsigned char*)d_ws;
    for (int li = 0; li < N_LAUNCHES; ++li) {
        a.ph_lo = (N_LAUNCHES == 1) ? 0 : li; a.ph_hi = (N_LAUNCHES == 1) ? N_PHASES : li + 1;
        hipLaunchKernelGGL(fwd_kernel, dim3(grid), dim3(NWAVES * 64), LDS_BYTES, stream, a);
        const hipError_t le = hipPeekAtLastError();
        if (le != hipSuccess) { fprintf(stderr, "kernel_launch: launch %d failed: %s\n", li, hipGetErrorName(le)); break; }
    }
}
```

```cpp
#include <hip/hip_runtime.h>
#include <cstdio>
#include <cstdint>

#ifndef MK_N_LAUNCHES
#define MK_N_LAUNCHES 1
#endif

#ifndef G_SP2
#define G_SP2 true
#endif
#ifndef G_ALIGN
#define G_ALIGN true
#endif
#ifndef REP_CONV
#define REP_CONV 1
#endif
#ifndef REP_G1
#define REP_G1 1
#endif
#ifndef REP_ATT
#define REP_ATT 1
#endif
#ifndef REP_G3
#define REP_G3 1
#endif
#ifndef REP_G4
#define REP_G4 1
#endif
#ifndef REP_T2
#define REP_T2 1
#endif
#ifndef REP_THIN
#define REP_THIN 1
#endif
#ifndef REP_SMALLG
#define REP_SMALLG 1
#endif

#define LAS __attribute__((address_space(3)))
#define GAS __attribute__((address_space(1)))
typedef unsigned short bf16_t;
typedef short bf16x8 __attribute__((ext_vector_type(8)));
typedef short s16x4 __attribute__((ext_vector_type(4)));
typedef float f32x4 __attribute__((ext_vector_type(4)));
typedef float f32x2 __attribute__((ext_vector_type(2)));
typedef float f32x16 __attribute__((ext_vector_type(16)));
typedef unsigned u32x4 __attribute__((ext_vector_type(4)));
typedef unsigned u32x2 __attribute__((ext_vector_type(2)));

constexpr int S = 8192, DM = 4096, DEPTH = 2;
constexpr int NH = 32, NKV = 8, HD = 128;
constexpr int KVW = NKV * HD;
constexpr int POOLW = 2048, PGI = 512, PGO = 1024;
constexpr int INW = 16384;
constexpr int FF = 11008;
constexpr int DPLE = 256;
constexpr float EPS = 1e-6f;

__device__ __forceinline__ unsigned cvt_pk_bf16(float lo, float hi) { unsigned r; asm volatile("v_cvt_pk_bf16_f32 %0, %1, %2" : "=v"(r) : "v"(lo), "v"(hi)); return r; }
__device__ __forceinline__ float bf_lo(unsigned w) { return __uint_as_float(w << 16); }
__device__ __forceinline__ float bf_hi(unsigned w) { return __uint_as_float(w & 0xffff0000u); }
__device__ __forceinline__ float sigmoid_f(float v) { return __builtin_amdgcn_rcpf(1.0f + __builtin_amdgcn_exp2f(v * -1.4426950408889634f)); }

namespace pg8 {
constexpr int BM = 256, BK = 64, HALF = 128, HTB = HALF * BK * 2  , STAGE_BYTES = 8 * HTB, NXCD = 8, WGM = 8;

__host__ __device__ __forceinline__ int lds_byte(int r, int c) { const int st = (r >> 4) * 2 + (c >> 5), rr = r & 15, cc = c & 31, ob = rr * 64 + cc * 2; return st * 1024 + (ob ^ (((ob >> 9) & 1) << 5)); }
__host__ __device__ __forceinline__ void stage_rc(int b, int& R, int& C) { const int st = b / 1024, sb = b % 1024, swz = sb ^ (((sb >> 9) & 1) << 5); R = (st >> 1) * 16 + swz / 64; C = (st & 1) * 32 + (swz % 64) / 2; }
__host__ __device__ __forceinline__ int perm32(int rho) { const int n = rho >> 4, i = rho & 15; return 8 * (i >> 2) + 4 * n + (i & 3); }

struct Unit { int pm, pn; };
struct Gemm { const bf16_t* A; const bf16_t* Bt; int M, N, K, lda, ldb, agrp; };

struct StaticOrder {
    int nM, nN, nwg, G, c;
    __host__ __device__ void init(int M, int N, int G_, int c_) { nM = M / BM; nN = N / BM; nwg = nM * nN; G = G_; c = c_; }
    __host__ __device__ bool next(int i, Unit& u) const {
        const long L = (long)i * G + c; if (L >= nwg) return false;
        int wgid = (int)L; { const int q = nwg / NXCD, r = nwg % NXCD, xcd = wgid % NXCD, off = wgid / NXCD; wgid = (xcd < r ? xcd * (q + 1) : r * (q + 1) + (xcd - r) * q) + off; }
        const int nig = WGM * nN, gid = wgid / nig, fm = gid * WGM, gsz = (nM - fm) < WGM ? (nM - fm) : WGM;
        u.pm = fm + ((wgid % nig) % gsz); u.pn = (wgid % nig) / gsz; return true;
    }
    __device__ __forceinline__ void a_ready(const Unit&) const {}
    __device__ __forceinline__ void done(const Unit&) const {}
};

__device__ __forceinline__ u32x4 pack8(const f32x4 v0, const f32x4 v1) { u32x4 w; w.x = cvt_pk_bf16(v0[0], v0[1]); w.y = cvt_pk_bf16(v0[2], v0[3]); w.z = cvt_pk_bf16(v1[0], v1[1]); w.w = cvt_pk_bf16(v1[2], v1[3]); return w; }

struct EpiPlain {
    static constexpr bool PERM = true, AFTER_DRAIN = false;
    bf16_t* O; int ldc;
    __device__ __forceinline__ void operator()(const f32x4 (&acc)[2][2][4][2], const Unit& u, int wr, int wc, int fr, int fq) const {
        const int row0 = u.pm * BM + wr * 64 + fr, col0 = u.pn * BM + wc * 32 + 8 * fq;
#pragma unroll
        for (int ai = 0; ai < 2; ++ai)
#pragma unroll
            for (int m = 0; m < 4; ++m) { bf16_t* rowp = O + (size_t)(row0 + ai * HALF + m * 16) * ldc + col0;
#pragma unroll
                for (int bj = 0; bj < 2; ++bj) *(u32x4*)(rowp + bj * HALF) = pack8(acc[ai][bj][m][0], acc[ai][bj][m][1]); }
    }
};
struct EpiZ {
    static constexpr bool PERM = true, AFTER_DRAIN = false;
    bf16_t *Q, *Kb, *Vb, *U, *GA, *GP;
    __device__ __forceinline__ void operator()(const f32x4 (&acc)[2][2][4][2], const Unit& u, int wr, int wc, int fr, int fq) const {
        const int pn = u.pn; bf16_t* base; int ldc, ct; bool sg = false;
        if (pn < 16)      { base = Q;  ldc = DM;    ct = pn; }
        else if (pn < 20) { base = Kb; ldc = KVW;   ct = pn - 16; }
        else if (pn < 24) { base = Vb; ldc = KVW;   ct = pn - 20; }
        else if (pn < 32) { base = U;  ldc = POOLW; ct = pn - 24; }
        else if (pn < 48) { base = GA; ldc = DM;    ct = pn - 32; sg = true; }
        else              { base = GP; ldc = DM;    ct = pn - 48; sg = true; }
        const int row0 = u.pm * BM + wr * 64 + fr, col0 = ct * BM + wc * 32 + 8 * fq;
#pragma unroll
        for (int ai = 0; ai < 2; ++ai)
#pragma unroll
            for (int m = 0; m < 4; ++m) { bf16_t* rowp = base + (size_t)(row0 + ai * HALF + m * 16) * ldc + col0;
#pragma unroll
                for (int bj = 0; bj < 2; ++bj) { f32x4 v0 = acc[ai][bj][m][0], v1 = acc[ai][bj][m][1];
                    if (sg) {
#pragma unroll
                        for (int j = 0; j < 4; ++j) { v0[j] = sigmoid_f(v0[j]); v1[j] = sigmoid_f(v1[j]); } }
                    *(u32x4*)(rowp + bj * HALF) = pack8(v0, v1); } }
    }
};
struct EpiSwiglu {
    static constexpr bool PERM = true, AFTER_DRAIN = false;
    bf16_t* F; int ldc;
    __device__ __forceinline__ void operator()(const f32x4 (&acc)[2][2][4][2], const Unit& u, int wr, int wc, int fr, int fq) const {
        const int row0 = u.pm * BM + wr * 64 + fr, col0 = u.pn * HALF + wc * 32 + 8 * fq;
#pragma unroll
        for (int ai = 0; ai < 2; ++ai)
#pragma unroll
            for (int m = 0; m < 4; ++m) { bf16_t* rowp = F + (size_t)(row0 + ai * HALF + m * 16) * ldc + col0;
                f32x4 v0, v1;
#pragma unroll
                for (int j = 0; j < 4; ++j) { const float g0 = acc[ai][0][m][0][j], g1 = acc[ai][0][m][1][j];
                    v0[j] = g0 * sigmoid_f(g0) * acc[ai][1][m][0][j]; v1[j] = g1 * sigmoid_f(g1) * acc[ai][1][m][1][j]; }
                *(u32x4*)rowp = pack8(v0, v1); }
    }
};
__device__ __forceinline__ void unpack8(const u32x4 w, f32x4& a, f32x4& b) { a[0] = bf_lo(w.x); a[1] = bf_hi(w.x); a[2] = bf_lo(w.y); a[3] = bf_hi(w.y); b[0] = bf_lo(w.z); b[1] = bf_hi(w.z); b[2] = bf_lo(w.w); b[3] = bf_hi(w.w); }
struct EpiPle {
    static constexpr bool PERM = true, AFTER_DRAIN = false;
    bf16_t* Y; const bf16_t* E; int ldc;
    __device__ __forceinline__ void operator()(const f32x4 (&acc)[2][2][4][2], const Unit& u, int wr, int wc, int fr, int fq) const {
        const int row0 = u.pm * BM + wr * 64 + fr, col0 = u.pn * BM + wc * 32 + 8 * fq;
#pragma unroll
        for (int ai = 0; ai < 2; ++ai)
#pragma unroll
            for (int m = 0; m < 4; ++m) { const size_t off = (size_t)(row0 + ai * HALF + m * 16) * ldc + col0;
#pragma unroll
                for (int bj = 0; bj < 2; ++bj) { const u32x4 ew = *(const u32x4*)(E + off + bj * HALF); f32x4 e0, e1; unpack8(ew, e0, e1);
                    f32x4 v0 = acc[ai][bj][m][0], v1 = acc[ai][bj][m][1];
#pragma unroll
                    for (int j = 0; j < 4; ++j) { v0[j] = sigmoid_f(v0[j]) * e0[j]; v1[j] = sigmoid_f(v1[j]) * e1[j]; }
                    *(u32x4*)(Y + off + bj * HALF) = pack8(v0, v1); }
                asm volatile("" ::: "memory"); }
    }
};
struct EpiPool {
    static constexpr bool PERM = true, AFTER_DRAIN = false;
    bf16_t* MG; const bf16_t *O, *GA, *GP; const float* ps; int ldc;
    __device__ __forceinline__ void operator()(const f32x4 (&acc)[2][2][4][2], const Unit& u, int wr, int wc, int fr, int fq) const {
        const int row0 = u.pm * BM + wr * 64 + fr, col0 = u.pn * BM + wc * 32 + 8 * fq;
        f32x4 pv[2][2];
#pragma unroll
        for (int bj = 0; bj < 2; ++bj)
#pragma unroll
            for (int n = 0; n < 2; ++n) pv[bj][n] = *(const f32x4*)(ps + col0 + bj * HALF + 4 * n);
#pragma unroll
        for (int ai = 0; ai < 2; ++ai)
#pragma unroll
            for (int m = 0; m < 4; ++m) { const size_t off = (size_t)(row0 + ai * HALF + m * 16) * ldc + col0;
#pragma unroll
                for (int bj = 0; bj < 2; ++bj) {
                    const u32x4 ow = *(const u32x4*)(O + off + bj * HALF), aw = *(const u32x4*)(GA + off + bj * HALF), pw = *(const u32x4*)(GP + off + bj * HALF);
                    f32x4 o0, o1, a0, a1, p0, p1; unpack8(ow, o0, o1); unpack8(aw, a0, a1); unpack8(pw, p0, p1);
                    const f32x4 v0 = a0 * o0 + p0 * (acc[ai][bj][m][0] * pv[bj][0]), v1 = a1 * o1 + p1 * (acc[ai][bj][m][1] * pv[bj][1]);
                    *(u32x4*)(MG + off + bj * HALF) = pack8(v0, v1); }
                asm volatile("" ::: "memory"); }
    }
};

template <class Epi, class Sched, bool ALIGN_EPI = false, bool SP2 = false>
__device__ __forceinline__ void gemm_phase(LAS unsigned char* lds, const Gemm g, const Sched& S, const Epi& E) {
    int tid_ = threadIdx.x; asm volatile("" : "+v"(tid_));
    const int tid = tid_, wid = __builtin_amdgcn_readfirstlane(tid >> 6), lane = tid & 63, wr = wid >> 2, wc = wid & 3, fr = lane & 15, fq = lane >> 4;
    const int K = g.K, nt = K / BK;
    unsigned voffA[2], voffB[2];
#pragma unroll
    for (int i = 0; i < 2; ++i) { int R, C; stage_rc(tid * 16 + i * 8192, R, C); const int Rb = Epi::PERM ? ((R & ~31) + perm32(R & 31)) : R;
        voffA[i] = (unsigned)(R * g.lda + C) * 2u; voffB[i] = (unsigned)(Rb * g.ldb + C) * 2u; }
    const size_t kstep = (size_t)(BK * 2);
    const size_t hstepA = (size_t)HALF * g.lda * 2, hstepB = (size_t)HALF * g.ldb * 2;
    const size_t tstepA = 2 * hstepA, tstepB = 2 * hstepB;
    const unsigned ldsw = (unsigned)wid * 1024u;
    const int aoff = lds_byte(wr * 64 + fr, fq * 8), boff = lds_byte(wc * 32 + fr, fq * 8);
#define PG8_SA(b, h) (((b) * 2 + (h)) * HTB)
#define PG8_SB(b, h) ((4 + (b) * 2 + (h)) * HTB)
#define PG8_STAGE(bufoff, gbase, voff) do { _Pragma("unroll") for (int _i = 0; _i < 2; ++_i) \
        __builtin_amdgcn_global_load_lds((const unsigned*)((const char*)(gbase) + (voff)[_i]), (LAS unsigned*)(lds + (bufoff) + ldsw + _i * 8192), 16, 0, 0); } while (0)
#define PG8_LDA(dst, b, h) do { _Pragma("unroll") for (int m = 0; m < 4; ++m) _Pragma("unroll") for (int k = 0; k < 2; ++k) dst[m][k] = *(const LAS bf16x8*)(lds + PG8_SA(b, h) + aoff + m * 2048 + k * 1024); } while (0)
#define PG8_LDB(dst, b, h) do { _Pragma("unroll") for (int n = 0; n < 2; ++n) _Pragma("unroll") for (int k = 0; k < 2; ++k) dst[n][k] = *(const LAS bf16x8*)(lds + PG8_SB(b, h) + boff + n * 2048 + k * 1024); } while (0)
#define PG8_MMA(ai, bj, At, Bt) do { __builtin_amdgcn_s_setprio(1); _Pragma("unroll") for (int m = 0; m < 4; ++m) _Pragma("unroll") for (int n = 0; n < 2; ++n) _Pragma("unroll") for (int k = 0; k < 2; ++k) \
        acc[ai][bj][m][n] = __builtin_amdgcn_mfma_f32_16x16x32_bf16(Bt[n][k], At[m][k], acc[ai][bj][m][n], 0, 0, 0); __builtin_amdgcn_s_setprio(0); } while (0)
#define PG8_WAIT_V(n) asm volatile("s_waitcnt vmcnt(" #n ")" ::: "memory")
#define PG8_WAIT_L(n) asm volatile("s_waitcnt lgkmcnt(" #n ")" ::: "memory")
#define PG8_BAR __builtin_amdgcn_s_barrier()
#define PG8_SCHED __builtin_amdgcn_sched_barrier(0)
    Unit cur, nxt; int ui = 0;
    if (!S.next(0, cur)) return;
    f32x4 acc[2][2][4][2];
#pragma unroll
    for (int a = 0; a < 2; ++a)
#pragma unroll
        for (int b = 0; b < 2; ++b)
#pragma unroll
            for (int m = 0; m < 4; ++m)
#pragma unroll
                for (int n = 0; n < 2; ++n) acc[a][b][m][n] = (f32x4){0.f, 0.f, 0.f, 0.f};
    bf16x8 At[4][2], B0[2][2], B1[2][2];
    const char* cA = (const char*)g.A + (size_t)cur.pm * tstepA + (size_t)(cur.pn >> 2) * g.agrp * 2; const char* cB = (const char*)g.Bt + (size_t)cur.pn * tstepB;
    S.a_ready(cur);
    if constexpr (SP2) {
        PG8_STAGE(PG8_SB(0, 0), cB, voffB); PG8_STAGE(PG8_SB(0, 1), cB + hstepB, voffB); PG8_STAGE(PG8_SA(0, 0), cA, voffA); PG8_STAGE(PG8_SA(0, 1), cA + hstepA, voffA);
        if (wr == 1) PG8_BAR;
        PG8_WAIT_V(2); PG8_BAR;
        PG8_STAGE(PG8_SB(1, 0), cB + kstep, voffB); PG8_STAGE(PG8_SA(1, 0), cA + kstep, voffA); PG8_STAGE(PG8_SB(1, 1), cB + hstepB + kstep, voffB);
        PG8_WAIT_V(6); PG8_BAR;
    } else {
        PG8_STAGE(PG8_SB(0, 0), cB, voffB); PG8_STAGE(PG8_SA(0, 0), cA, voffA); PG8_STAGE(PG8_SB(0, 1), cB + hstepB, voffB); PG8_STAGE(PG8_SA(0, 1), cA + hstepA, voffA);
        if (wr == 1) PG8_BAR;
        PG8_WAIT_V(4); PG8_BAR;
        PG8_STAGE(PG8_SB(1, 0), cB + kstep, voffB); PG8_STAGE(PG8_SA(1, 0), cA + kstep, voffA); PG8_STAGE(PG8_SB(1, 1), cB + hstepB + kstep, voffB);
        PG8_WAIT_V(6); PG8_BAR;
    }
    for (;;) {
        const bool has_next = S.next(ui + 1, nxt);
        const char* nA = has_next ? (const char*)g.A + (size_t)nxt.pm * tstepA + (size_t)(nxt.pn >> 2) * g.agrp * 2 : cA; const char* nB = has_next ? (const char*)g.Bt + (size_t)nxt.pn * tstepB : cB;
        for (int t = 0; t < nt; t += 2) {
            const bool last = (t == nt - 2);
            const char* a1 = cA + (size_t)(t + 1) * kstep;
            const char* a2 = last ? nA : cA + (size_t)(t + 2) * kstep; const char* b2 = last ? nB : cB + (size_t)(t + 2) * kstep;
            const char* a3 = a2 + kstep; const char* b3 = b2 + kstep;
            if (last && has_next) S.a_ready(nxt);
            if constexpr (SP2) {
            PG8_LDB(B0, 0, 0); PG8_LDB(B1, 0, 1); PG8_SCHED; PG8_LDA(At, 0, 0); PG8_STAGE(PG8_SA(1, 1), a1 + hstepA, voffA);
            PG8_WAIT_V(8); PG8_WAIT_L(0); PG8_BAR; PG8_MMA(0, 0, At, B0); PG8_MMA(0, 1, At, B1); PG8_BAR; PG8_SCHED;
            PG8_LDA(At, 0, 1); PG8_STAGE(PG8_SB(0, 0), b2, voffB); PG8_STAGE(PG8_SB(0, 1), b2 + hstepB, voffB); PG8_STAGE(PG8_SA(0, 0), a2, voffA);
            PG8_WAIT_V(8); PG8_WAIT_L(0); PG8_BAR; PG8_MMA(1, 0, At, B0); PG8_MMA(1, 1, At, B1); PG8_BAR; PG8_SCHED;
            PG8_LDB(B0, 1, 0); PG8_LDB(B1, 1, 1); PG8_SCHED; PG8_LDA(At, 1, 0); PG8_STAGE(PG8_SA(0, 1), a2 + hstepA, voffA);
            PG8_WAIT_V(8); PG8_WAIT_L(0); PG8_BAR; PG8_MMA(0, 0, At, B0); PG8_MMA(0, 1, At, B1); PG8_BAR; PG8_SCHED;
            PG8_LDA(At, 1, 1); PG8_STAGE(PG8_SB(1, 0), b3, voffB); PG8_STAGE(PG8_SB(1, 1), b3 + hstepB, voffB); PG8_STAGE(PG8_SA(1, 0), a3, voffA);
            PG8_WAIT_V(8); PG8_WAIT_L(0); PG8_BAR; PG8_MMA(1, 0, At, B0); PG8_MMA(1, 1, At, B1); PG8_BAR; PG8_SCHED;
            } else {
            PG8_LDB(B0, 0, 0); PG8_SCHED; PG8_LDA(At, 0, 0); PG8_STAGE(PG8_SA(1, 1), a1 + hstepA, voffA);
            PG8_WAIT_L(8); PG8_BAR; PG8_WAIT_L(0); PG8_MMA(0, 0, At, B0); PG8_BAR; PG8_SCHED;
            PG8_LDB(B1, 0, 1); PG8_STAGE(PG8_SB(0, 0), b2, voffB);
            PG8_BAR; PG8_WAIT_L(0); PG8_MMA(0, 1, At, B1); PG8_BAR;
            PG8_LDA(At, 0, 1); PG8_STAGE(PG8_SA(0, 0), a2, voffA);
            PG8_BAR; PG8_WAIT_L(0); PG8_MMA(1, 0, At, B0); PG8_BAR; PG8_SCHED;
            PG8_STAGE(PG8_SB(0, 1), b2 + hstepB, voffB);
            PG8_WAIT_V(6); PG8_BAR; PG8_MMA(1, 1, At, B1); PG8_BAR;
            PG8_LDB(B0, 1, 0); PG8_SCHED; PG8_LDA(At, 1, 0); PG8_STAGE(PG8_SA(0, 1), a2 + hstepA, voffA);
            PG8_WAIT_L(8); PG8_BAR; PG8_WAIT_L(0); PG8_MMA(0, 0, At, B0); PG8_BAR; PG8_SCHED;
            PG8_LDB(B1, 1, 1); PG8_STAGE(PG8_SB(1, 0), b3, voffB);
            PG8_BAR; PG8_WAIT_L(0); PG8_MMA(0, 1, At, B1); PG8_BAR;
            PG8_LDA(At, 1, 1); PG8_STAGE(PG8_SA(1, 0), a3, voffA);
            PG8_BAR; PG8_WAIT_L(0); PG8_MMA(1, 0, At, B0); PG8_BAR; PG8_SCHED;
            PG8_STAGE(PG8_SB(1, 1), b3 + hstepB, voffB);
            PG8_WAIT_V(6); PG8_BAR; PG8_MMA(1, 1, At, B1); PG8_BAR;
            }
        }
        if constexpr (ALIGN_EPI) { if (wr == 0) PG8_BAR; }
        E(acc, cur, wr, wc, fr, fq); S.done(cur);
        if (!has_next) break;
#pragma unroll
        for (int a = 0; a < 2; ++a)
#pragma unroll
            for (int b = 0; b < 2; ++b)
#pragma unroll
                for (int m = 0; m < 4; ++m)
#pragma unroll
                    for (int n = 0; n < 2; ++n) acc[a][b][m][n] = (f32x4){0.f, 0.f, 0.f, 0.f};
        cur = nxt; cA = nA; cB = nB; ++ui;
        if constexpr (ALIGN_EPI) { if (wr == 1) PG8_BAR; }
    }
    PG8_WAIT_V(0);
    if constexpr (!ALIGN_EPI) { if (wr == 0) PG8_BAR; }
    PG8_BAR;
#undef PG8_SA
#undef PG8_SB
#undef PG8_STAGE
#undef PG8_LDA
#undef PG8_LDB
#undef PG8_MMA
#undef PG8_WAIT_V
#undef PG8_WAIT_L
#undef PG8_BAR
#undef PG8_SCHED
}
}

namespace att {
constexpr int D = 128, NW = 8, QBLK = 32, KVBLK = 64;
constexpr float SCALE = 0.088388347648318440f;
constexpr int LDQ = DM, LDK = KVW, LDO = DM;
constexpr int SHM_V = KVBLK * D * 2, SHM_K = KVBLK * D * 2, SHM_ATTN = 2 * SHM_V + 2 * SHM_K + NW * 64 * 4;
#define KSWZ(row, colB) ((row) * 256 + ((colB) ^ (((row) & 7) << 4)))
#define SBAR() __builtin_amdgcn_sched_barrier(0)
__device__ __forceinline__ int crow(int r, int hi) { return (r & 3) + 8 * (r >> 2) + 4 * hi; }
__device__ __forceinline__ unsigned cvtpk(float lo, float hi) { unsigned r; asm volatile("v_cvt_pk_bf16_f32 %0, %1, %2" : "=v"(r) : "v"(lo), "v"(hi)); return r; }

constexpr float THRL = 8.f;
#define MX3(a, b, c) __builtin_fmaxf(__builtin_fmaxf((a), (b)), (c))
template <bool FIRST>
__device__ __forceinline__ bool partialSM(f32x16& p0, f32x16& p1, float& mhat, f32x16& negm, float& l_reg, LAS float* al_l, int r32, int hi) {
  float a = MX3(p0[0], p0[1], p1[0]), b = MX3(p0[2], p0[3], p1[1]); a = MX3(a, p1[2], p1[3]);
#pragma unroll
  for (int r = 4; r < 16; r += 4) { a = MX3(a, p0[r], p0[r + 1]); b = MX3(b, p0[r + 2], p0[r + 3]); a = MX3(a, p1[r], p1[r + 1]); b = MX3(b, p1[r + 2], p1[r + 3]); }
  float rm = __builtin_fmaxf(a, b);
  { auto rr = __builtin_amdgcn_permlane32_swap(__float_as_uint(rm), __float_as_uint(rm), false, false);
    rm = __builtin_fmaxf(__uint_as_float(rr[0]), __uint_as_float(rr[1])); }
  bool resc = false;
  if (FIRST) { const float dl = rm; mhat = dl;
#pragma unroll
    for (int r = 0; r < 16; ++r) { p0[r] -= dl; p1[r] -= dl; }
#pragma unroll
    for (int r = 0; r < 16; ++r) negm[r] = -mhat;
    asm volatile("" : "+v"(negm));
  } else if (__builtin_expect(__any(rm > THRL), 0)) { const float dl = __builtin_fmaxf(rm, 0.f); mhat += dl;
#pragma unroll
    for (int r = 0; r < 16; ++r) { p0[r] -= dl; p1[r] -= dl; }
#pragma unroll
    for (int r = 0; r < 16; ++r) negm[r] = -mhat;
    asm volatile("" : "+v"(negm));
    const float f = __builtin_amdgcn_exp2f(-dl); l_reg *= f; if (hi == 0) al_l[r32] = f; resc = true; }
#pragma unroll
  for (int r = 0; r < 16; ++r) p0[r] = __builtin_amdgcn_exp2f(p0[r]);
  return resc;
}
#undef MX3
__device__ __forceinline__ void finishSM(f32x16& p0, f32x16& p1, float& l_reg, bf16x8& pa0, bf16x8& pa1, bf16x8& pa2, bf16x8& pa3) {
#pragma unroll
  for (int r = 0; r < 16; ++r) p1[r] = __builtin_amdgcn_exp2f(p1[r]);
  float ps = 0;
#pragma unroll
  for (int r = 0; r < 16; ++r) ps += p0[r];
#pragma unroll
  for (int r = 0; r < 16; ++r) ps += p1[r];
  l_reg += ps;
#define PK4(P, BASE, OUT) do { unsigned a0 = cvtpk(P[BASE + 0], P[BASE + 1]), a1 = cvtpk(P[BASE + 2], P[BASE + 3]);   \
    unsigned b0 = cvtpk(P[BASE + 4], P[BASE + 5]), b1 = cvtpk(P[BASE + 6], P[BASE + 7]);                              \
    auto r0 = __builtin_amdgcn_permlane32_swap(a0, b0, false, false); auto r1 = __builtin_amdgcn_permlane32_swap(a1, b1, false, false); \
    u32x4 w = {r0[0], r1[0], r0[1], r1[1]}; OUT = *reinterpret_cast<bf16x8*>(&w); } while (0)
  PK4(p0, 0, pa0); PK4(p0, 8, pa1); PK4(p1, 0, pa2); PK4(p1, 8, pa3);
#undef PK4
}
__device__ __forceinline__ void qkt(f32x16& p0, f32x16& p1, const LAS char* Ks, const bf16x8* qr, const f32x16& negm, int r32, int hi) {
#pragma unroll
  for (int d0 = 0; d0 < 8; ++d0) { int cb = (d0 * 16 + hi * 8) * 2;
    bf16x8 b0 = *reinterpret_cast<const LAS bf16x8*>(Ks + KSWZ(r32, cb));
    bf16x8 b1 = *reinterpret_cast<const LAS bf16x8*>(Ks + KSWZ(32 + r32, cb));
    if (d0 == 0) { p0 = __builtin_amdgcn_mfma_f32_32x32x16_bf16(b0, qr[0], negm, 0, 0, 0); p1 = __builtin_amdgcn_mfma_f32_32x32x16_bf16(b1, qr[0], negm, 0, 0, 0); }
    else { p0 = __builtin_amdgcn_mfma_f32_32x32x16_bf16(b0, qr[d0], p0, 0, 0, 0); p1 = __builtin_amdgcn_mfma_f32_32x32x16_bf16(b1, qr[d0], p1, 0, 0, 0); } }
}
__device__ __forceinline__ int v_st(int k, int c) { const int kk = (k & ~0xC) | ((k & 4) << 1) | ((k & 8) >> 1); return ((kk >> 3) * 4 + (c >> 5)) * 512 + ((kk & 7) * 32 + (c & 31)) * 2; }
__device__ __forceinline__ int v_rd_base(int lane) { return ((lane & 3) << 3) | (((lane >> 2) & 3) << 6) | (((lane >> 4) & 1) << 5) | (((lane >> 5) & 1) << 8); }
constexpr int v_rd_off(int d0, int ks, int half) { return d0 * 512 + ks * 4096 + half * 2048; }
template <int OFF> __device__ __forceinline__ s16x4 tr_read(int vb) {
  s16x4 r; asm volatile("ds_read_b64_tr_b16 %0, %1 offset:%2" : "=&v"(r) : "v"(vb), "i"(OFF) : "memory"); return r;
}
template <int D0> __device__ __forceinline__ void pv_one(f32x16& od, int vb, bf16x8 pa0, bf16x8 pa1, bf16x8 pa2, bf16x8 pa3) {
  const s16x4 l0 = tr_read<v_rd_off(D0, 0, 0)>(vb), h0 = tr_read<v_rd_off(D0, 0, 1)>(vb), l1 = tr_read<v_rd_off(D0, 1, 0)>(vb), h1 = tr_read<v_rd_off(D0, 1, 1)>(vb);
  const s16x4 l2 = tr_read<v_rd_off(D0, 2, 0)>(vb), h2 = tr_read<v_rd_off(D0, 2, 1)>(vb), l3 = tr_read<v_rd_off(D0, 3, 0)>(vb), h3 = tr_read<v_rd_off(D0, 3, 1)>(vb);
  asm volatile("s_waitcnt lgkmcnt(0)" ::: "memory"); SBAR();
#define PK(L, H) (bf16x8){L[0], L[1], L[2], L[3], H[0], H[1], H[2], H[3]}
  od = __builtin_amdgcn_mfma_f32_32x32x16_bf16(pa0, PK(l0, h0), od, 0, 0, 0);
  od = __builtin_amdgcn_mfma_f32_32x32x16_bf16(pa1, PK(l1, h1), od, 0, 0, 0);
  od = __builtin_amdgcn_mfma_f32_32x32x16_bf16(pa2, PK(l2, h2), od, 0, 0, 0);
  od = __builtin_amdgcn_mfma_f32_32x32x16_bf16(pa3, PK(l3, h3), od, 0, 0, 0);
#undef PK
}
__device__ __forceinline__ void pv_d0(f32x16* o, int vb, bf16x8 pa0, bf16x8 pa1, bf16x8 pa2, bf16x8 pa3) {
  pv_one<0>(o[0], vb, pa0, pa1, pa2, pa3); pv_one<1>(o[1], vb, pa0, pa1, pa2, pa3); pv_one<2>(o[2], vb, pa0, pa1, pa2, pa3); pv_one<3>(o[3], vb, pa0, pa1, pa2, pa3);
}
__device__ __forceinline__ void attn_dense_body(const bf16_t* __restrict__ Qb, const bf16_t* __restrict__ Kh, const bf16_t* __restrict__ Vh, bf16_t* __restrict__ Ob, int seq, LAS char* lds) {
  int tid_ = threadIdx.x; asm volatile("" : "+v"(tid_));
  const int tid = tid_, wid = tid >> 6, lane = tid & 63, r32 = lane & 31, hi = lane >> 5;
  LAS char* V_lds = lds; LAS char* K_lds = lds + 2 * SHM_V;
  LAS float* ws = (LAS float*)(lds + 2 * SHM_V + 2 * SHM_K) + wid * 64; LAS float* li_l = ws; LAS float* al_l = ws + 32;
  float mhat = 0.f, l_reg = 0; f32x16 o[4] = {}; bf16x8 qr[8]; f32x16 negm = f32x16{}; asm volatile("" : "+v"(negm));
  const bf16_t* Qw = Qb + (long)(wid * QBLK + r32) * LDQ + hi * 8;
#pragma unroll
  for (int d0 = 0; d0 < 8; ++d0) qr[d0] = *reinterpret_cast<const bf16x8*>(Qw + d0 * 16);
  const int sr = tid >> 4, sc = (tid & 15) * 8, vst0 = v_st(sr, sc), vst1 = v_st(32 + sr, sc);
  const int vb0 = (int)(unsigned)(uintptr_t)V_lds + v_rd_base(lane);
  struct { bf16x8 vs0, vs1, ks0, ks1; } sr_[2];
#define SLOAD(i, k0) do { sr_[i].vs0 = *reinterpret_cast<const bf16x8*>(&Vh[(long)((k0) + sr) * LDK + sc]); sr_[i].vs1 = *reinterpret_cast<const bf16x8*>(&Vh[(long)((k0) + 32 + sr) * LDK + sc]); \
    sr_[i].ks0 = *reinterpret_cast<const bf16x8*>(&Kh[(long)((k0) + sr) * LDK + sc]); sr_[i].ks1 = *reinterpret_cast<const bf16x8*>(&Kh[(long)((k0) + 32 + sr) * LDK + sc]); } while (0)
#define SWRITE(b, i) do { *(LAS bf16x8*)(V_lds + (b) * SHM_V + vst0) = sr_[i].vs0;          \
    *(LAS bf16x8*)(V_lds + (b) * SHM_V + vst1) = sr_[i].vs1; int kc = sc * 2;               \
    *(LAS bf16x8*)(K_lds + (b) * SHM_K + KSWZ(sr, kc)) = sr_[i].ks0;                       \
    *(LAS bf16x8*)(K_lds + (b) * SHM_K + KSWZ(32 + sr, kc)) = sr_[i].ks1; } while (0)
#define SWAIT() asm volatile("s_waitcnt vmcnt(4)" ::: "memory")
#define RESC(fl) do { if (fl) { asm volatile("s_waitcnt lgkmcnt(0)" ::: "memory"); \
    _Pragma("unroll") for (int d = 0; d < 4; ++d) _Pragma("unroll") for (int r = 0; r < 16; ++r) o[d][r] *= al_l[crow(r, hi)]; } } while (0)
  f32x16 pA0, pA1, pB0, pB1; bool rsA, rsB; bf16x8 pa0, pa1, pa2, pa3; const int NT = seq / KVBLK;
  constexpr int SE = 0, SO = 1;
  SLOAD(SE, 0); asm volatile("s_waitcnt vmcnt(0)" ::: "memory"); SWRITE(0, SE); __syncthreads();
  qkt(pA0, pA1, K_lds, qr, negm, r32, hi); (void)partialSM<true>(pA0, pA1, mhat, negm, l_reg, al_l, r32, hi);
  SLOAD(SO, KVBLK); if (2 < NT) SLOAD(SE, 2 * KVBLK);
  SWAIT(); SWRITE(1, SO); __syncthreads();
  for (int j = 1; j + 1 < NT; j += 2) {
    SBAR(); qkt(pB0, pB1, K_lds + SHM_K, qr, negm, r32, hi);
    finishSM(pA0, pA1, l_reg, pa0, pa1, pa2, pa3); SBAR();
    SLOAD(SO, (j + 2) * KVBLK); SBAR();
    pv_d0(o, vb0, pa0, pa1, pa2, pa3); rsB = partialSM<false>(pB0, pB1, mhat, negm, l_reg, al_l, r32, hi);
    __syncthreads(); SWAIT(); SWRITE(0, SE);
    RESC(rsB); __syncthreads();
    SBAR(); qkt(pA0, pA1, K_lds, qr, negm, r32, hi);
    finishSM(pB0, pB1, l_reg, pa0, pa1, pa2, pa3); SBAR();
    if (j + 3 < NT) SLOAD(SE, (j + 3) * KVBLK); SBAR();
    pv_d0(o, vb0 + SHM_V, pa0, pa1, pa2, pa3); rsA = partialSM<false>(pA0, pA1, mhat, negm, l_reg, al_l, r32, hi);
    __syncthreads(); SWAIT(); SWRITE(1, SO);
    RESC(rsA); __syncthreads();
  }
  SBAR(); qkt(pB0, pB1, K_lds + SHM_K, qr, negm, r32, hi);
  finishSM(pA0, pA1, l_reg, pa0, pa1, pa2, pa3); SBAR();
  pv_d0(o, vb0, pa0, pa1, pa2, pa3); rsB = partialSM<false>(pB0, pB1, mhat, negm, l_reg, al_l, r32, hi);
  __syncthreads(); RESC(rsB);
  finishSM(pB0, pB1, l_reg, pa0, pa1, pa2, pa3); SBAR();
  pv_d0(o, vb0 + SHM_V, pa0, pa1, pa2, pa3);
  { auto rr = __builtin_amdgcn_permlane32_swap(__float_as_uint(l_reg), __float_as_uint(l_reg), false, false); l_reg = __uint_as_float(rr[0]) + __uint_as_float(rr[1]); }
  if (hi == 0) li_l[r32] = l_reg; asm volatile("s_waitcnt lgkmcnt(0)" ::: "memory");
  float rli[16];
#pragma unroll
  for (int r = 0; r < 16; ++r) rli[r] = __builtin_amdgcn_rcpf(li_l[crow(r, hi)]);
  bf16_t* Ow = Ob + (long)(wid * QBLK) * LDO;
#pragma unroll
  for (int r = 0; r < 16; ++r) { const int orow = crow(r, hi);
#pragma unroll
    for (int d0 = 0; d0 < 4; ++d0) { const unsigned w = cvtpk(o[d0][r] * rli[r], 0.f); Ow[(long)orow * LDO + d0 * 32 + r32] = (bf16_t)(w & 0xffffu); } }
#undef SLOAD
#undef SWRITE
#undef SWAIT
#undef RESC
}
#undef SBAR
}

constexpr int NWAVES = 8;
constexpr int N_PHASES = 1 + 11 * DEPTH;
constexpr int N_LAUNCHES = MK_N_LAUNCHES;
static_assert(N_LAUNCHES == 1 || N_LAUNCHES == N_PHASES, "MK_N_LAUNCHES is 1 or 23");

constexpr size_t MiB = 1u << 20;
constexpr size_t WS_CTL = 0, CTL_ZERO_BYTES = 1 * MiB;
constexpr size_t WS_ROPE = 1 * MiB;
constexpr size_t WS_PB = 2 * MiB;
constexpr size_t WS_W = 16 * MiB;
constexpr size_t LW_IN = 0, LW_POOL = 128 * MiB, LW_OUT = 132 * MiB, LW_GU = 164 * MiB, LW_DOWN = 336 * MiB, LW_PIN = 422 * MiB, LW_PG = 424 * MiB, LW_BYTES = 456 * MiB;
constexpr size_t WS_ACT = WS_W + 2 * LW_BYTES;
constexpr size_t WS_H = WS_ACT;
constexpr size_t WS_Q = WS_H + 64 * MiB;
constexpr size_t WS_K = WS_Q + 64 * MiB;
constexpr size_t WS_V = WS_K + 16 * MiB;
constexpr size_t WS_U = WS_V + 16 * MiB;
constexpr size_t WS_GA = WS_U + 32 * MiB;
constexpr size_t WS_GP = WS_GA + 64 * MiB;
constexpr size_t WS_Q2 = WS_GP + 64 * MiB;
constexpr size_t WS_K2 = WS_Q2 + 64 * MiB;
constexpr size_t WS_DL = WS_K2 + 16 * MiB;
constexpr size_t WS_O = WS_DL + 32 * MiB;
constexpr size_t WS_MG = WS_O + 64 * MiB;
constexpr size_t WS_Y = WS_MG + 64 * MiB;
constexpr size_t WS_F = WS_Y + 64 * MiB;
constexpr size_t WS_E = WS_F + 172 * MiB;
constexpr size_t WS_END = WS_E + 128 * MiB;
static_assert(WS_END <= 2048 * MiB, "workspace map");

constexpr int CW_TMO = 0, CW_CODE = 1;
constexpr int CW_BAR = 4096;

constexpr int RING_OFF = 0, RING_BYTES = 131072;
constexpr int LDSCTL_OFF = RING_BYTES, MISC_OFF = LDSCTL_OFF + 320;
constexpr int LDS_BYTES = 147456;

typedef GAS unsigned gu32;
#define RLX_AGENT __ATOMIC_RELAXED, __HIP_MEMORY_SCOPE_AGENT
#define LDS_WAIT() asm volatile("s_waitcnt lgkmcnt(0)" ::: "memory")
#define VM_WAIT() asm volatile("s_waitcnt vmcnt(0)" ::: "memory")
__device__ __forceinline__ unsigned f2bf(float f) { unsigned u = __builtin_bit_cast(unsigned, f); return (u + 0x7fffu + ((u >> 16) & 1u)) >> 16; }
__device__ __forceinline__ unsigned pk2(float lo, float hi) { return f2bf(lo) | (f2bf(hi) << 16); }

#define XB_TMO      128
#define XB_XCNT(j)  (256  + 64 * (j))
#define XB_XSUB(j)  (1280 + 64 * (j))
#define XB_XGEN(j)  (2304 + 64 * (j))
#define XB_TOP      3328
#define XB_TOPGEN   3392
#define XCD_BAR_WORDS 3456
#define XB_SPIN_CAP (1u << 18)

__device__ __forceinline__ unsigned xb_ld(unsigned* p)              { return __hip_atomic_load(p, __ATOMIC_RELAXED, __HIP_MEMORY_SCOPE_AGENT); }
__device__ __forceinline__ unsigned xb_add(unsigned* p, unsigned v) { return __hip_atomic_fetch_add(p, v, __ATOMIC_RELAXED, __HIP_MEMORY_SCOPE_AGENT); }
__device__ __forceinline__ unsigned xb_xcc_id() { return (unsigned)__builtin_amdgcn_s_getreg((3 << 11) | 20) & 0xFu; }
#define XB_SPIN(cond, bar) do { unsigned _sp = 0; while (cond) { __builtin_amdgcn_s_sleep(1); \
    if ((++_sp & 255u) == 0u) { if (xb_ld(&(bar)[XB_TMO])) break; if (_sp > XB_SPIN_CAP) { atomicAdd(&(bar)[XB_TMO], 1u); break; } } } } while (0)

struct XcdBarrier {
    unsigned* bar; unsigned x;
    volatile LAS unsigned* st;
};
__device__ __forceinline__ XcdBarrier xcd_barrier_post(unsigned* bar, volatile LAS unsigned* st) {
    XcdBarrier b; b.bar = bar; b.x = xb_xcc_id(); b.st = st;
    if (threadIdx.x == 0) (void)xb_add(&bar[XB_XCNT(b.x)], 1u);
    return b;
}
__device__ __forceinline__ void xcd_barrier_complete(unsigned* bar, unsigned x, unsigned& nloc, unsigned& nx) {
    const unsigned G = gridDim.x * gridDim.y * gridDim.z;
    unsigned sum, cnt, mine, sp = 0u;
    for (;;) {
        sum = 0u; cnt = 0u; mine = 0u;
#pragma unroll
        for (unsigned j = 0; j < 16; ++j) { const unsigned c = xb_ld(&bar[XB_XCNT(j)]); sum += c; cnt += (c > 0u) ? 1u : 0u; mine = (j == x) ? c : mine; }
        if (sum == G) break;
        __builtin_amdgcn_s_sleep(1);
        if ((++sp & 255u) == 0u) { if (xb_ld(&bar[XB_TMO])) break; if (sp > XB_SPIN_CAP) { atomicAdd(&bar[XB_TMO], 1u); break; } }
    }
    nloc = mine > 0u ? mine : 1u; nx = cnt > 0u ? cnt : 1u;
}
__device__ __forceinline__ void xcd_barrier(const XcdBarrier& b) {
    asm volatile("s_waitcnt vmcnt(0)" ::: "memory");
    __syncthreads();
    if (threadIdx.x == 0) {
        unsigned* bar = b.bar; asm volatile("" : "+s"(bar));
        __builtin_amdgcn_s_waitcnt(0);
        unsigned nloc = b.st[0], nx = b.st[1];
        if (nloc == 0u) { xcd_barrier_complete(bar, b.x, nloc, nx); b.st[0] = nloc; b.st[1] = nx; }
        const unsigned old = xb_add(&bar[XB_XSUB(b.x)], 1u);
        const unsigned gen = old / nloc;
        if (old + 1u == (gen + 1u) * nloc) {
            __builtin_amdgcn_fence(__ATOMIC_RELEASE, "agent");
            asm volatile("s_waitcnt vmcnt(0)" ::: "memory");
            const unsigned og = xb_add(&bar[XB_TOP], 1u);
            const unsigned tg = og / nx;
            if (og + 1u == (tg + 1u) * nx) xb_add(&bar[XB_TOPGEN], 1u);
            else XB_SPIN(xb_ld(&bar[XB_TOPGEN]) == tg, bar);
            __builtin_amdgcn_fence(__ATOMIC_ACQUIRE, "agent");
            xb_add(&bar[XB_XGEN(b.x)], 1u);
            asm volatile("s_waitcnt vmcnt(0)" ::: "memory");
        } else {
            XB_SPIN(xb_ld(&bar[XB_XGEN(b.x)]) == gen, bar);
            __builtin_amdgcn_fence(__ATOMIC_ACQUIRE, "agent");
            asm volatile("s_waitcnt vmcnt(0)" ::: "memory");
        }
    }
    __syncthreads();
}

struct Frame {
    LAS unsigned char* lds;
    int tid, lane, wave;
    int vcu, G, bx;
};
__device__ __forceinline__ Frame make_frame(LAS unsigned char* lds) {
    Frame F; int t = threadIdx.x; asm volatile("" : "+v"(t)); int bx = blockIdx.x; asm volatile("" : "+s"(bx)); int G = gridDim.x; asm volatile("" : "+s"(G));
    F.lds = lds; F.tid = t; F.lane = t & 63; F.wave = __builtin_amdgcn_readfirstlane(t >> 6); F.G = G; F.bx = bx;
    F.vcu = (G % 8 == 0) ? (bx % 8) * (G / 8) + bx / 8 : bx;
    return F;
}

__device__ __forceinline__ float shx(float v, int m, int lane) { return __int_as_float(__builtin_amdgcn_ds_bpermute((lane ^ m) << 2, __float_as_int(v))); }
__device__ __forceinline__ float wave_sum(float v, int lane) {
#pragma unroll
    for (int o = 1; o < 64; o <<= 1) v += shx(v, o, lane);
    return v;
}

template <int MAP>
__device__ __forceinline__ void p0_transpose_item(const float* W, int K, int N, bf16_t* WT, int row_off, LAS float* scr, int item, int lane) {
    const int nblk = N / 32, kb = item / nblk, nb = item % nblk, k0 = 64 * kb, n0 = 32 * nb;
    const int r0 = (MAP == 0) ? (row_off + n0) : (256 * (n0 >> 7) + (n0 & 127) + row_off);
#pragma unroll 8
    for (int i = 0; i < 32; ++i) { const int kk = 2 * i + (lane >> 5); scr[kk * 33 + (lane & 31)] = W[(size_t)(k0 + kk) * N + n0 + (lane & 31)]; }
    LDS_WAIT(); asm volatile("" ::: "memory");
    const int c = lane & 7;
#pragma unroll
    for (int j = 0; j < 4; ++j) { const int n = (lane >> 3) + 8 * j; const LAS float* s = scr + (8 * c) * 33 + n;
        u32x4 o; o.x = pk2(s[0 * 33], s[1 * 33]); o.y = pk2(s[2 * 33], s[3 * 33]); o.z = pk2(s[4 * 33], s[5 * 33]); o.w = pk2(s[6 * 33], s[7 * 33]);
        *(GAS u32x4*)(WT + (size_t)(r0 + n) * K + k0 + 8 * c) = o; }
    LDS_WAIT(); asm volatile("" ::: "memory");
}

struct Args { const float* in[18]; float* out; unsigned char* ws; int ph_lo, ph_hi; };

__device__ __forceinline__ void norm_row(int lane, const float* xin, float* xout, const bf16_t* y, const LAS float* gpost, const LAS float* gpre, bf16_t* h, int hmode) {
    const GAS f32x4* xr = (const GAS f32x4*)xin + lane;
    f32x4 v[16];
#pragma unroll
    for (int j = 0; j < 16; ++j) v[j] = xr[64 * j];
    if (y) {
        const GAS u32x2* yr = (const GAS u32x2*)y + lane; f32x4 yv[16]; float s = 0.f;
#pragma unroll
        for (int j = 0; j < 16; ++j) { const u32x2 w = yr[64 * j]; yv[j] = (f32x4){bf_lo(w.x), bf_hi(w.x), bf_lo(w.y), bf_hi(w.y)}; s += (yv[j].x * yv[j].x + yv[j].y * yv[j].y) + (yv[j].z * yv[j].z + yv[j].w * yv[j].w); }
        const float rstd = 1.0f / sqrtf(wave_sum(s, lane) * (1.f / DM) + EPS);
#pragma unroll
        for (int j = 0; j < 16; ++j) { const f32x4 g = *(const LAS f32x4*)(gpost + 4 * lane + 256 * j); v[j] = v[j] + yv[j] * rstd * g; }
    }
    if (xout) { GAS f32x4* xo = (GAS f32x4*)xout + lane;
#pragma unroll
        for (int j = 0; j < 16; ++j) xo[64 * j] = v[j]; }
    if (hmode) {
        float rstd = 1.f;
        if (hmode == 2) { float s = 0.f;
#pragma unroll
            for (int j = 0; j < 16; ++j) s += (v[j].x * v[j].x + v[j].y * v[j].y) + (v[j].z * v[j].z + v[j].w * v[j].w);
            rstd = 1.0f / sqrtf(wave_sum(s, lane) * (1.f / DM) + EPS); }
        GAS u32x2* ho = (GAS u32x2*)h + lane;
#pragma unroll
        for (int j = 0; j < 16; ++j) { f32x4 t = v[j] * rstd; if (hmode == 2) { const f32x4 g = *(const LAS f32x4*)(gpre + 4 * lane + 256 * j); t = t * g; }
            u32x2 w; w.x = cvt_pk_bf16(t.x, t.y); w.y = cvt_pk_bf16(t.z, t.w); ho[64 * j] = w; }
    }
}
__device__ __forceinline__ void norm_pass(Frame& F, const float* xin, float* xout, const bf16_t* y, const float* gpost, const float* gpre, bf16_t* h, int hmode) {
    LAS float* gl = (LAS float*)(F.lds + RING_OFF);
    __syncthreads();
    for (int i = F.tid; i < DM; i += NWAVES * 64) { gl[i] = gpost ? gpost[i] : 0.f; gl[DM + i] = gpre ? gpre[i] : 0.f; }
    __syncthreads();
    const int gw = F.vcu * NWAVES + F.wave, NGW = F.G * NWAVES;
    for (int m = gw; m < S; m += NGW)
        norm_row(F.lane, xin + (size_t)m * DM, xout ? xout + (size_t)m * DM : nullptr, y ? y + (size_t)m * DM : nullptr, gl, gl + DM, h ? h + (size_t)m * DM : nullptr, hmode);
    __syncthreads();
}

__device__ __forceinline__ void qk_norm_rope_pass(Frame& F, const bf16_t* Qr, const bf16_t* Kr, bf16_t* Q2, bf16_t* K2, const float* qn, const float* kn, const float* rope) {
    const int gw = F.vcu * NWAVES + F.wave, NGW = F.G * NWAVES;
    const int g16 = F.lane >> 4, s = F.lane & 15;
    constexpr int NITEM = S * (NH + NKV);
    const int dsub = 8 * s;
    const int axis = s >> 3, half = (s >> 2) & 1, i0 = 8 * (s & 3);
    for (int it = 4 * gw + g16; it < NITEM; it += 4 * NGW) {
        const int row = it / (NH + NKV), hh = it % (NH + NKV);
        const bool isq = hh < NH;
        const bf16_t* src = isq ? Qr + (size_t)row * DM + hh * HD + dsub : Kr + (size_t)row * KVW + (hh - NH) * HD + dsub;
        bf16_t* dst = isq ? Q2 + (size_t)row * DM + hh * HD + dsub : K2 + (size_t)row * KVW + (hh - NH) * HD + dsub;
        const float* gn = isq ? qn : kn;
        const u32x4 w = *(const GAS u32x4*)src;
        float x[8] = {bf_lo(w.x), bf_hi(w.x), bf_lo(w.y), bf_hi(w.y), bf_lo(w.z), bf_hi(w.z), bf_lo(w.w), bf_hi(w.w)};
        float ss = 0.f;
#pragma unroll
        for (int j = 0; j < 8; ++j) ss += x[j] * x[j];
        ss += shx(ss, 1, F.lane); ss += shx(ss, 2, F.lane); ss += shx(ss, 4, F.lane); ss += shx(ss, 8, F.lane);
        const float rstd = 1.0f / sqrtf(ss * (1.f / HD) + EPS);
        const f32x4 ga = *(const f32x4*)(gn + dsub), gb = *(const f32x4*)(gn + dsub + 4);
        const float g[8] = {ga.x, ga.y, ga.z, ga.w, gb.x, gb.y, gb.z, gb.w};
        const float rs = isq ? rstd * (att::SCALE * 1.4426950408889634f) : rstd;
#pragma unroll
        for (int j = 0; j < 8; ++j) x[j] = x[j] * rs * g[j];
        float xp[8];
#pragma unroll
        for (int j = 0; j < 8; ++j) xp[j] = shx(x[j], 4, F.lane);
        const int pos = axis ? (row & 63) : (row >> 6);
        const f32x4* tp = (const f32x4*)(rope + ((size_t)pos * 32 + i0) * 2);
        float o[8];
#pragma unroll
        for (int jj = 0; jj < 4; ++jj) { const f32x4 cs = tp[jj];
            o[2 * jj]     = half ? (x[2 * jj] * cs.x + xp[2 * jj] * cs.y)         : (x[2 * jj] * cs.x - xp[2 * jj] * cs.y);
            o[2 * jj + 1] = half ? (x[2 * jj + 1] * cs.z + xp[2 * jj + 1] * cs.w) : (x[2 * jj + 1] * cs.z - xp[2 * jj + 1] * cs.w); }
        u32x4 ow; ow.x = cvt_pk_bf16(o[0], o[1]); ow.y = cvt_pk_bf16(o[2], o[3]); ow.z = cvt_pk_bf16(o[4], o[5]); ow.w = cvt_pk_bf16(o[6], o[7]);
        *(GAS u32x4*)dst = ow;
    }
}
__device__ __forceinline__ void pool_delta_pass(Frame& F, const bf16_t* U, bf16_t* DL) {
    const int gt = F.vcu * (NWAVES * 64) + F.tid, NT = F.G * NWAVES * 64;
    for (int it = gt; it < S * (POOLW / 8); it += NT) {
        const int t = it >> 8, c = it & 255, g = c >> 6, hw = 1 << g;
        const int lo = (t - hw) < 0 ? 0 : (t - hw), hi = (t + hw) > S ? S : (t + hw);
        float acc[8] = {0.f, 0.f, 0.f, 0.f, 0.f, 0.f, 0.f, 0.f};
        for (int r = lo; r < hi; ++r) { const u32x4 w = *(const GAS u32x4*)(U + (size_t)r * POOLW + 8 * c);
            acc[0] += bf_lo(w.x); acc[1] += bf_hi(w.x); acc[2] += bf_lo(w.y); acc[3] += bf_hi(w.y); acc[4] += bf_lo(w.z); acc[5] += bf_hi(w.z); acc[6] += bf_lo(w.w); acc[7] += bf_hi(w.w); }
        const u32x4 w = *(const GAS u32x4*)(U + (size_t)t * POOLW + 8 * c);
        const float inv = 1.0f / (float)(hi - lo);
        const float me[8] = {bf_lo(w.x), bf_hi(w.x), bf_lo(w.y), bf_hi(w.y), bf_lo(w.z), bf_hi(w.z), bf_lo(w.w), bf_hi(w.w)};
        float d[8];
#pragma unroll
        for (int j = 0; j < 8; ++j) d[j] = acc[j] * inv - me[j];
        u32x4 ow; ow.x = cvt_pk_bf16(d[0], d[1]); ow.y = cvt_pk_bf16(d[2], d[3]); ow.z = cvt_pk_bf16(d[4], d[5]); ow.w = cvt_pk_bf16(d[6], d[7]);
        *(GAS u32x4*)(DL + (size_t)t * POOLW + 8 * c) = ow;
    }
}

__device__ __forceinline__ double inv_freq_of(int i) {
    const double step = 0.74989420933245582730;
    double r = 1.0; for (int k = 0; k < i; ++k) r *= step; return r;
}

typedef const __attribute__((address_space(4))) Args CArgs;
__device__ __forceinline__ CArgs* fresh_args() { CArgs* p = (CArgs*)__builtin_amdgcn_kernarg_segment_ptr(); asm volatile("" : "+s"(p)); return p; }
#define WSP(off) ((bf16_t*)(ws + (off)))

__global__ void __launch_bounds__(NWAVES * 64, 2) fwd_kernel(Args args) {
    extern __shared__ __attribute__((aligned(16))) unsigned char lds[];
    LAS unsigned char* const L = (LAS unsigned char*)lds;
    for (int u = threadIdx.x; u < (LDS_BYTES - LDSCTL_OFF) / 4; u += NWAVES * 64) ((LAS unsigned*)(L + LDSCTL_OFF))[u] = 0u;
    __syncthreads();
    unsigned* const barw = (unsigned*)(args.ws + WS_CTL) + CW_BAR;
    XcdBarrier bar; bar.bar = barw; bar.x = 0; bar.st = nullptr;
    if (N_LAUNCHES == 1) bar = xcd_barrier_post(barw, (volatile LAS unsigned*)(L + MISC_OFF) + 8);
#define GRID_BAR() do { if (N_LAUNCHES == 1) xcd_barrier(bar); } while (0)
    const int lo = args.ph_lo, hi = args.ph_hi;
#define IN(k) (lo <= (k) && (k) < hi)
#define SEAM(k) do { if (IN(k) && IN((k) + 1)) GRID_BAR(); } while (0)

    if (IN(0)) {
        CArgs* ap = fresh_args(); unsigned char* ws = ap->ws; Frame F = make_frame(L);
        LAS float* scr = (LAS float*)(F.lds + RING_OFF + F.wave * 16384);
        const int gw = F.vcu * NWAVES + F.wave, NGW = F.G * NWAVES;
        constexpr int I_IN = (DM / 64) * (INW / 32), I_POOL = (PGI / 64) * (PGO / 32), I_OUT = (DM / 64) * (DM / 32), I_GU = (DM / 64) * (FF / 32), I_DOWN = (FF / 64) * (DM / 32), I_PIN = (DPLE / 64) * (DM / 32);
        constexpr int I_LAYER = I_IN + 4 * I_POOL + I_OUT + 2 * I_GU + I_DOWN + I_PIN + I_OUT;
        for (int rep = 0; rep < REP_CONV; ++rep)
        for (int it = gw; it < DEPTH * I_LAYER; it += NGW) {
            const int l = it / I_LAYER; int r = it % I_LAYER;
            unsigned char* wl = ws + WS_W + (size_t)l * LW_BYTES;
            if (r < I_IN) { p0_transpose_item<0>(ap->in[2] + (size_t)l * DM * INW, DM, INW, (bf16_t*)(wl + LW_IN), 0, scr, r, F.lane); continue; } r -= I_IN;
            if (r < 4 * I_POOL) { const int g = r / I_POOL; p0_transpose_item<0>(ap->in[5] + ((size_t)l * 4 + g) * PGI * PGO, PGI, PGO, (bf16_t*)(wl + LW_POOL), g * PGO, scr, r % I_POOL, F.lane); continue; } r -= 4 * I_POOL;
            if (r < I_OUT) { p0_transpose_item<0>(ap->in[7] + (size_t)l * DM * DM, DM, DM, (bf16_t*)(wl + LW_OUT), 0, scr, r, F.lane); continue; } r -= I_OUT;
            if (r < I_GU) { p0_transpose_item<1>(ap->in[12] + (size_t)l * DM * FF, DM, FF, (bf16_t*)(wl + LW_GU), 0, scr, r, F.lane); continue; } r -= I_GU;
            if (r < I_GU) { p0_transpose_item<1>(ap->in[13] + (size_t)l * DM * FF, DM, FF, (bf16_t*)(wl + LW_GU), 128, scr, r, F.lane); continue; } r -= I_GU;
            if (r < I_DOWN) { p0_transpose_item<0>(ap->in[14] + (size_t)l * FF * DM, FF, DM, (bf16_t*)(wl + LW_DOWN), 0, scr, r, F.lane); continue; } r -= I_DOWN;
            if (r < I_PIN) { p0_transpose_item<0>(ap->in[15] + (size_t)l * DPLE * DM, DPLE, DM, (bf16_t*)(wl + LW_PIN), 0, scr, r, F.lane); continue; } r -= I_PIN;
            p0_transpose_item<0>(ap->in[16] + (size_t)l * DM * DM, DM, DM, (bf16_t*)(wl + LW_PG), 0, scr, r, F.lane);
        }
        { const int gt = F.vcu * (NWAVES * 64) + F.tid, NT = F.G * NWAVES * 64;
          const float* p_in = ap->in[1]; bf16_t* PB = WSP(WS_PB); float* rope = (float*)(ws + WS_ROPE);
          for (int i = gt; i < DEPTH * S * DPLE / 8; i += NT) { const f32x4 a = *(const GAS f32x4*)(p_in + (size_t)i * 8), b = *(const GAS f32x4*)(p_in + (size_t)i * 8 + 4);
              u32x4 o; o.x = cvt_pk_bf16(a.x, a.y); o.y = cvt_pk_bf16(a.z, a.w); o.z = cvt_pk_bf16(b.x, b.y); o.w = cvt_pk_bf16(b.z, b.w); *(GAS u32x4*)(PB + (size_t)i * 8) = o; }
          for (int i = gt; i < 128 * 32; i += NT) { const int pos = i >> 5, fi = i & 31;
              const double ang = (double)pos * inv_freq_of(fi); const double k = __builtin_rint(ang * 0.15915494309189533577); const double r = ang - k * 6.283185307179586476925;
              const float rf = (float)r; rope[2 * i] = cosf(rf); rope[2 * i + 1] = sinf(rf); }
        }
        norm_pass(F, ap->in[0], nullptr, nullptr, nullptr, ap->in[8], WSP(WS_H), 2);
    }
    SEAM(0);

    for (int l = 0; l < DEPTH; ++l) {
        const int pb = 1 + 11 * l;
        if (IN(pb + 0)) {
            CArgs* ap = fresh_args(); unsigned char* ws = ap->ws; Frame F = make_frame(L); unsigned char* wl = ws + WS_W + (size_t)l * LW_BYTES;
            for (int rep = 0; rep < REP_G1; ++rep) { pg8::Gemm g{WSP(WS_H), (const bf16_t*)(wl + LW_IN), S, INW, DM, DM, DM, 0}; pg8::StaticOrder So; So.init(S, INW, F.G, F.bx);
              pg8::EpiZ E{WSP(WS_Q), WSP(WS_K), WSP(WS_V), WSP(WS_U), WSP(WS_GA), WSP(WS_GP)};
              pg8::gemm_phase<pg8::EpiZ, pg8::StaticOrder, G_ALIGN, G_SP2>(F.lds + RING_OFF, g, So, E); }
            if (l == 0) {
                for (int l2 = 0; l2 < DEPTH; ++l2) {
                    pg8::Gemm g2{WSP(WS_PB) + (size_t)l2 * S * DPLE, (const bf16_t*)(ws + WS_W + (size_t)l2 * LW_BYTES + LW_PIN), S, DM, DPLE, DPLE, DPLE, 0}; pg8::StaticOrder S2; S2.init(S, DM, F.G, F.bx);
                    pg8::EpiPlain E2{WSP(WS_E) + (size_t)l2 * S * DM, DM};
                    pg8::gemm_phase<pg8::EpiPlain, pg8::StaticOrder, G_ALIGN, G_SP2>(F.lds + RING_OFF, g2, S2, E2);
                }
            }
        }
        SEAM(pb + 0);
        if (IN(pb + 1)) {
            CArgs* ap = fresh_args(); unsigned char* ws = ap->ws; Frame F = make_frame(L);
            for (int rep = 0; rep < REP_T2; ++rep) {
            qk_norm_rope_pass(F, WSP(WS_Q), WSP(WS_K), WSP(WS_Q2), WSP(WS_K2), ap->in[3] + l * HD, ap->in[4] + l * HD, (const float*)(ws + WS_ROPE));
            pool_delta_pass(F, WSP(WS_U), WSP(WS_DL)); }
        }
        SEAM(pb + 1);
        if (IN(pb + 2)) {
            CArgs* ap = fresh_args(); unsigned char* ws = ap->ws; Frame F = make_frame(L);
            for (int rep = 0; rep < REP_ATT; ++rep)
            for (int U0 = F.vcu; U0 < NH * (S / 256); U0 += F.G) {
                const int a = U0 >> 8, b = (U0 >> 5) & 7, c = U0 & 31, h = 4 * b + a, qb = c, kvh = h >> 2;
                att::attn_dense_body(WSP(WS_Q2) + (size_t)qb * 256 * DM + h * HD, WSP(WS_K2) + kvh * HD, WSP(WS_V) + kvh * HD, WSP(WS_O) + (size_t)qb * 256 * DM + h * HD, S, (LAS char*)(F.lds + RING_OFF));
                __syncthreads();
            }
        }
        SEAM(pb + 2);
        if (IN(pb + 3)) {
            CArgs* ap = fresh_args(); unsigned char* ws = ap->ws; Frame F = make_frame(L); unsigned char* wl = ws + WS_W + (size_t)l * LW_BYTES;
            pg8::Gemm g{WSP(WS_DL), (const bf16_t*)(wl + LW_POOL), S, DM, PGI, POOLW, PGI, PGI}; pg8::StaticOrder So; So.init(S, DM, F.G, F.bx);
            pg8::EpiPool E{WSP(WS_MG), WSP(WS_O), WSP(WS_GA), WSP(WS_GP), ap->in[6] + (size_t)l * DM, DM};
            for (int rep = 0; rep < REP_SMALLG; ++rep)
            pg8::gemm_phase<pg8::EpiPool, pg8::StaticOrder, G_ALIGN, G_SP2>(F.lds + RING_OFF, g, So, E);
        }
        SEAM(pb + 3);
        if (IN(pb + 4)) {
            CArgs* ap = fresh_args(); unsigned char* ws = ap->ws; Frame F = make_frame(L); unsigned char* wl = ws + WS_W + (size_t)l * LW_BYTES;
            pg8::Gemm g{WSP(WS_MG), (const bf16_t*)(wl + LW_OUT), S, DM, DM, DM, DM, 0}; pg8::StaticOrder So; So.init(S, DM, F.G, F.bx);
            pg8::EpiPlain E{WSP(WS_Y), DM};
            for (int rep = 0; rep < REP_SMALLG; ++rep)
            pg8::gemm_phase<pg8::EpiPlain, pg8::StaticOrder, G_ALIGN, G_SP2>(F.lds + RING_OFF, g, So, E);
        }
        SEAM(pb + 4);
        if (IN(pb + 5)) {
            CArgs* ap = fresh_args(); unsigned char* ws = ap->ws; Frame F = make_frame(L);
            norm_pass(F, l == 0 ? ap->in[0] : (const float*)ap->out, ap->out, WSP(WS_Y), ap->in[9] + (size_t)l * DM, ap->in[10] + (size_t)l * DM, WSP(WS_H), 2);
        }
        SEAM(pb + 5);
        if (IN(pb + 6)) {
            CArgs* ap = fresh_args(); unsigned char* ws = ap->ws; Frame F = make_frame(L); unsigned char* wl = ws + WS_W + (size_t)l * LW_BYTES;
            pg8::Gemm g{WSP(WS_H), (const bf16_t*)(wl + LW_GU), S, 2 * FF, DM, DM, DM, 0}; pg8::StaticOrder So; So.init(S, 2 * FF, F.G, F.bx);
            pg8::EpiSwiglu E{WSP(WS_F), FF};
            for (int rep = 0; rep < REP_G3; ++rep)
            pg8::gemm_phase<pg8::EpiSwiglu, pg8::StaticOrder, G_ALIGN, G_SP2>(F.lds + RING_OFF, g, So, E);
        }
        SEAM(pb + 6);
        if (IN(pb + 7)) {
            CArgs* ap = fresh_args(); unsigned char* ws = ap->ws; Frame F = make_frame(L); unsigned char* wl = ws + WS_W + (size_t)l * LW_BYTES;
            pg8::Gemm g{WSP(WS_F), (const bf16_t*)(wl + LW_DOWN), S, DM, FF, FF, FF, 0}; pg8::StaticOrder So; So.init(S, DM, F.G, F.bx);
            pg8::EpiPlain E{WSP(WS_Y), DM};
            for (int rep = 0; rep < REP_G4; ++rep)
            pg8::gemm_phase<pg8::EpiPlain, pg8::StaticOrder, G_ALIGN, G_SP2>(F.lds + RING_OFF, g, So, E);
        }
        SEAM(pb + 7);
        if (IN(pb + 8)) {
            CArgs* ap = fresh_args(); unsigned char* ws = ap->ws; Frame F = make_frame(L);
            for (int rep = 1; rep < REP_THIN; ++rep) norm_pass(F, ap->out, (float*)(ws + WS_Q), WSP(WS_Y), ap->in[11] + (size_t)l * DM, ap->in[11] + (size_t)l * DM, WSP(WS_Q2), 2);
            norm_pass(F, ap->out, ap->out, WSP(WS_Y), ap->in[11] + (size_t)l * DM, nullptr, WSP(WS_H), 1);
        }
        SEAM(pb + 8);
        if (IN(pb + 9)) {
            CArgs* ap = fresh_args(); unsigned char* ws = ap->ws; Frame F = make_frame(L); unsigned char* wl = ws + WS_W + (size_t)l * LW_BYTES;
            pg8::Gemm g{WSP(WS_H), (const bf16_t*)(wl + LW_PG), S, DM, DM, DM, DM, 0}; pg8::StaticOrder So; So.init(S, DM, F.G, F.bx);
            pg8::EpiPle E{WSP(WS_Y), WSP(WS_E) + (size_t)l * S * DM, DM};
            for (int rep = 0; rep < REP_SMALLG; ++rep)
            pg8::gemm_phase<pg8::EpiPle, pg8::StaticOrder, G_ALIGN, G_SP2>(F.lds + RING_OFF, g, So, E);
        }
        SEAM(pb + 9);
        if (IN(pb + 10)) {
            CArgs* ap = fresh_args(); unsigned char* ws = ap->ws; Frame F = make_frame(L);
            if (l + 1 < DEPTH) norm_pass(F, ap->out, ap->out, WSP(WS_Y), ap->in[17] + (size_t)l * DM, ap->in[8] + (size_t)(l + 1) * DM, WSP(WS_H), 2);
            else norm_pass(F, ap->out, ap->out, WSP(WS_Y), ap->in[17] + (size_t)l * DM, nullptr, nullptr, 0);
        }
        SEAM(pb + 10);
    }
#undef IN
#undef SEAM
#undef GRID_BAR
}

extern "C" void kernel_launch(void* const* d_in, const int* in_sizes, int n_in, void* d_out, int out_size, void* d_ws, size_t ws_size, hipStream_t stream) {
    static int grid = 0;
    if (grid == 0) {
        if (n_in != 18 || in_sizes[0] != S * DM || out_size != S * DM || ws_size < WS_END) { fprintf(stderr, "kernel_launch: shape/workspace mismatch: n_in %d in0 %d out %d ws %zu (need %zu)\n", n_in, n_in > 0 ? in_sizes[0] : -1, out_size, ws_size, (size_t)WS_END); grid = -1; return; }
        int dev = 0, cus = 0, per_cu = 0;
        if (hipGetDevice(&dev) != hipSuccess || hipDeviceGetAttribute(&cus, hipDeviceAttributeMultiprocessorCount, dev) != hipSuccess) { grid = -1; return; }
        if (hipFuncSetAttribute((const void*)fwd_kernel, hipFuncAttributeMaxDynamicSharedMemorySize, LDS_BYTES) != hipSuccess) { fprintf(stderr, "kernel_launch: hipFuncSetAttribute failed\n"); grid = -1; return; }
        if (hipOccupancyMaxActiveBlocksPerMultiprocessor(&per_cu, (const void*)fwd_kernel, NWAVES * 64, LDS_BYTES) != hipSuccess || per_cu < 1) { fprintf(stderr, "kernel_launch: occupancy query says %d blocks per CU\n", per_cu); }
        (void)hipGetLastError();
        grid = cus;
    }
    if (grid < 0) return;
    if (hipMemsetAsync((char*)d_ws + WS_CTL, 0, CTL_ZERO_BYTES, stream) != hipSuccess) return;
    Args a{};
    for (int i = 0; i < 18; ++i) a.in[i] = (const float*)d_in[i];
    a.out = (float*)d_out; a.ws = (unsigned char*)d_ws;
    for (int li = 0; li < N_LAUNCHES; ++li) {
        a.ph_lo = (N_LAUNCHES == 1) ? 0 : li; a.ph_hi = (N_LAUNCHES == 1) ? N_PHASES : li + 1;
        hipLaunchKernelGGL(fwd_kernel, dim3(grid), dim3(NWAVES * 64), LDS_BYTES, stream, a);
        const hipError_t le = hipPeekAtLastError();
        if (le != hipSuccess) { fprintf(stderr, "kernel_launch: launch %d failed: %s\n", li, hipGetErrorName(le)); break; }
    }
}
```

```cpp
#include <hip/hip_runtime.h>
#include <cstdio>
#include <cstdint>

#ifndef MK_N_LAUNCHES
#define MK_N_LAUNCHES 1
#endif

#ifndef G_SP2
#define G_SP2 true
#endif
#ifndef G_ALIGN
#define G_ALIGN true
#endif
#ifndef REP_CONV
#define REP_CONV 1
#endif
#ifndef REP_G1
#define REP_G1 1
#endif
#ifndef REP_ATT
#define REP_ATT 1
#endif
#ifndef REP_G3
#define REP_G3 1
#endif
#ifndef REP_G4
#define REP_G4 1
#endif
#ifndef REP_T2
#define REP_T2 1
#endif
#ifndef REP_THIN
#define REP_THIN 1
#endif
#ifndef REP_SMALLG
#define REP_SMALLG 1
#endif

#define LAS __attribute__((address_space(3)))
#define GAS __attribute__((address_space(1)))
typedef unsigned short bf16_t;
typedef short bf16x8 __attribute__((ext_vector_type(8)));
typedef short s16x4 __attribute__((ext_vector_type(4)));
typedef float f32x4 __attribute__((ext_vector_type(4)));
typedef float f32x2 __attribute__((ext_vector_type(2)));
typedef float f32x16 __attribute__((ext_vector_type(16)));
typedef unsigned u32x4 __attribute__((ext_vector_type(4)));
typedef unsigned u32x2 __attribute__((ext_vector_type(2)));

constexpr int S = 8192, DM = 4096, DEPTH = 2;
constexpr int NH = 32, NKV = 8, HD = 128;
constexpr int KVW = NKV * HD;
constexpr int POOLW = 2048, PGI = 512, PGO = 1024;
constexpr int INW = 16384;
constexpr int FF = 11008;
constexpr int DPLE = 256;
constexpr float EPS = 1e-6f;

__device__ __forceinline__ unsigned cvt_pk_bf16(float lo, float hi) { unsigned r; asm volatile("v_cvt_pk_bf16_f32 %0, %1, %2" : "=v"(r) : "v"(lo), "v"(hi)); return r; }
__device__ __forceinline__ float bf_lo(unsigned w) { return __uint_as_float(w << 16); }
__device__ __forceinline__ float bf_hi(unsigned w) { return __uint_as_float(w & 0xffff0000u); }
__device__ __forceinline__ float sigmoid_f(float v) { return __builtin_amdgcn_rcpf(1.0f + __builtin_amdgcn_exp2f(v * -1.4426950408889634f)); }

namespace pg8 {
constexpr int BM = 256, BK = 64, HALF = 128, HTB = HALF * BK * 2  , STAGE_BYTES = 8 * HTB, NXCD = 8, WGM = 8;

__host__ __device__ __forceinline__ int lds_byte(int r, int c) { const int st = (r >> 4) * 2 + (c >> 5), rr = r & 15, cc = c & 31, ob = rr * 64 + cc * 2; return st * 1024 + (ob ^ (((ob >> 9) & 1) << 5)); }
__host__ __device__ __forceinline__ void stage_rc(int b, int& R, int& C) { const int st = b / 1024, sb = b % 1024, swz = sb ^ (((sb >> 9) & 1) << 5); R = (st >> 1) * 16 + swz / 64; C = (st & 1) * 32 + (swz % 64) / 2; }
__host__ __device__ __forceinline__ int perm32(int rho) { const int n = rho >> 4, i = rho & 15; return 8 * (i >> 2) + 4 * n + (i & 3); }

struct Unit { int pm, pn; };
struct Gemm { const bf16_t* A; const bf16_t* Bt; int M, N, K, lda, ldb, agrp; };

struct StaticOrder {
    int nM, nN, nwg, G, c;
    __host__ __device__ void init(int M, int N, int G_, int c_) { nM = M / BM; nN = N / BM; nwg = nM * nN; G = G_; c = c_; }
    __host__ __device__ bool next(int i, Unit& u) const {
        const long L = (long)i * G + c; if (L >= nwg) return false;
        int wgid = (int)L; { const int q = nwg / NXCD, r = nwg % NXCD, xcd = wgid % NXCD, off = wgid / NXCD; wgid = (xcd < r ? xcd * (q + 1) : r * (q + 1) + (xcd - r) * q) + off; }
        const int nig = WGM * nN, gid = wgid / nig, fm = gid * WGM, gsz = (nM - fm) < WGM ? (nM - fm) : WGM;
        u.pm = fm + ((wgid % nig) % gsz); u.pn = (wgid % nig) / gsz; return true;
    }
    __device__ __forceinline__ void a_ready(const Unit&) const {}
    __device__ __forceinline__ void done(const Unit&) const {}
};

__device__ __forceinline__ u32x4 pack8(const f32x4 v0, const f32x4 v1) { u32x4 w; w.x = cvt_pk_bf16(v0[0], v0[1]); w.y = cvt_pk_bf16(v0[2], v0[3]); w.z = cvt_pk_bf16(v1[0], v1[1]); w.w = cvt_pk_bf16(v1[2], v1[3]); return w; }

struct EpiPlain {
    static constexpr bool PERM = true, AFTER_DRAIN = false;
    bf16_t* O; int ldc;
    __device__ __forceinline__ void operator()(const f32x4 (&acc)[2][2][4][2], const Unit& u, int wr, int wc, int fr, int fq) const {
        const int row0 = u.pm * BM + wr * 64 + fr, col0 = u.pn * BM + wc * 32 + 8 * fq;
#pragma unroll
        for (int ai = 0; ai < 2; ++ai)
#pragma unroll
            for (int m = 0; m < 4; ++m) { bf16_t* rowp = O + (size_t)(row0 + ai * HALF + m * 16) * ldc + col0;
#pragma unroll
                for (int bj = 0; bj < 2; ++bj) *(u32x4*)(rowp + bj * HALF) = pack8(acc[ai][bj][m][0], acc[ai][bj][m][1]); }
    }
};
struct EpiZ {
    static constexpr bool PERM = true, AFTER_DRAIN = false;
    bf16_t *Q, *Kb, *Vb, *U, *GA, *GP;
    __device__ __forceinline__ void operator()(const f32x4 (&acc)[2][2][4][2], const Unit& u, int wr, int wc, int fr, int fq) const {
        const int pn = u.pn; bf16_t* base; int ldc, ct; bool sg = false;
        if (pn < 16)      { base = Q;  ldc = DM;    ct = pn; }
        else if (pn < 20) { base = Kb; ldc = KVW;   ct = pn - 16; }
        else if (pn < 24) { base = Vb; ldc = KVW;   ct = pn - 20; }
        else if (pn < 32) { base = U;  ldc = POOLW; ct = pn - 24; }
        else if (pn < 48) { base = GA; ldc = DM;    ct = pn - 32; sg = true; }
        else              { base = GP; ldc = DM;    ct = pn - 48; sg = true; }
        const int row0 = u.pm * BM + wr * 64 + fr, col0 = ct * BM + wc * 32 + 8 * fq;
#pragma unroll
        for (int ai = 0; ai < 2; ++ai)
#pragma unroll
            for (int m = 0; m < 4; ++m) { bf16_t* rowp = base + (size_t)(row0 + ai * HALF + m * 16) * ldc + col0;
#pragma unroll
                for (int bj = 0; bj < 2; ++bj) { f32x4 v0 = acc[ai][bj][m][0], v1 = acc[ai][bj][m][1];
                    if (sg) {
#pragma unroll
                        for (int j = 0; j < 4; ++j) { v0[j] = sigmoid_f(v0[j]); v1[j] = sigmoid_f(v1[j]); } }
                    *(u32x4*)(rowp + bj * HALF) = pack8(v0, v1); } }
    }
};
struct EpiSwiglu {
    static constexpr bool PERM = true, AFTER_DRAIN = false;
    bf16_t* F; int ldc;
    __device__ __forceinline__ void operator()(const f32x4 (&acc)[2][2][4][2], const Unit& u, int wr, int wc, int fr, int fq) const {
        const int row0 = u.pm * BM + wr * 64 + fr, col0 = u.pn * HALF + wc * 32 + 8 * fq;
#pragma unroll
        for (int ai = 0; ai < 2; ++ai)
#pragma unroll
            for (int m = 0; m < 4; ++m) { bf16_t* rowp = F + (size_t)(row0 + ai * HALF + m * 16) * ldc + col0;
                f32x4 v0, v1;
#pragma unroll
                for (int j = 0; j < 4; ++j) { const float g0 = acc[ai][0][m][0][j], g1 = acc[ai][0][m][1][j];
                    v0[j] = g0 * sigmoid_f(g0) * acc[ai][1][m][0][j]; v1[j] = g1 * sigmoid_f(g1) * acc[ai][1][m][1][j]; }
                *(u32x4*)rowp = pack8(v0, v1); }
    }
};
__device__ __forceinline__ void unpack8(const u32x4 w, f32x4& a, f32x4& b) { a[0] = bf_lo(w.x); a[1] = bf_hi(w.x); a[2] = bf_lo(w.y); a[3] = bf_hi(w.y); b[0] = bf_lo(w.z); b[1] = bf_hi(w.z); b[2] = bf_lo(w.w); b[3] = bf_hi(w.w); }
struct EpiPle {
    static constexpr bool PERM = true, AFTER_DRAIN = false;
    bf16_t* Y; const bf16_t* E; int ldc;
    __device__ __forceinline__ void operator()(const f32x4 (&acc)[2][2][4][2], const Unit& u, int wr, int wc, int fr, int fq) const {
        const int row0 = u.pm * BM + wr * 64 + fr, col0 = u.pn * BM + wc * 32 + 8 * fq;
#pragma unroll
        for (int ai = 0; ai < 2; ++ai)
#pragma unroll
            for (int m = 0; m < 4; ++m) { const size_t off = (size_t)(row0 + ai * HALF + m * 16) * ldc + col0;
#pragma unroll
                for (int bj = 0; bj < 2; ++bj) { const u32x4 ew = *(const u32x4*)(E + off + bj * HALF); f32x4 e0, e1; unpack8(ew, e0, e1);
                    f32x4 v0 = acc[ai][bj][m][0], v1 = acc[ai][bj][m][1];
#pragma unroll
                    for (int j = 0; j < 4; ++j) { v0[j] = sigmoid_f(v0[j]) * e0[j]; v1[j] = sigmoid_f(v1[j]) * e1[j]; }
                    *(u32x4*)(Y + off + bj * HALF) = pack8(v0, v1); }
                asm volatile("" ::: "memory"); }
    }
};
struct EpiPool {
    static constexpr bool PERM = true, AFTER_DRAIN = false;
    bf16_t* MG; const bf16_t *O, *GA, *GP; const float* ps; int ldc;
    __device__ __forceinline__ void operator()(const f32x4 (&acc)[2][2][4][2], const Unit& u, int wr, int wc, int fr, int fq) const {
        const int row0 = u.pm * BM + wr * 64 + fr, col0 = u.pn * BM + wc * 32 + 8 * fq;
        f32x4 pv[2][2];
#pragma unroll
        for (int bj = 0; bj < 2; ++bj)
#pragma unroll
            for (int n = 0; n < 2; ++n) pv[bj][n] = *(const f32x4*)(ps + col0 + bj * HALF + 4 * n);
#pragma unroll
        for (int ai = 0; ai < 2; ++ai)
#pragma unroll
            for (int m = 0; m < 4; ++m) { const size_t off = (size_t)(row0 + ai * HALF + m * 16) * ldc + col0;
#pragma unroll
                for (int bj = 0; bj < 2; ++bj) {
                    const u32x4 ow = *(const u32x4*)(O + off + bj * HALF), aw = *(const u32x4*)(GA + off + bj * HALF), pw = *(const u32x4*)(GP + off + bj * HALF);
                    f32x4 o0, o1, a0, a1, p0, p1; unpack8(ow, o0, o1); unpack8(aw, a0, a1); unpack8(pw, p0, p1);
                    const f32x4 v0 = a0 * o0 + p0 * (acc[ai][bj][m][0] * pv[bj][0]), v1 = a1 * o1 + p1 * (acc[ai][bj][m][1] * pv[bj][1]);
                    *(u32x4*)(MG + off + bj * HALF) = pack8(v0, v1); }
                asm volatile("" ::: "memory"); }
    }
};

template <class Epi, class Sched, bool ALIGN_EPI = false, bool SP2 = false>
__device__ __forceinline__ void gemm_phase(LAS unsigned char* lds, const Gemm g, const Sched& S, const Epi& E) {
    int tid_ = threadIdx.x; asm volatile("" : "+v"(tid_));
    const int tid = tid_, wid = __builtin_amdgcn_readfirstlane(tid >> 6), lane = tid & 63, wr = wid >> 2, wc = wid & 3, fr = lane & 15, fq = lane >> 4;
    const int K = g.K, nt = K / BK;
    unsigned voffA[2], voffB[2];
#pragma unroll
    for (int i = 0; i < 2; ++i) { int R, C; stage_rc(tid * 16 + i * 8192, R, C); const int Rb = Epi::PERM ? ((R & ~31) + perm32(R & 31)) : R;
        voffA[i] = (unsigned)(R * g.lda + C) * 2u; voffB[i] = (unsigned)(Rb * g.ldb + C) * 2u; }
    const size_t kstep = (size_t)(BK * 2);
    const size_t hstepA = (size_t)HALF * g.lda * 2, hstepB = (size_t)HALF * g.ldb * 2;
    const size_t tstepA = 2 * hstepA, tstepB = 2 * hstepB;
    const unsigned ldsw = (unsigned)wid * 1024u;
    const int aoff = lds_byte(wr * 64 + fr, fq * 8), boff = lds_byte(wc * 32 + fr, fq * 8);
#define PG8_SA(b, h) (((b) * 2 + (h)) * HTB)
#define PG8_SB(b, h) ((4 + (b) * 2 + (h)) * HTB)
#define PG8_STAGE(bufoff, gbase, voff) do { _Pragma("unroll") for (int _i = 0; _i < 2; ++_i) \
        __builtin_amdgcn_global_load_lds((const unsigned*)((const char*)(gbase) + (voff)[_i]), (LAS unsigned*)(lds + (bufoff) + ldsw + _i * 8192), 16, 0, 0); } while (0)
#define PG8_LDA(dst, b, h) do { _Pragma("unroll") for (int m = 0; m < 4; ++m) _Pragma("unroll") for (int k = 0; k < 2; ++k) dst[m][k] = *(const LAS bf16x8*)(lds + PG8_SA(b, h) + aoff + m * 2048 + k * 1024); } while (0)
#define PG8_LDB(dst, b, h) do { _Pragma("unroll") for (int n = 0; n < 2; ++n) _Pragma("unroll") for (int k = 0; k < 2; ++k) dst[n][k] = *(const LAS bf16x8*)(lds + PG8_SB(b, h) + boff + n * 2048 + k * 1024); } while (0)
#define PG8_MMA(ai, bj, At, Bt) do { __builtin_amdgcn_s_setprio(1); _Pragma("unroll") for (int m = 0; m < 4; ++m) _Pragma("unroll") for (int n = 0; n < 2; ++n) _Pragma("unroll") for (int k = 0; k < 2; ++k) \
        acc[ai][bj][m][n] = __builtin_amdgcn_mfma_f32_16x16x32_bf16(Bt[n][k], At[m][k], acc[ai][bj][m][n], 0, 0, 0); __builtin_amdgcn_s_setprio(0); } while (0)
#define PG8_WAIT_V(n) asm volatile("s_waitcnt vmcnt(" #n ")" ::: "memory")
#define PG8_WAIT_L(n) asm volatile("s_waitcnt lgkmcnt(" #n ")" ::: "memory")
#define PG8_BAR __builtin_amdgcn_s_barrier()
#define PG8_SCHED __builtin_amdgcn_sched_barrier(0)
    Unit cur, nxt; int ui = 0;
    if (!S.next(0, cur)) return;
    f32x4 acc[2][2][4][2];
#pragma unroll
    for (int a = 0; a < 2; ++a)
#pragma unroll
        for (int b = 0; b < 2; ++b)
#pragma unroll
            for (int m = 0; m < 4; ++m)
#pragma unroll
                for (int n = 0; n < 2; ++n) acc[a][b][m][n] = (f32x4){0.f, 0.f, 0.f, 0.f};
    bf16x8 At[4][2], B0[2][2], B1[2][2];
    const char* cA = (const char*)g.A + (size_t)cur.pm * tstepA + (size_t)(cur.pn >> 2) * g.agrp * 2; const char* cB = (const char*)g.Bt + (size_t)cur.pn * tstepB;
    S.a_ready(cur);
    if constexpr (SP2) {
        PG8_STAGE(PG8_SB(0, 0), cB, voffB); PG8_STAGE(PG8_SB(0, 1), cB + hstepB, voffB); PG8_STAGE(PG8_SA(0, 0), cA, voffA); PG8_STAGE(PG8_SA(0, 1), cA + hstepA, voffA);
        if (wr == 1) PG8_BAR;
        PG8_WAIT_V(2); PG8_BAR;
        PG8_STAGE(PG8_SB(1, 0), cB + kstep, voffB); PG8_STAGE(PG8_SA(1, 0), cA + kstep, voffA); PG8_STAGE(PG8_SB(1, 1), cB + hstepB + kstep, voffB);
        PG8_WAIT_V(6); PG8_BAR;
    } else {
        PG8_STAGE(PG8_SB(0, 0), cB, voffB); PG8_STAGE(PG8_SA(0, 0), cA, voffA); PG8_STAGE(PG8_SB(0, 1), cB + hstepB, voffB); PG8_STAGE(PG8_SA(0, 1), cA + hstepA, voffA);
        if (wr == 1) PG8_BAR;
        PG8_WAIT_V(4); PG8_BAR;
        PG8_STAGE(PG8_SB(1, 0), cB + kstep, voffB); PG8_STAGE(PG8_SA(1, 0), cA + kstep, voffA); PG8_STAGE(PG8_SB(1, 1), cB + hstepB + kstep, voffB);
        PG8_WAIT_V(6); PG8_BAR;
    }
    for (;;) {
        const bool has_next = S.next(ui + 1, nxt);
        const char* nA = has_next ? (const char*)g.A + (size_t)nxt.pm * tstepA + (size_t)(nxt.pn >> 2) * g.agrp * 2 : cA; const char* nB = has_next ? (const char*)g.Bt + (size_t)nxt.pn * tstepB : cB;
        for (int t = 0; t < nt; t += 2) {
            const bool last = (t == nt - 2);
            const char* a1 = cA + (size_t)(t + 1) * kstep;
            const char* a2 = last ? nA : cA + (size_t)(t + 2) * kstep; const char* b2 = last ? nB : cB + (size_t)(t + 2) * kstep;
            const char* a3 = a2 + kstep; const char* b3 = b2 + kstep;
            if (last && has_next) S.a_ready(nxt);
            if constexpr (SP2) {
            PG8_LDB(B0, 0, 0); PG8_LDB(B1, 0, 1); PG8_SCHED; PG8_LDA(At, 0, 0); PG8_STAGE(PG8_SA(1, 1), a1 + hstepA, voffA);
            PG8_WAIT_V(8); PG8_WAIT_L(0); PG8_BAR; PG8_MMA(0, 0, At, B0); PG8_MMA(0, 1, At, B1); PG8_BAR; PG8_SCHED;
            PG8_LDA(At, 0, 1); PG8_STAGE(PG8_SB(0, 0), b2, voffB); PG8_STAGE(PG8_SB(0, 1), b2 + hstepB, voffB); PG8_STAGE(PG8_SA(0, 0), a2, voffA);
            PG8_WAIT_V(8); PG8_WAIT_L(0); PG8_BAR; PG8_MMA(1, 0, At, B0); PG8_MMA(1, 1, At, B1); PG8_BAR; PG8_SCHED;
            PG8_LDB(B0, 1, 0); PG8_LDB(B1, 1, 1); PG8_SCHED; PG8_LDA(At, 1, 0); PG8_STAGE(PG8_SA(0, 1), a2 + hstepA, voffA);
            PG8_WAIT_V(8); PG8_WAIT_L(0); PG8_BAR; PG8_MMA(0, 0, At, B0); PG8_MMA(0, 1, At, B1); PG8_BAR; PG8_SCHED;
            PG8_LDA(At, 1, 1); PG8_STAGE(PG8_SB(1, 0), b3, voffB); PG8_STAGE(PG8_SB(1, 1), b3 + hstepB, voffB); PG8_STAGE(PG8_SA(1, 0), a3, voffA);
            PG8_WAIT_V(8); PG8_WAIT_L(0); PG8_BAR; PG8_MMA(1, 0, At, B0); PG8_MMA(1, 1, At, B1); PG8_BAR; PG8_SCHED;
            } else {
            PG8_LDB(B0, 0, 0); PG8_SCHED; PG8_LDA(At, 0, 0); PG8_STAGE(PG8_SA(1, 1), a1 + hstepA, voffA);
            PG8_WAIT_L(8); PG8_BAR; PG8_WAIT_L(0); PG8_MMA(0, 0, At, B0); PG8_BAR; PG8_SCHED;
            PG8_LDB(B1, 0, 1); PG8_STAGE(PG8_SB(0, 0), b2, voffB);
            PG8_BAR; PG8_WAIT_L(0); PG8_MMA(0, 1, At, B1); PG8_BAR;
            PG8_LDA(At, 0, 1); PG8_STAGE(PG8_SA(0, 0), a2, voffA);
            PG8_BAR; PG8_WAIT_L(0); PG8_MMA(1, 0, At, B0); PG8_BAR; PG8_SCHED;
            PG8_STAGE(PG8_SB(0, 1), b2 + hstepB, voffB);
            PG8_WAIT_V(6); PG8_BAR; PG8_MMA(1, 1, At, B1); PG8_BAR;
            PG8_LDB(B0, 1, 0); PG8_SCHED; PG8_LDA(At, 1, 0); PG8_STAGE(PG8_SA(0, 1), a2 + hstepA, voffA);
            PG8_WAIT_L(8); PG8_BAR; PG8_WAIT_L(0); PG8_MMA(0, 0, At, B0); PG8_BAR; PG8_SCHED;
            PG8_LDB(B1, 1, 1); PG8_STAGE(PG8_SB(1, 0), b3, voffB);
            PG8_BAR; PG8_WAIT_L(0); PG8_MMA(0, 1, At, B1); PG8_BAR;
            PG8_LDA(At, 1, 1); PG8_STAGE(PG8_SA(1, 0), a3, voffA);
            PG8_BAR; PG8_WAIT_L(0); PG8_MMA(1, 0, At, B0); PG8_BAR; PG8_SCHED;
            PG8_STAGE(PG8_SB(1, 1), b3 + hstepB, voffB);
            PG8_WAIT_V(6); PG8_BAR; PG8_MMA(1, 1, At, B1); PG8_BAR;
            }
        }
        if constexpr (ALIGN_EPI) { if (wr == 0) PG8_BAR; }
        E(acc, cur, wr, wc, fr, fq); S.done(cur);
        if (!has_next) break;
#pragma unroll
        for (int a = 0; a < 2; ++a)
#pragma unroll
            for (int b = 0; b < 2; ++b)
#pragma unroll
                for (int m = 0; m < 4; ++m)
#pragma unroll
                    for (int n = 0; n < 2; ++n) acc[a][b][m][n] = (f32x4){0.f, 0.f, 0.f, 0.f};
        cur = nxt; cA = nA; cB = nB; ++ui;
        if constexpr (ALIGN_EPI) { if (wr == 1) PG8_BAR; }
    }
    PG8_WAIT_V(0);
    if constexpr (!ALIGN_EPI) { if (wr == 0) PG8_BAR; }
    PG8_BAR;
#undef PG8_SA
#undef PG8_SB
#undef PG8_STAGE
#undef PG8_LDA
#undef PG8_LDB
#undef PG8_MMA
#undef PG8_WAIT_V
#undef PG8_WAIT_L
#undef PG8_BAR
#undef PG8_SCHED
}
}

namespace att {
constexpr int D = 128, NW = 8, QBLK = 32, KVBLK = 64;
constexpr float SCALE = 0.088388347648318440f;
constexpr int LDQ = DM, LDK = KVW, LDO = DM;
constexpr int SHM_V = KVBLK * D * 2, SHM_K = KVBLK * D * 2, SHM_ATTN = 2 * SHM_V + 2 * SHM_K + NW * 64 * 4;
#define KSWZ(row, colB) ((row) * 256 + ((colB) ^ (((row) & 7) << 4)))
#define SBAR() __builtin_amdgcn_sched_barrier(0)
__device__ __forceinline__ int crow(int r, int hi) { return (r & 3) + 8 * (r >> 2) + 4 * hi; }
__device__ __forceinline__ unsigned cvtpk(float lo, float hi) { unsigned r; asm volatile("v_cvt_pk_bf16_f32 %0, %1, %2" : "=v"(r) : "v"(lo), "v"(hi)); return r; }

constexpr float THRL = 8.f;
#define MX3(a, b, c) __builtin_fmaxf(__builtin_fmaxf((a), (b)), (c))
template <bool FIRST>
__device__ __forceinline__ bool partialSM(f32x16& p0, f32x16& p1, float& mhat, f32x16& negm, float& l_reg, LAS float* al_l, int r32, int hi) {
  float a = MX3(p0[0], p0[1], p1[0]), b = MX3(p0[2], p0[3], p1[1]); a = MX3(a, p1[2], p1[3]);
#pragma unroll
  for (int r = 4; r < 16; r += 4) { a = MX3(a, p0[r], p0[r + 1]); b = MX3(b, p0[r + 2], p0[r + 3]); a = MX3(a, p1[r], p1[r + 1]); b = MX3(b, p1[r + 2], p1[r + 3]); }
  float rm = __builtin_fmaxf(a, b);
  { auto rr = __builtin_amdgcn_permlane32_swap(__float_as_uint(rm), __float_as_uint(rm), false, false);
    rm = __builtin_fmaxf(__uint_as_float(rr[0]), __uint_as_float(rr[1])); }
  bool resc = false;
  if (FIRST) { const float dl = rm; mhat = dl;
#pragma unroll
    for (int r = 0; r < 16; ++r) { p0[r] -= dl; p1[r] -= dl; }
#pragma unroll
    for (int r = 0; r < 16; ++r) negm[r] = -mhat;
    asm volatile("" : "+v"(negm));
  } else if (__builtin_expect(__any(rm > THRL), 0)) { const float dl = __builtin_fmaxf(rm, 0.f); mhat += dl;
#pragma unroll
    for (int r = 0; r < 16; ++r) { p0[r] -= dl; p1[r] -= dl; }
#pragma unroll
    for (int r = 0; r < 16; ++r) negm[r] = -mhat;
    asm volatile("" : "+v"(negm));
    const float f = __builtin_amdgcn_exp2f(-dl); l_reg *= f; if (hi == 0) al_l[r32] = f; resc = true; }
#pragma unroll
  for (int r = 0; r < 16; ++r) p0[r] = __builtin_amdgcn_exp2f(p0[r]);
  return resc;
}
#undef MX3
__device__ __forceinline__ void finishSM(f32x16& p0, f32x16& p1, float& l_reg, bf16x8& pa0, bf16x8& pa1, bf16x8& pa2, bf16x8& pa3) {
#pragma unroll
  for (int r = 0; r < 16; ++r) p1[r] = __builtin_amdgcn_exp2f(p1[r]);
  float ps = 0;
#pragma unroll
  for (int r = 0; r < 16; ++r) ps += p0[r];
#pragma unroll
  for (int r = 0; r < 16; ++r) ps += p1[r];
  l_reg += ps;
#define PK4(P, BASE, OUT) do { unsigned a0 = cvtpk(P[BASE + 0], P[BASE + 1]), a1 = cvtpk(P[BASE + 2], P[BASE + 3]);   \
    unsigned b0 = cvtpk(P[BASE + 4], P[BASE + 5]), b1 = cvtpk(P[BASE + 6], P[BASE + 7]);                              \
    auto r0 = __builtin_amdgcn_permlane32_swap(a0, b0, false, false); auto r1 = __builtin_amdgcn_permlane32_swap(a1, b1, false, false); \
    u32x4 w = {r0[0], r1[0], r0[1], r1[1]}; OUT = *reinterpret_cast<bf16x8*>(&w); } while (0)
  PK4(p0, 0, pa0); PK4(p0, 8, pa1); PK4(p1, 0, pa2); PK4(p1, 8, pa3);
#undef PK4
}
__device__ __forceinline__ void qkt(f32x16& p0, f32x16& p1, const LAS char* Ks, const bf16x8* qr, const f32x16& negm, int r32, int hi) {
#pragma unroll
  for (int d0 = 0; d0 < 8; ++d0) { int cb = (d0 * 16 + hi * 8) * 2;
    bf16x8 b0 = *reinterpret_cast<const LAS bf16x8*>(Ks + KSWZ(r32, cb));
    bf16x8 b1 = *reinterpret_cast<const LAS bf16x8*>(Ks + KSWZ(32 + r32, cb));
    if (d0 == 0) { p0 = __builtin_amdgcn_mfma_f32_32x32x16_bf16(b0, qr[0], negm, 0, 0, 0); p1 = __builtin_amdgcn_mfma_f32_32x32x16_bf16(b1, qr[0], negm, 0, 0, 0); }
    else { p0 = __builtin_amdgcn_mfma_f32_32x32x16_bf16(b0, qr[d0], p0, 0, 0, 0); p1 = __builtin_amdgcn_mfma_f32_32x32x16_bf16(b1, qr[d0], p1, 0, 0, 0); } }
}
__device__ __forceinline__ int v_st(int k, int c) { const int kk = (k & ~0xC) | ((k & 4) << 1) | ((k & 8) >> 1); return ((kk >> 3) * 4 + (c >> 5)) * 512 + ((kk & 7) * 32 + (c & 31)) * 2; }
__device__ __forceinline__ int v_rd_base(int lane) { return ((lane & 3) << 3) | (((lane >> 2) & 3) << 6) | (((lane >> 4) & 1) << 5) | (((lane >> 5) & 1) << 8); }
constexpr int v_rd_off(int d0, int ks, int half) { return d0 * 512 + ks * 4096 + half * 2048; }
template <int OFF> __device__ __forceinline__ s16x4 tr_read(int vb) {
  s16x4 r; asm volatile("ds_read_b64_tr_b16 %0, %1 offset:%2" : "=&v"(r) : "v"(vb), "i"(OFF) : "memory"); return r;
}
template <int D0> __device__ __forceinline__ void pv_one(f32x16& od, int vb, bf16x8 pa0, bf16x8 pa1, bf16x8 pa2, bf16x8 pa3) {
  const s16x4 l0 = tr_read<v_rd_off(D0, 0, 0)>(vb), h0 = tr_read<v_rd_off(D0, 0, 1)>(vb), l1 = tr_read<v_rd_off(D0, 1, 0)>(vb), h1 = tr_read<v_rd_off(D0, 1, 1)>(vb);
  const s16x4 l2 = tr_read<v_rd_off(D0, 2, 0)>(vb), h2 = tr_read<v_rd_off(D0, 2, 1)>(vb), l3 = tr_read<v_rd_off(D0, 3, 0)>(vb), h3 = tr_read<v_rd_off(D0, 3, 1)>(vb);
  asm volatile("s_waitcnt lgkmcnt(0)" ::: "memory"); SBAR();
#define PK(L, H) (bf16x8){L[0], L[1], L[2], L[3], H[0], H[1], H[2], H[3]}
  od = __builtin_amdgcn_mfma_f32_32x32x16_bf16(pa0, PK(l0, h0), od, 0, 0, 0);
  od = __builtin_amdgcn_mfma_f32_32x32x16_bf16(pa1, PK(l1, h1), od, 0, 0, 0);
  od = __builtin_amdgcn_mfma_f32_32x32x16_bf16(pa2, PK(l2, h2), od, 0, 0, 0);
  od = __builtin_amdgcn_mfma_f32_32x32x16_bf16(pa3, PK(l3, h3), od, 0, 0, 0);
#undef PK
}
__device__ __forceinline__ void pv_d0(f32x16* o, int vb, bf16x8 pa0, bf16x8 pa1, bf16x8 pa2, bf16x8 pa3) {
  pv_one<0>(o[0], vb, pa0, pa1, pa2, pa3); pv_one<1>(o[1], vb, pa0, pa1, pa2, pa3); pv_one<2>(o[2], vb, pa0, pa1, pa2, pa3); pv_one<3>(o[3], vb, pa0, pa1, pa2, pa3);
}
__device__ __forceinline__ void attn_dense_body(const bf16_t* __restrict__ Qb, const bf16_t* __restrict__ Kh, const bf16_t* __restrict__ Vh, bf16_t* __restrict__ Ob, int seq, LAS char* lds) {
  int tid_ = threadIdx.x; asm volatile("" : "+v"(tid_));
  const int tid = tid_, wid = tid >> 6, lane = tid & 63, r32 = lane & 31, hi = lane >> 5;
  LAS char* V_lds = lds; LAS char* K_lds = lds + 2 * SHM_V;
  LAS float* ws = (LAS float*)(lds + 2 * SHM_V + 2 * SHM_K) + wid * 64; LAS float* li_l = ws; LAS float* al_l = ws + 32;
  float mhat = 0.f, l_reg = 0; f32x16 o[4] = {}; bf16x8 qr[8]; f32x16 negm = f32x16{}; asm volatile("" : "+v"(negm));
  const bf16_t* Qw = Qb + (long)(wid * QBLK + r32) * LDQ + hi * 8;
#pragma unroll
  for (int d0 = 0; d0 < 8; ++d0) qr[d0] = *reinterpret_cast<const bf16x8*>(Qw + d0 * 16);
  const int sr = tid >> 4, sc = (tid & 15) * 8, vst0 = v_st(sr, sc), vst1 = v_st(32 + sr, sc);
  const int vb0 = (int)(unsigned)(uintptr_t)V_lds + v_rd_base(lane);
  struct { bf16x8 vs0, vs1, ks0, ks1; } sr_[2];
#define SLOAD(i, k0) do { sr_[i].vs0 = *reinterpret_cast<const bf16x8*>(&Vh[(long)((k0) + sr) * LDK + sc]); sr_[i].vs1 = *reinterpret_cast<const bf16x8*>(&Vh[(long)((k0) + 32 + sr) * LDK + sc]); \
    sr_[i].ks0 = *reinterpret_cast<const bf16x8*>(&Kh[(long)((k0) + sr) * LDK + sc]); sr_[i].ks1 = *reinterpret_cast<const bf16x8*>(&Kh[(long)((k0) + 32 + sr) * LDK + sc]); } while (0)
#define SWRITE(b, i) do { *(LAS bf16x8*)(V_lds + (b) * SHM_V + vst0) = sr_[i].vs0;          \
    *(LAS bf16x8*)(V_lds + (b) * SHM_V + vst1) = sr_[i].vs1; int kc = sc * 2;               \
    *(LAS bf16x8*)(K_lds + (b) * SHM_K + KSWZ(sr, kc)) = sr_[i].ks0;                       \
    *(LAS bf16x8*)(K_lds + (b) * SHM_K + KSWZ(32 + sr, kc)) = sr_[i].ks1; } while (0)
#define SWAIT() asm volatile("s_waitcnt vmcnt(4)" ::: "memory")
#define RESC(fl) do { if (fl) { asm volatile("s_waitcnt lgkmcnt(0)" ::: "memory"); \
    _Pragma("unroll") for (int d = 0; d < 4; ++d) _Pragma("unroll") for (int r = 0; r < 16; ++r) o[d][r] *= al_l[crow(r, hi)]; } } while (0)
  f32x16 pA0, pA1, pB0, pB1; bool rsA, rsB; bf16x8 pa0, pa1, pa2, pa3; const int NT = seq / KVBLK;
  constexpr int SE = 0, SO = 1;
  SLOAD(SE, 0); asm volatile("s_waitcnt vmcnt(0)" ::: "memory"); SWRITE(0, SE); __syncthreads();
  qkt(pA0, pA1, K_lds, qr, negm, r32, hi); (void)partialSM<true>(pA0, pA1, mhat, negm, l_reg, al_l, r32, hi);
  SLOAD(SO, KVBLK); if (2 < NT) SLOAD(SE, 2 * KVBLK);
  SWAIT(); SWRITE(1, SO); __syncthreads();
  for (int j = 1; j + 1 < NT; j += 2) {
    SBAR(); qkt(pB0, pB1, K_lds + SHM_K, qr, negm, r32, hi);
    finishSM(pA0, pA1, l_reg, pa0, pa1, pa2, pa3); SBAR();
    SLOAD(SO, (j + 2) * KVBLK); SBAR();
    pv_d0(o, vb0, pa0, pa1, pa2, pa3); rsB = partialSM<false>(pB0, pB1, mhat, negm, l_reg, al_l, r32, hi);
    __syncthreads(); SWAIT(); SWRITE(0, SE);
    RESC(rsB); __syncthreads();
    SBAR(); qkt(pA0, pA1, K_lds, qr, negm, r32, hi);
    finishSM(pB0, pB1, l_reg, pa0, pa1, pa2, pa3); SBAR();
    if (j + 3 < NT) SLOAD(SE, (j + 3) * KVBLK); SBAR();
    pv_d0(o, vb0 + SHM_V, pa0, pa1, pa2, pa3); rsA = partialSM<false>(pA0, pA1, mhat, negm, l_reg, al_l, r32, hi);
    __syncthreads(); SWAIT(); SWRITE(1, SO);
    RESC(rsA); __syncthreads();
  }
  SBAR(); qkt(pB0, pB1, K_lds + SHM_K, qr, negm, r32, hi);
  finishSM(pA0, pA1, l_reg, pa0, pa1, pa2, pa3); SBAR();
  pv_d0(o, vb0, pa0, pa1, pa2, pa3); rsB = partialSM<false>(pB0, pB1, mhat, negm, l_reg, al_l, r32, hi);
  __syncthreads(); RESC(rsB);
  finishSM(pB0, pB1, l_reg, pa0, pa1, pa2, pa3); SBAR();
  pv_d0(o, vb0 + SHM_V, pa0, pa1, pa2, pa3);
  { auto rr = __builtin_amdgcn_permlane32_swap(__float_as_uint(l_reg), __float_as_uint(l_reg), false, false); l_reg = __uint_as_float(rr[0]) + __uint_as_float(rr[1]); }
  if (hi == 0) li_l[r32] = l_reg; asm volatile("s_waitcnt lgkmcnt(0)" ::: "memory");
  float rli[16];
#pragma unroll
  for (int r = 0; r < 16; ++r) rli[r] = __builtin_amdgcn_rcpf(li_l[crow(r, hi)]);
  bf16_t* Ow = Ob + (long)(wid * QBLK) * LDO;
#pragma unroll
  for (int r = 0; r < 16; ++r) { const int orow = crow(r, hi);
#pragma unroll
    for (int d0 = 0; d0 < 4; ++d0) { const unsigned w = cvtpk(o[d0][r] * rli[r], 0.f); Ow[(long)orow * LDO + d0 * 32 + r32] = (bf16_t)(w & 0xffffu); } }
#undef SLOAD
#undef SWRITE
#undef SWAIT
#undef RESC
}

constexpr int RSLOT = 16384, RING_ATTN = 6 * RSLOT + NW * 64 * 4;
__device__ __forceinline__ void attn_ring_body(const bf16_t* __restrict__ Qb, const bf16_t* __restrict__ Kh, const bf16_t* __restrict__ Vh, bf16_t* __restrict__ Ob, int seq, LAS char* lds) {
  int tid_ = threadIdx.x; asm volatile("" : "+v"(tid_));
  const int tid = tid_, wid = __builtin_amdgcn_readfirstlane(tid >> 6), lane = tid & 63, r32 = lane & 31, hi = lane >> 5;
  LAS char* K_lds = lds; LAS char* V_lds = lds + 3 * RSLOT;
  LAS float* ws = (LAS float*)(lds + 6 * RSLOT) + wid * 64; LAS float* li_l = ws; LAS float* al_l = ws + 32;
  int koff[2], voff[2];
#pragma unroll
  for (int e = 0; e < 2; ++e) { const int i = 2 * wid + e;
    const int krow = 4 * i + (lane >> 4), cp = lane & 15, kc = cp ^ (krow & 7); koff[e] = krow * LDK + 8 * kc;
    const int sub = 2 * i + (lane >> 5), q = lane & 31, kk = (sub >> 2) * 8 + (q >> 2), c = (sub & 3) * 32 + (q & 3) * 8, k = (kk & ~0xC) | ((kk & 4) << 1) | ((kk & 8) >> 1); voff[e] = k * LDK + c; }
  const unsigned pdst = (unsigned)(2 * wid) * 1024u;
#define DMA_K(t, slot) do { _Pragma("unroll") for (int e = 0; e < 2; ++e) __builtin_amdgcn_global_load_lds((const unsigned*)(Kh + (long)(t) * KVBLK * LDK + koff[e]), (LAS unsigned*)(K_lds + (slot) + pdst + e * 1024), 16, 0, 0); } while (0)
#define DMA_V(t, slot) do { _Pragma("unroll") for (int e = 0; e < 2; ++e) __builtin_amdgcn_global_load_lds((const unsigned*)(Vh + (long)(t) * KVBLK * LDK + voff[e]), (LAS unsigned*)(V_lds + (slot) + pdst + e * 1024), 16, 0, 0); } while (0)
#define WAIT_BAR(N) asm volatile("s_waitcnt vmcnt(" #N ") lgkmcnt(0)\n\ts_barrier" ::: "memory")
  const int NT = seq / KVBLK;
  int cur = 0, nxt = RSLOT, nn = 2 * RSLOT;
#define ROT() do { const int t_ = cur; cur = nxt; nxt = nn; nn = t_; } while (0)
  DMA_K(0, 0); DMA_V(0, 0); DMA_K(1, RSLOT);
  float mhat = 0.f, l_reg = 0; f32x16 o[4] = {}; bf16x8 qr[8]; f32x16 negm = f32x16{}; asm volatile("" : "+v"(negm));
  const bf16_t* Qw = Qb + (long)(wid * QBLK + r32) * LDQ + hi * 8;
#pragma unroll
  for (int d0 = 0; d0 < 8; ++d0) qr[d0] = *reinterpret_cast<const bf16x8*>(Qw + d0 * 16);
  const int vb0 = (int)(unsigned)(uintptr_t)V_lds + v_rd_base(lane);
#define RESC(fl) do { if (fl) { asm volatile("s_waitcnt lgkmcnt(0)" ::: "memory"); \
    _Pragma("unroll") for (int d = 0; d < 4; ++d) _Pragma("unroll") for (int r = 0; r < 16; ++r) o[d][r] *= al_l[crow(r, hi)]; } } while (0)
  f32x16 pA0, pA1, pB0, pB1; bool rs; bf16x8 pa0, pa1, pa2, pa3;
  WAIT_BAR(0);
  qkt(pA0, pA1, K_lds + cur, qr, negm, r32, hi); (void)partialSM<true>(pA0, pA1, mhat, negm, l_reg, al_l, r32, hi);
  DMA_K(2, nn); DMA_V(1, nxt);
  WAIT_BAR(4); ROT();
#define ITER(X0, X1, Y0, Y1, t) do { \
    SBAR(); qkt(X0, X1, K_lds + cur, qr, negm, r32, hi); \
    finishSM(Y0, Y1, l_reg, pa0, pa1, pa2, pa3); SBAR(); \
    if ((t) + 2 < NT) DMA_K((t) + 2, nn); if ((t) + 1 < NT) DMA_V((t) + 1, nxt); SBAR(); \
    pv_d0(o, vb0 + nn, pa0, pa1, pa2, pa3); rs = partialSM<false>(X0, X1, mhat, negm, l_reg, al_l, r32, hi); \
    if ((t) + 2 < NT) WAIT_BAR(4); else if ((t) + 1 < NT) WAIT_BAR(2); else WAIT_BAR(0); \
    RESC(rs); ROT(); } while (0)
  int t = 1;
  for (; t + 1 < NT; t += 2) { ITER(pB0, pB1, pA0, pA1, t); ITER(pA0, pA1, pB0, pB1, t + 1); }
  ITER(pB0, pB1, pA0, pA1, t);
  finishSM(pB0, pB1, l_reg, pa0, pa1, pa2, pa3); SBAR();
  pv_d0(o, vb0 + nn, pa0, pa1, pa2, pa3);
  { auto rr = __builtin_amdgcn_permlane32_swap(__float_as_uint(l_reg), __float_as_uint(l_reg), false, false); l_reg = __uint_as_float(rr[0]) + __uint_as_float(rr[1]); }
  if (hi == 0) li_l[r32] = l_reg; asm volatile("s_waitcnt lgkmcnt(0)" ::: "memory");
  float rli[16];
#pragma unroll
  for (int r = 0; r < 16; ++r) rli[r] = __builtin_amdgcn_rcpf(li_l[crow(r, hi)]);
  bf16_t* Ow = Ob + (long)(wid * QBLK) * LDO;
#pragma unroll
  for (int r = 0; r < 16; ++r) { const int orow = crow(r, hi);
#pragma unroll
    for (int d0 = 0; d0 < 4; ++d0) { const unsigned w = cvtpk(o[d0][r] * rli[r], 0.f); Ow[(long)orow * LDO + d0 * 32 + r32] = (bf16_t)(w & 0xffffu); } }
  asm volatile("s_waitcnt lgkmcnt(0)\n\ts_barrier" ::: "memory");
#undef DMA_K
#undef DMA_V
#undef WAIT_BAR
#undef ROT
#undef RESC
#undef ITER
}
#undef SBAR
}

constexpr int NWAVES = 8;
constexpr int N_PHASES = 1 + 11 * DEPTH;
constexpr int N_LAUNCHES = MK_N_LAUNCHES;
static_assert(N_LAUNCHES == 1 || N_LAUNCHES == N_PHASES, "MK_N_LAUNCHES is 1 or 23");

constexpr size_t MiB = 1u << 20;
constexpr size_t WS_CTL = 0, CTL_ZERO_BYTES = 1 * MiB;
constexpr size_t WS_ROPE = 1 * MiB;
constexpr size_t WS_PB = 2 * MiB;
constexpr size_t WS_W = 16 * MiB;
constexpr size_t LW_IN = 0, LW_POOL = 128 * MiB, LW_OUT = 132 * MiB, LW_GU = 164 * MiB, LW_DOWN = 336 * MiB, LW_PIN = 422 * MiB, LW_PG = 424 * MiB, LW_BYTES = 456 * MiB;
constexpr size_t WS_ACT = WS_W + 2 * LW_BYTES;
constexpr size_t WS_H = WS_ACT;
constexpr size_t WS_Q = WS_H + 64 * MiB;
constexpr size_t WS_K = WS_Q + 64 * MiB;
constexpr size_t WS_V = WS_K + 16 * MiB;
constexpr size_t WS_U = WS_V + 16 * MiB;
constexpr size_t WS_GA = WS_U + 32 * MiB;
constexpr size_t WS_GP = WS_GA + 64 * MiB;
constexpr size_t WS_Q2 = WS_GP + 64 * MiB;
constexpr size_t WS_K2 = WS_Q2 + 64 * MiB;
constexpr size_t WS_DL = WS_K2 + 16 * MiB;
constexpr size_t WS_O = WS_DL + 32 * MiB;
constexpr size_t WS_MG = WS_O + 64 * MiB;
constexpr size_t WS_Y = WS_MG + 64 * MiB;
constexpr size_t WS_F = WS_Y + 64 * MiB;
constexpr size_t WS_E = WS_F + 172 * MiB;
constexpr size_t WS_END = WS_E + 128 * MiB;
static_assert(WS_END <= 2048 * MiB, "workspace map");

constexpr int CW_TMO = 0, CW_CODE = 1;
constexpr int CW_BAR = 4096;

constexpr int RING_OFF = 0, RING_BYTES = 131072;
constexpr int LDSCTL_OFF = RING_BYTES, MISC_OFF = LDSCTL_OFF + 320;
constexpr int LDS_BYTES = 147456;

typedef GAS unsigned gu32;
#define RLX_AGENT __ATOMIC_RELAXED, __HIP_MEMORY_SCOPE_AGENT
#define LDS_WAIT() asm volatile("s_waitcnt lgkmcnt(0)" ::: "memory")
#define VM_WAIT() asm volatile("s_waitcnt vmcnt(0)" ::: "memory")
__device__ __forceinline__ unsigned f2bf(float f) { unsigned u = __builtin_bit_cast(unsigned, f); return (u + 0x7fffu + ((u >> 16) & 1u)) >> 16; }
__device__ __forceinline__ unsigned pk2(float lo, float hi) { return f2bf(lo) | (f2bf(hi) << 16); }

#define XB_TMO      128
#define XB_XCNT(j)  (256  + 64 * (j))
#define XB_XSUB(j)  (1280 + 64 * (j))
#define XB_XGEN(j)  (2304 + 64 * (j))
#define XB_TOP      3328
#define XB_TOPGEN   3392
#define XCD_BAR_WORDS 3456
#define XB_SPIN_CAP (1u << 18)

__device__ __forceinline__ unsigned xb_ld(unsigned* p)              { return __hip_atomic_load(p, __ATOMIC_RELAXED, __HIP_MEMORY_SCOPE_AGENT); }
__device__ __forceinline__ unsigned xb_add(unsigned* p, unsigned v) { return __hip_atomic_fetch_add(p, v, __ATOMIC_RELAXED, __HIP_MEMORY_SCOPE_AGENT); }
__device__ __forceinline__ unsigned xb_xcc_id() { return (unsigned)__builtin_amdgcn_s_getreg((3 << 11) | 20) & 0xFu; }
#define XB_SPIN(cond, bar) do { unsigned _sp = 0; while (cond) { __builtin_amdgcn_s_sleep(1); \
    if ((++_sp & 255u) == 0u) { if (xb_ld(&(bar)[XB_TMO])) break; if (_sp > XB_SPIN_CAP) { atomicAdd(&(bar)[XB_TMO], 1u); break; } } } } while (0)

struct XcdBarrier {
    unsigned* bar; unsigned x;
    volatile LAS unsigned* st;
};
__device__ __forceinline__ XcdBarrier xcd_barrier_post(unsigned* bar, volatile LAS unsigned* st) {
    XcdBarrier b; b.bar = bar; b.x = xb_xcc_id(); b.st = st;
    if (threadIdx.x == 0) (void)xb_add(&bar[XB_XCNT(b.x)], 1u);
    return b;
}
__device__ __forceinline__ void xcd_barrier_complete(unsigned* bar, unsigned x, unsigned& nloc, unsigned& nx) {
    const unsigned G = gridDim.x * gridDim.y * gridDim.z;
    unsigned sum, cnt, mine, sp = 0u;
    for (;;) {
        sum = 0u; cnt = 0u; mine = 0u;
#pragma unroll
        for (unsigned j = 0; j < 16; ++j) { const unsigned c = xb_ld(&bar[XB_XCNT(j)]); sum += c; cnt += (c > 0u) ? 1u : 0u; mine = (j == x) ? c : mine; }
        if (sum == G) break;
        __builtin_amdgcn_s_sleep(1);
        if ((++sp & 255u) == 0u) { if (xb_ld(&bar[XB_TMO])) break; if (sp > XB_SPIN_CAP) { atomicAdd(&bar[XB_TMO], 1u); break; } }
    }
    nloc = mine > 0u ? mine : 1u; nx = cnt > 0u ? cnt : 1u;
}
__device__ __forceinline__ void xcd_barrier(const XcdBarrier& b) {
    asm volatile("s_waitcnt vmcnt(0)" ::: "memory");
    __syncthreads();
    if (threadIdx.x == 0) {
        unsigned* bar = b.bar; asm volatile("" : "+s"(bar));
        __builtin_amdgcn_s_waitcnt(0);
        unsigned nloc = b.st[0], nx = b.st[1];
        if (nloc == 0u) { xcd_barrier_complete(bar, b.x, nloc, nx); b.st[0] = nloc; b.st[1] = nx; }
        const unsigned old = xb_add(&bar[XB_XSUB(b.x)], 1u);
        const unsigned gen = old / nloc;
        if (old + 1u == (gen + 1u) * nloc) {
            __builtin_amdgcn_fence(__ATOMIC_RELEASE, "agent");
            asm volatile("s_waitcnt vmcnt(0)" ::: "memory");
            const unsigned og = xb_add(&bar[XB_TOP], 1u);
            const unsigned tg = og / nx;
            if (og + 1u == (tg + 1u) * nx) xb_add(&bar[XB_TOPGEN], 1u);
            else XB_SPIN(xb_ld(&bar[XB_TOPGEN]) == tg, bar);
            __builtin_amdgcn_fence(__ATOMIC_ACQUIRE, "agent");
            xb_add(&bar[XB_XGEN(b.x)], 1u);
            asm volatile("s_waitcnt vmcnt(0)" ::: "memory");
        } else {
            XB_SPIN(xb_ld(&bar[XB_XGEN(b.x)]) == gen, bar);
            __builtin_amdgcn_fence(__ATOMIC_ACQUIRE, "agent");
            asm volatile("s_waitcnt vmcnt(0)" ::: "memory");
        }
    }
    __syncthreads();
}

struct Frame {
    LAS unsigned char* lds;
    int tid, lane, wave;
    int vcu, G, bx;
};
__device__ __forceinline__ Frame make_frame(LAS unsigned char* lds) {
    Frame F; int t = threadIdx.x; asm volatile("" : "+v"(t)); int bx = blockIdx.x; asm volatile("" : "+s"(bx)); int G = gridDim.x; asm volatile("" : "+s"(G));
    F.lds = lds; F.tid = t; F.lane = t & 63; F.wave = __builtin_amdgcn_readfirstlane(t >> 6); F.G = G; F.bx = bx;
    F.vcu = (G % 8 == 0) ? (bx % 8) * (G / 8) + bx / 8 : bx;
    return F;
}

__device__ __forceinline__ float shx(float v, int m, int lane) { return __int_as_float(__builtin_amdgcn_ds_bpermute((lane ^ m) << 2, __float_as_int(v))); }
__device__ __forceinline__ float wave_sum(float v, int lane) {
#pragma unroll
    for (int o = 1; o < 64; o <<= 1) v += shx(v, o, lane);
    return v;
}

template <int MAP>
__device__ __forceinline__ void p0_transpose_item(const float* W, int K, int N, bf16_t* WT, int row_off, LAS float* scr, int item, int lane) {
    const int nblk = N / 32, kb = item / nblk, nb = item % nblk, k0 = 64 * kb, n0 = 32 * nb;
    const int r0 = (MAP == 0) ? (row_off + n0) : (256 * (n0 >> 7) + (n0 & 127) + row_off);
#pragma unroll 8
    for (int i = 0; i < 32; ++i) { const int kk = 2 * i + (lane >> 5); scr[kk * 33 + (lane & 31)] = W[(size_t)(k0 + kk) * N + n0 + (lane & 31)]; }
    LDS_WAIT(); asm volatile("" ::: "memory");
    const int c = lane & 7;
#pragma unroll
    for (int j = 0; j < 4; ++j) { const int n = (lane >> 3) + 8 * j; const LAS float* s = scr + (8 * c) * 33 + n;
        u32x4 o; o.x = pk2(s[0 * 33], s[1 * 33]); o.y = pk2(s[2 * 33], s[3 * 33]); o.z = pk2(s[4 * 33], s[5 * 33]); o.w = pk2(s[6 * 33], s[7 * 33]);
        *(GAS u32x4*)(WT + (size_t)(r0 + n) * K + k0 + 8 * c) = o; }
    LDS_WAIT(); asm volatile("" ::: "memory");
}

struct Args { const float* in[18]; float* out; unsigned char* ws; int ph_lo, ph_hi; };

__device__ __forceinline__ void norm_row(int lane, const float* xin, float* xout, const bf16_t* y, const LAS float* gpost, const LAS float* gpre, bf16_t* h, int hmode) {
    const GAS f32x4* xr = (const GAS f32x4*)xin + lane;
    f32x4 v[16];
#pragma unroll
    for (int j = 0; j < 16; ++j) v[j] = xr[64 * j];
    if (y) {
        const GAS u32x2* yr = (const GAS u32x2*)y + lane; f32x4 yv[16]; float s = 0.f;
#pragma unroll
        for (int j = 0; j < 16; ++j) { const u32x2 w = yr[64 * j]; yv[j] = (f32x4){bf_lo(w.x), bf_hi(w.x), bf_lo(w.y), bf_hi(w.y)}; s += (yv[j].x * yv[j].x + yv[j].y * yv[j].y) + (yv[j].z * yv[j].z + yv[j].w * yv[j].w); }
        const float rstd = 1.0f / sqrtf(wave_sum(s, lane) * (1.f / DM) + EPS);
#pragma unroll
        for (int j = 0; j < 16; ++j) { const f32x4 g = *(const LAS f32x4*)(gpost + 4 * lane + 256 * j); v[j] = v[j] + yv[j] * rstd * g; }
    }
    if (xout) { GAS f32x4* xo = (GAS f32x4*)xout + lane;
#pragma unroll
        for (int j = 0; j < 16; ++j) xo[64 * j] = v[j]; }
    if (hmode) {
        float rstd = 1.f;
        if (hmode == 2) { float s = 0.f;
#pragma unroll
            for (int j = 0; j < 16; ++j) s += (v[j].x * v[j].x + v[j].y * v[j].y) + (v[j].z * v[j].z + v[j].w * v[j].w);
            rstd = 1.0f / sqrtf(wave_sum(s, lane) * (1.f / DM) + EPS); }
        GAS u32x2* ho = (GAS u32x2*)h + lane;
#pragma unroll
        for (int j = 0; j < 16; ++j) { f32x4 t = v[j] * rstd; if (hmode == 2) { const f32x4 g = *(const LAS f32x4*)(gpre + 4 * lane + 256 * j); t = t * g; }
            u32x2 w; w.x = cvt_pk_bf16(t.x, t.y); w.y = cvt_pk_bf16(t.z, t.w); ho[64 * j] = w; }
    }
}
__device__ __forceinline__ void norm_pass(Frame& F, const float* xin, float* xout, const bf16_t* y, const float* gpost, const float* gpre, bf16_t* h, int hmode) {
    LAS float* gl = (LAS float*)(F.lds + RING_OFF);
    __syncthreads();
    for (int i = F.tid; i < DM; i += NWAVES * 64) { gl[i] = gpost ? gpost[i] : 0.f; gl[DM + i] = gpre ? gpre[i] : 0.f; }
    __syncthreads();
    const int gw = F.vcu * NWAVES + F.wave, NGW = F.G * NWAVES;
    for (int m = gw; m < S; m += NGW)
        norm_row(F.lane, xin + (size_t)m * DM, xout ? xout + (size_t)m * DM : nullptr, y ? y + (size_t)m * DM : nullptr, gl, gl + DM, h ? h + (size_t)m * DM : nullptr, hmode);
    __syncthreads();
}

__device__ __forceinline__ void qk_norm_rope_pass(Frame& F, const bf16_t* Qr, const bf16_t* Kr, bf16_t* Q2, bf16_t* K2, const float* qn, const float* kn, const float* rope) {
    const int gw = F.vcu * NWAVES + F.wave, NGW = F.G * NWAVES;
    const int g16 = F.lane >> 4, s = F.lane & 15;
    constexpr int NITEM = S * (NH + NKV);
    const int dsub = 8 * s;
    const int axis = s >> 3, half = (s >> 2) & 1, i0 = 8 * (s & 3);
    for (int it = 4 * gw + g16; it < NITEM; it += 4 * NGW) {
        const int row = it / (NH + NKV), hh = it % (NH + NKV);
        const bool isq = hh < NH;
        const bf16_t* src = isq ? Qr + (size_t)row * DM + hh * HD + dsub : Kr + (size_t)row * KVW + (hh - NH) * HD + dsub;
        bf16_t* dst = isq ? Q2 + (size_t)row * DM + hh * HD + dsub : K2 + (size_t)row * KVW + (hh - NH) * HD + dsub;
        const float* gn = isq ? qn : kn;
        const u32x4 w = *(const GAS u32x4*)src;
        float x[8] = {bf_lo(w.x), bf_hi(w.x), bf_lo(w.y), bf_hi(w.y), bf_lo(w.z), bf_hi(w.z), bf_lo(w.w), bf_hi(w.w)};
        float ss = 0.f;
#pragma unroll
        for (int j = 0; j < 8; ++j) ss += x[j] * x[j];
        ss += shx(ss, 1, F.lane); ss += shx(ss, 2, F.lane); ss += shx(ss, 4, F.lane); ss += shx(ss, 8, F.lane);
        const float rstd = 1.0f / sqrtf(ss * (1.f / HD) + EPS);
        const f32x4 ga = *(const f32x4*)(gn + dsub), gb = *(const f32x4*)(gn + dsub + 4);
        const float g[8] = {ga.x, ga.y, ga.z, ga.w, gb.x, gb.y, gb.z, gb.w};
        const float rs = isq ? rstd * (att::SCALE * 1.4426950408889634f) : rstd;
#pragma unroll
        for (int j = 0; j < 8; ++j) x[j] = x[j] * rs * g[j];
        float xp[8];
#pragma unroll
        for (int j = 0; j < 8; ++j) xp[j] = shx(x[j], 4, F.lane);
        const int pos = axis ? (row & 63) : (row >> 6);
        const f32x4* tp = (const f32x4*)(rope + ((size_t)pos * 32 + i0) * 2);
        float o[8];
#pragma unroll
        for (int jj = 0; jj < 4; ++jj) { const f32x4 cs = tp[jj];
            o[2 * jj]     = half ? (x[2 * jj] * cs.x + xp[2 * jj] * cs.y)         : (x[2 * jj] * cs.x - xp[2 * jj] * cs.y);
            o[2 * jj + 1] = half ? (x[2 * jj + 1] * cs.z + xp[2 * jj + 1] * cs.w) : (x[2 * jj + 1] * cs.z - xp[2 * jj + 1] * cs.w); }
        u32x4 ow; ow.x = cvt_pk_bf16(o[0], o[1]); ow.y = cvt_pk_bf16(o[2], o[3]); ow.z = cvt_pk_bf16(o[4], o[5]); ow.w = cvt_pk_bf16(o[6], o[7]);
        *(GAS u32x4*)dst = ow;
    }
}
__device__ __forceinline__ void pool_delta_pass(Frame& F, const bf16_t* U, bf16_t* DL) {
    const int gt = F.vcu * (NWAVES * 64) + F.tid, NT = F.G * NWAVES * 64;
    for (int it = gt; it < S * (POOLW / 8); it += NT) {
        const int t = it >> 8, c = it & 255, g = c >> 6, hw = 1 << g;
        const int lo = (t - hw) < 0 ? 0 : (t - hw), hi = (t + hw) > S ? S : (t + hw);
        float acc[8] = {0.f, 0.f, 0.f, 0.f, 0.f, 0.f, 0.f, 0.f};
        for (int r = lo; r < hi; ++r) { const u32x4 w = *(const GAS u32x4*)(U + (size_t)r * POOLW + 8 * c);
            acc[0] += bf_lo(w.x); acc[1] += bf_hi(w.x); acc[2] += bf_lo(w.y); acc[3] += bf_hi(w.y); acc[4] += bf_lo(w.z); acc[5] += bf_hi(w.z); acc[6] += bf_lo(w.w); acc[7] += bf_hi(w.w); }
        const u32x4 w = *(const GAS u32x4*)(U + (size_t)t * POOLW + 8 * c);
        const float inv = 1.0f / (float)(hi - lo);
        const float me[8] = {bf_lo(w.x), bf_hi(w.x), bf_lo(w.y), bf_hi(w.y), bf_lo(w.z), bf_hi(w.z), bf_lo(w.w), bf_hi(w.w)};
        float d[8];
#pragma unroll
        for (int j = 0; j < 8; ++j) d[j] = acc[j] * inv - me[j];
        u32x4 ow; ow.x = cvt_pk_bf16(d[0], d[1]); ow.y = cvt_pk_bf16(d[2], d[3]); ow.z = cvt_pk_bf16(d[4], d[5]); ow.w = cvt_pk_bf16(d[6], d[7]);
        *(GAS u32x4*)(DL + (size_t)t * POOLW + 8 * c) = ow;
    }
}

__device__ __forceinline__ double inv_freq_of(int i) {
    const double step = 0.74989420933245582730;
    double r = 1.0; for (int k = 0; k < i; ++k) r *= step; return r;
}

typedef const __attribute__((address_space(4))) Args CArgs;
__device__ __forceinline__ CArgs* fresh_args() { CArgs* p = (CArgs*)__builtin_amdgcn_kernarg_segment_ptr(); asm volatile("" : "+s"(p)); return p; }
#define WSP(off) ((bf16_t*)(ws + (off)))

__global__ void __launch_bounds__(NWAVES * 64, 2) fwd_kernel(Args args) {
    extern __shared__ __attribute__((aligned(16))) unsigned char lds[];
    LAS unsigned char* const L = (LAS unsigned char*)lds;
    for (int u = threadIdx.x; u < (LDS_BYTES - LDSCTL_OFF) / 4; u += NWAVES * 64) ((LAS unsigned*)(L + LDSCTL_OFF))[u] = 0u;
    __syncthreads();
    unsigned* const barw = (unsigned*)(args.ws + WS_CTL) + CW_BAR;
    XcdBarrier bar; bar.bar = barw; bar.x = 0; bar.st = nullptr;
    if (N_LAUNCHES == 1) bar = xcd_barrier_post(barw, (volatile LAS unsigned*)(L + MISC_OFF) + 8);
#define GRID_BAR() do { if (N_LAUNCHES == 1) xcd_barrier(bar); } while (0)
    const int lo = args.ph_lo, hi = args.ph_hi;
#define IN(k) (lo <= (k) && (k) < hi)
#define SEAM(k) do { if (IN(k) && IN((k) + 1)) GRID_BAR(); } while (0)

    if (IN(0)) {
        CArgs* ap = fresh_args(); unsigned char* ws = ap->ws; Frame F = make_frame(L);
        LAS float* scr = (LAS float*)(F.lds + RING_OFF + F.wave * 16384);
        const int gw = F.vcu * NWAVES + F.wave, NGW = F.G * NWAVES;
        constexpr int I_IN = (DM / 64) * (INW / 32), I_POOL = (PGI / 64) * (PGO / 32), I_OUT = (DM / 64) * (DM / 32), I_GU = (DM / 64) * (FF / 32), I_DOWN = (FF / 64) * (DM / 32), I_PIN = (DPLE / 64) * (DM / 32);
        constexpr int I_LAYER = I_IN + 4 * I_POOL + I_OUT + 2 * I_GU + I_DOWN + I_PIN + I_OUT;
        for (int rep = 0; rep < REP_CONV; ++rep)
        for (int it = gw; it < DEPTH * I_LAYER; it += NGW) {
            const int l = it / I_LAYER; int r = it % I_LAYER;
            unsigned char* wl = ws + WS_W + (size_t)l * LW_BYTES;
            if (r < I_IN) { p0_transpose_item<0>(ap->in[2] + (size_t)l * DM * INW, DM, INW, (bf16_t*)(wl + LW_IN), 0, scr, r, F.lane); continue; } r -= I_IN;
            if (r < 4 * I_POOL) { const int g = r / I_POOL; p0_transpose_item<0>(ap->in[5] + ((size_t)l * 4 + g) * PGI * PGO, PGI, PGO, (bf16_t*)(wl + LW_POOL), g * PGO, scr, r % I_POOL, F.lane); continue; } r -= 4 * I_POOL;
            if (r < I_OUT) { p0_transpose_item<0>(ap->in[7] + (size_t)l * DM * DM, DM, DM, (bf16_t*)(wl + LW_OUT), 0, scr, r, F.lane); continue; } r -= I_OUT;
            if (r < I_GU) { p0_transpose_item<1>(ap->in[12] + (size_t)l * DM * FF, DM, FF, (bf16_t*)(wl + LW_GU), 0, scr, r, F.lane); continue; } r -= I_GU;
            if (r < I_GU) { p0_transpose_item<1>(ap->in[13] + (size_t)l * DM * FF, DM, FF, (bf16_t*)(wl + LW_GU), 128, scr, r, F.lane); continue; } r -= I_GU;
            if (r < I_DOWN) { p0_transpose_item<0>(ap->in[14] + (size_t)l * FF * DM, FF, DM, (bf16_t*)(wl + LW_DOWN), 0, scr, r, F.lane); continue; } r -= I_DOWN;
            if (r < I_PIN) { p0_transpose_item<0>(ap->in[15] + (size_t)l * DPLE * DM, DPLE, DM, (bf16_t*)(wl + LW_PIN), 0, scr, r, F.lane); continue; } r -= I_PIN;
            p0_transpose_item<0>(ap->in[16] + (size_t)l * DM * DM, DM, DM, (bf16_t*)(wl + LW_PG), 0, scr, r, F.lane);
        }
        { const int gt = F.vcu * (NWAVES * 64) + F.tid, NT = F.G * NWAVES * 64;
          const float* p_in = ap->in[1]; bf16_t* PB = WSP(WS_PB); float* rope = (float*)(ws + WS_ROPE);
          for (int i = gt; i < DEPTH * S * DPLE / 8; i += NT) { const f32x4 a = *(const GAS f32x4*)(p_in + (size_t)i * 8), b = *(const GAS f32x4*)(p_in + (size_t)i * 8 + 4);
              u32x4 o; o.x = cvt_pk_bf16(a.x, a.y); o.y = cvt_pk_bf16(a.z, a.w); o.z = cvt_pk_bf16(b.x, b.y); o.w = cvt_pk_bf16(b.z, b.w); *(GAS u32x4*)(PB + (size_t)i * 8) = o; }
          for (int i = gt; i < 128 * 32; i += NT) { const int pos = i >> 5, fi = i & 31;
              const double ang = (double)pos * inv_freq_of(fi); const double k = __builtin_rint(ang * 0.15915494309189533577); const double r = ang - k * 6.283185307179586476925;
              const float rf = (float)r; rope[2 * i] = cosf(rf); rope[2 * i + 1] = sinf(rf); }
        }
        norm_pass(F, ap->in[0], nullptr, nullptr, nullptr, ap->in[8], WSP(WS_H), 2);
    }
    SEAM(0);

    for (int l = 0; l < DEPTH; ++l) {
        const int pb = 1 + 11 * l;
        if (IN(pb + 0)) {
            CArgs* ap = fresh_args(); unsigned char* ws = ap->ws; Frame F = make_frame(L); unsigned char* wl = ws + WS_W + (size_t)l * LW_BYTES;
            for (int rep = 0; rep < REP_G1; ++rep) { pg8::Gemm g{WSP(WS_H), (const bf16_t*)(wl + LW_IN), S, INW, DM, DM, DM, 0}; pg8::StaticOrder So; So.init(S, INW, F.G, F.bx);
              pg8::EpiZ E{WSP(WS_Q), WSP(WS_K), WSP(WS_V), WSP(WS_U), WSP(WS_GA), WSP(WS_GP)};
              pg8::gemm_phase<pg8::EpiZ, pg8::StaticOrder, G_ALIGN, G_SP2>(F.lds + RING_OFF, g, So, E); }
            if (l == 0) {
                for (int l2 = 0; l2 < DEPTH; ++l2) {
                    pg8::Gemm g2{WSP(WS_PB) + (size_t)l2 * S * DPLE, (const bf16_t*)(ws + WS_W + (size_t)l2 * LW_BYTES + LW_PIN), S, DM, DPLE, DPLE, DPLE, 0}; pg8::StaticOrder S2; S2.init(S, DM, F.G, F.bx);
                    pg8::EpiPlain E2{WSP(WS_E) + (size_t)l2 * S * DM, DM};
                    pg8::gemm_phase<pg8::EpiPlain, pg8::StaticOrder, G_ALIGN, G_SP2>(F.lds + RING_OFF, g2, S2, E2);
                }
            }
        }
        SEAM(pb + 0);
        if (IN(pb + 1)) {
            CArgs* ap = fresh_args(); unsigned char* ws = ap->ws; Frame F = make_frame(L);
            for (int rep = 0; rep < REP_T2; ++rep) {
            qk_norm_rope_pass(F, WSP(WS_Q), WSP(WS_K), WSP(WS_Q2), WSP(WS_K2), ap->in[3] + l * HD, ap->in[4] + l * HD, (const float*)(ws + WS_ROPE));
            pool_delta_pass(F, WSP(WS_U), WSP(WS_DL)); }
        }
        SEAM(pb + 1);
        if (IN(pb + 2)) {
            CArgs* ap = fresh_args(); unsigned char* ws = ap->ws; Frame F = make_frame(L);
            for (int rep = 0; rep < REP_ATT; ++rep)
            for (int U0 = F.vcu; U0 < NH * (S / 256); U0 += F.G) {
                const int a = U0 >> 8, b = (U0 >> 5) & 7, c = U0 & 31, h = 4 * b + a, qb = c, kvh = h >> 2;
                att::attn_ring_body(WSP(WS_Q2) + (size_t)qb * 256 * DM + h * HD, WSP(WS_K2) + kvh * HD, WSP(WS_V) + kvh * HD, WSP(WS_O) + (size_t)qb * 256 * DM + h * HD, S, (LAS char*)(F.lds + RING_OFF));
            }
        }
        SEAM(pb + 2);
        if (IN(pb + 3)) {
            CArgs* ap = fresh_args(); unsigned char* ws = ap->ws; Frame F = make_frame(L); unsigned char* wl = ws + WS_W + (size_t)l * LW_BYTES;
            pg8::Gemm g{WSP(WS_DL), (const bf16_t*)(wl + LW_POOL), S, DM, PGI, POOLW, PGI, PGI}; pg8::StaticOrder So; So.init(S, DM, F.G, F.bx);
            pg8::EpiPool E{WSP(WS_MG), WSP(WS_O), WSP(WS_GA), WSP(WS_GP), ap->in[6] + (size_t)l * DM, DM};
            for (int rep = 0; rep < REP_SMALLG; ++rep)
            pg8::gemm_phase<pg8::EpiPool, pg8::StaticOrder, G_ALIGN, G_SP2>(F.lds + RING_OFF, g, So, E);
        }
        SEAM(pb + 3);
        if (IN(pb + 4)) {
            CArgs* ap = fresh_args(); unsigned char* ws = ap->ws; Frame F = make_frame(L); unsigned char* wl = ws + WS_W + (size_t)l * LW_BYTES;
            pg8::Gemm g{WSP(WS_MG), (const bf16_t*)(wl + LW_OUT), S, DM, DM, DM, DM, 0}; pg8::StaticOrder So; So.init(S, DM, F.G, F.bx);
            pg8::EpiPlain E{WSP(WS_Y), DM};
            for (int rep = 0; rep < REP_SMALLG; ++rep)
            pg8::gemm_phase<pg8::EpiPlain, pg8::StaticOrder, G_ALIGN, G_SP2>(F.lds + RING_OFF, g, So, E);
        }
        SEAM(pb + 4);
        if (IN(pb + 5)) {
            CArgs* ap = fresh_args(); unsigned char* ws = ap->ws; Frame F = make_frame(L);
            norm_pass(F, l == 0 ? ap->in[0] : (const float*)ap->out, ap->out, WSP(WS_Y), ap->in[9] + (size_t)l * DM, ap->in[10] + (size_t)l * DM, WSP(WS_H), 2);
        }
        SEAM(pb + 5);
        if (IN(pb + 6)) {
            CArgs* ap = fresh_args(); unsigned char* ws = ap->ws; Frame F = make_frame(L); unsigned char* wl = ws + WS_W + (size_t)l * LW_BYTES;
            pg8::Gemm g{WSP(WS_H), (const bf16_t*)(wl + LW_GU), S, 2 * FF, DM, DM, DM, 0}; pg8::StaticOrder So; So.init(S, 2 * FF, F.G, F.bx);
            pg8::EpiSwiglu E{WSP(WS_F), FF};
            for (int rep = 0; rep < REP_G3; ++rep)
            pg8::gemm_phase<pg8::EpiSwiglu, pg8::StaticOrder, G_ALIGN, G_SP2>(F.lds + RING_OFF, g, So, E);
        }
        SEAM(pb + 6);
        if (IN(pb + 7)) {
            CArgs* ap = fresh_args(); unsigned char* ws = ap->ws; Frame F = make_frame(L); unsigned char* wl = ws + WS_W + (size_t)l * LW_BYTES;
            pg8::Gemm g{WSP(WS_F), (const bf16_t*)(wl + LW_DOWN), S, DM, FF, FF, FF, 0}; pg8::StaticOrder So; So.init(S, DM, F.G, F.bx);
            pg8::EpiPlain E{WSP(WS_Y), DM};
            for (int rep = 0; rep < REP_G4; ++rep)
            pg8::gemm_phase<pg8::EpiPlain, pg8::StaticOrder, G_ALIGN, G_SP2>(F.lds + RING_OFF, g, So, E);
        }
        SEAM(pb + 7);
        if (IN(pb + 8)) {
            CArgs* ap = fresh_args(); unsigned char* ws = ap->ws; Frame F = make_frame(L);
            for (int rep = 1; rep < REP_THIN; ++rep) norm_pass(F, ap->out, (float*)(ws + WS_Q), WSP(WS_Y), ap->in[11] + (size_t)l * DM, ap->in[11] + (size_t)l * DM, WSP(WS_Q2), 2);
            norm_pass(F, ap->out, ap->out, WSP(WS_Y), ap->in[11] + (size_t)l * DM, nullptr, WSP(WS_H), 1);
        }
        SEAM(pb + 8);
        if (IN(pb + 9)) {
            CArgs* ap = fresh_args(); unsigned char* ws = ap->ws; Frame F = make_frame(L); unsigned char* wl = ws + WS_W + (size_t)l * LW_BYTES;
            pg8::Gemm g{WSP(WS_H), (const bf16_t*)(wl + LW_PG), S, DM, DM, DM, DM, 0}; pg8::StaticOrder So; So.init(S, DM, F.G, F.bx);
            pg8::EpiPle E{WSP(WS_Y), WSP(WS_E) + (size_t)l * S * DM, DM};
            for (int rep = 0; rep < REP_SMALLG; ++rep)
            pg8::gemm_phase<pg8::EpiPle, pg8::StaticOrder, G_ALIGN, G_SP2>(F.lds + RING_OFF, g, So, E);
        }
        SEAM(pb + 9);
        if (IN(pb + 10)) {
            CArgs* ap = fresh_args(); unsigned char* ws = ap->ws; Frame F = make_frame(L);
            if (l + 1 < DEPTH) norm_pass(F, ap->out, ap->out, WSP(WS_Y), ap->in[17] + (size_t)l * DM, ap->in[8] + (size_t)(l + 1) * DM, WSP(WS_H), 2);
            else norm_pass(F, ap->out, ap->out, WSP(WS_Y), ap->in[17] + (size_t)l * DM, nullptr, nullptr, 0);
        }
        SEAM(pb + 10);
    }
#undef IN
#undef SEAM
#undef GRID_BAR
}

extern "C" void kernel_launch(void* const* d_in, const int* in_sizes, int n_in, void* d_out, int out_size, void* d_ws, size_t ws_size, hipStream_t stream) {
    static int grid = 0;
    if (grid == 0) {
        if (n_in != 18 || in_sizes[0] != S * DM || out_size != S * DM || ws_size < WS_END) { fprintf(stderr, "kernel_launch: shape/workspace mismatch: n_in %d in0 %d out %d ws %zu (need %zu)\n", n_in, n_in > 0 ? in_sizes[0] : -1, out_size, ws_size, (size_t)WS_END); grid = -1; return; }
        int dev = 0, cus = 0, per_cu = 0;
        if (hipGetDevice(&dev) != hipSuccess || hipDeviceGetAttribute(&cus, hipDeviceAttributeMultiprocessorCount, dev) != hipSuccess) { grid = -1; return; }
        if (hipFuncSetAttribute((const void*)fwd_kernel, hipFuncAttributeMaxDynamicSharedMemorySize, LDS_BYTES) != hipSuccess) { fprintf(stderr, "kernel_launch: hipFuncSetAttribute failed\n"); grid = -1; return; }
        if (hipOccupancyMaxActiveBlocksPerMultiprocessor(&per_cu, (const void*)fwd_kernel, NWAVES * 64, LDS_BYTES) != hipSuccess || per_cu < 1) { fprintf(stderr, "kernel_launch: occupancy query says %d blocks per CU\n", per_cu); }
        (void)hipGetLastError();
        grid = cus;
    }
    if (grid < 0) return;
    if (hipMemsetAsync((char*)d_ws + WS_CTL, 0, CTL_ZERO_BYTES, stream) != hipSuccess) return;
    Args a{};
    for (int i = 0; i < 18; ++i) a.in[i] = (const float*)d_in[i];
    a.out = (float*)d_out; a.ws = (unsigned char*)d_ws;
    for (int li = 0; li < N_LAUNCHES; ++li) {
        a.ph_lo = (N_LAUNCHES == 1) ? 0 : li; a.ph_hi = (N_LAUNCHES == 1) ? N_PHASES : li + 1;
        hipLaunchKernelGGL(fwd_kernel, dim3(grid), dim3(NWAVES * 64), LDS_BYTES, stream, a);
        const hipError_t le = hipPeekAtLastError();
        if (le != hipSuccess) { fprintf(stderr, "kernel_launch: launch %d failed: %s\n", li, hipGetErrorName(le)); break; }
    }
}
```

```cpp
#include <hip/hip_runtime.h>
#include <cstdio>
#include <cstdint>

#ifndef MK_N_LAUNCHES
#define MK_N_LAUNCHES 1
#endif

#ifndef G_SP2
#define G_SP2 true
#endif
#ifndef G_ALIGN
#define G_ALIGN true
#endif
#ifndef NT_STORE
#define NT_STORE 0
#endif
#ifndef REP_BAR
#define REP_BAR 1
#endif
#ifndef REP_CONV
#define REP_CONV 1
#endif
#ifndef REP_G1
#define REP_G1 1
#endif
#ifndef REP_ATT
#define REP_ATT 1
#endif
#ifndef REP_G3
#define REP_G3 1
#endif
#ifndef REP_G4
#define REP_G4 1
#endif
#ifndef REP_T2
#define REP_T2 1
#endif
#ifndef REP_THIN
#define REP_THIN 1
#endif
#ifndef REP_SMALLG
#define REP_SMALLG 1
#endif

#define LAS __attribute__((address_space(3)))
#define GAS __attribute__((address_space(1)))
typedef unsigned short bf16_t;
typedef short bf16x8 __attribute__((ext_vector_type(8)));
typedef short s16x4 __attribute__((ext_vector_type(4)));
typedef float f32x4 __attribute__((ext_vector_type(4)));
typedef float f32x2 __attribute__((ext_vector_type(2)));
typedef float f32x16 __attribute__((ext_vector_type(16)));
typedef unsigned u32x4 __attribute__((ext_vector_type(4)));
typedef unsigned u32x2 __attribute__((ext_vector_type(2)));

constexpr int S = 8192, DM = 4096, DEPTH = 2;
constexpr int NH = 32, NKV = 8, HD = 128;
constexpr int KVW = NKV * HD;
constexpr int POOLW = 2048, PGI = 512, PGO = 1024;
constexpr int INW = 16384;
constexpr int FF = 11008;
constexpr int DPLE = 256;
constexpr float EPS = 1e-6f;

__device__ __forceinline__ unsigned cvt_pk_bf16(float lo, float hi) { unsigned r; asm volatile("v_cvt_pk_bf16_f32 %0, %1, %2" : "=v"(r) : "v"(lo), "v"(hi)); return r; }
__device__ __forceinline__ float bf_lo(unsigned w) { return __uint_as_float(w << 16); }
__device__ __forceinline__ float bf_hi(unsigned w) { return __uint_as_float(w & 0xffff0000u); }
__device__ __forceinline__ float sigmoid_f(float v) { return __builtin_amdgcn_rcpf(1.0f + __builtin_amdgcn_exp2f(v * -1.4426950408889634f)); }

namespace pg8 {
constexpr int BM = 256, BK = 64, HALF = 128, HTB = HALF * BK * 2  , STAGE_BYTES = 8 * HTB, NXCD = 8, WGM = 8;

__host__ __device__ __forceinline__ int lds_byte(int r, int c) { const int st = (r >> 4) * 2 + (c >> 5), rr = r & 15, cc = c & 31, ob = rr * 64 + cc * 2; return st * 1024 + (ob ^ (((ob >> 9) & 1) << 5)); }
__host__ __device__ __forceinline__ void stage_rc(int b, int& R, int& C) { const int st = b / 1024, sb = b % 1024, swz = sb ^ (((sb >> 9) & 1) << 5); R = (st >> 1) * 16 + swz / 64; C = (st & 1) * 32 + (swz % 64) / 2; }
__host__ __device__ __forceinline__ int perm32(int rho) { const int n = rho >> 4, i = rho & 15; return 8 * (i >> 2) + 4 * n + (i & 3); }

struct Unit { int pm, pn; };
struct Gemm { const bf16_t* A; const bf16_t* Bt; int M, N, K, lda, ldb, agrp; };

struct StaticOrder {
    int nM, nN, nwg, G, c;
    __host__ __device__ void init(int M, int N, int G_, int c_) { nM = M / BM; nN = N / BM; nwg = nM * nN; G = G_; c = c_; }
    __host__ __device__ bool next(int i, Unit& u) const {
        const long L = (long)i * G + c; if (L >= nwg) return false;
        int wgid = (int)L; { const int q = nwg / NXCD, r = nwg % NXCD, xcd = wgid % NXCD, off = wgid / NXCD; wgid = (xcd < r ? xcd * (q + 1) : r * (q + 1) + (xcd - r) * q) + off; }
        const int nig = WGM * nN, gid = wgid / nig, fm = gid * WGM, gsz = (nM - fm) < WGM ? (nM - fm) : WGM;
        u.pm = fm + ((wgid % nig) % gsz); u.pn = (wgid % nig) / gsz; return true;
    }
    __device__ __forceinline__ void a_ready(const Unit&) const {}
    __device__ __forceinline__ void done(const Unit&) const {}
};

__device__ __forceinline__ u32x4 pack8(const f32x4 v0, const f32x4 v1) { u32x4 w; w.x = cvt_pk_bf16(v0[0], v0[1]); w.y = cvt_pk_bf16(v0[2], v0[3]); w.z = cvt_pk_bf16(v1[0], v1[1]); w.w = cvt_pk_bf16(v1[2], v1[3]); return w; }

__device__ __forceinline__ void st16(bf16_t* p, const u32x4 v) {
#if NT_STORE
    __builtin_nontemporal_store(v, (u32x4*)p);
#else
    *(u32x4*)p = v;
#endif
}
struct EpiPlain {
    static constexpr bool PERM = true, AFTER_DRAIN = false;
    bf16_t* O; int ldc;
    __device__ __forceinline__ void operator()(const f32x4 (&acc)[2][2][4][2], const Unit& u, int wr, int wc, int fr, int fq) const {
        const int row0 = u.pm * BM + wr * 64 + fr, col0 = u.pn * BM + wc * 32 + 8 * fq;
#pragma unroll
        for (int ai = 0; ai < 2; ++ai)
#pragma unroll
            for (int m = 0; m < 4; ++m) { bf16_t* rowp = O + (size_t)(row0 + ai * HALF + m * 16) * ldc + col0;
#pragma unroll
                for (int bj = 0; bj < 2; ++bj) *(u32x4*)(rowp + bj * HALF) = pack8(acc[ai][bj][m][0], acc[ai][bj][m][1]); }
    }
};
struct EpiZ {
    static constexpr bool PERM = true, AFTER_DRAIN = false;
    bf16_t *Q, *Kb, *Vb, *U, *GA, *GP;
    __device__ __forceinline__ void operator()(const f32x4 (&acc)[2][2][4][2], const Unit& u, int wr, int wc, int fr, int fq) const {
        const int pn = u.pn; bf16_t* base; int ldc, ct; bool sg = false;
        if (pn < 16)      { base = Q;  ldc = DM;    ct = pn; }
        else if (pn < 20) { base = Kb; ldc = KVW;   ct = pn - 16; }
        else if (pn < 24) { base = Vb; ldc = KVW;   ct = pn - 20; }
        else if (pn < 32) { base = U;  ldc = POOLW; ct = pn - 24; }
        else if (pn < 48) { base = GA; ldc = DM;    ct = pn - 32; sg = true; }
        else              { base = GP; ldc = DM;    ct = pn - 48; sg = true; }
        const int row0 = u.pm * BM + wr * 64 + fr, col0 = ct * BM + wc * 32 + 8 * fq;
#pragma unroll
        for (int ai = 0; ai < 2; ++ai)
#pragma unroll
            for (int m = 0; m < 4; ++m) { bf16_t* rowp = base + (size_t)(row0 + ai * HALF + m * 16) * ldc + col0;
#pragma unroll
                for (int bj = 0; bj < 2; ++bj) { f32x4 v0 = acc[ai][bj][m][0], v1 = acc[ai][bj][m][1];
                    if (sg) {
#pragma unroll
                        for (int j = 0; j < 4; ++j) { v0[j] = sigmoid_f(v0[j]); v1[j] = sigmoid_f(v1[j]); } }
                    st16(rowp + bj * HALF, pack8(v0, v1)); } }
    }
};
struct EpiSwiglu {
    static constexpr bool PERM = true, AFTER_DRAIN = false;
    bf16_t* F; int ldc;
    __device__ __forceinline__ void operator()(const f32x4 (&acc)[2][2][4][2], const Unit& u, int wr, int wc, int fr, int fq) const {
        const int row0 = u.pm * BM + wr * 64 + fr, col0 = u.pn * HALF + wc * 32 + 8 * fq;
#pragma unroll
        for (int ai = 0; ai < 2; ++ai)
#pragma unroll
            for (int m = 0; m < 4; ++m) { bf16_t* rowp = F + (size_t)(row0 + ai * HALF + m * 16) * ldc + col0;
                f32x4 v0, v1;
#pragma unroll
                for (int j = 0; j < 4; ++j) { const float g0 = acc[ai][0][m][0][j], g1 = acc[ai][0][m][1][j];
                    v0[j] = g0 * sigmoid_f(g0) * acc[ai][1][m][0][j]; v1[j] = g1 * sigmoid_f(g1) * acc[ai][1][m][1][j]; }
                *(u32x4*)rowp = pack8(v0, v1); }
    }
};
__device__ __forceinline__ void unpack8(const u32x4 w, f32x4& a, f32x4& b) { a[0] = bf_lo(w.x); a[1] = bf_hi(w.x); a[2] = bf_lo(w.y); a[3] = bf_hi(w.y); b[0] = bf_lo(w.z); b[1] = bf_hi(w.z); b[2] = bf_lo(w.w); b[3] = bf_hi(w.w); }
struct EpiPle {
    static constexpr bool PERM = true, AFTER_DRAIN = false;
    bf16_t* Y; const bf16_t* E; int ldc;
    __device__ __forceinline__ void operator()(const f32x4 (&acc)[2][2][4][2], const Unit& u, int wr, int wc, int fr, int fq) const {
        const int row0 = u.pm * BM + wr * 64 + fr, col0 = u.pn * BM + wc * 32 + 8 * fq;
#pragma unroll
        for (int ai = 0; ai < 2; ++ai)
#pragma unroll
            for (int m = 0; m < 4; ++m) { const size_t off = (size_t)(row0 + ai * HALF + m * 16) * ldc + col0;
#pragma unroll
                for (int bj = 0; bj < 2; ++bj) { const u32x4 ew = *(const u32x4*)(E + off + bj * HALF); f32x4 e0, e1; unpack8(ew, e0, e1);
                    f32x4 v0 = acc[ai][bj][m][0], v1 = acc[ai][bj][m][1];
#pragma unroll
                    for (int j = 0; j < 4; ++j) { v0[j] = sigmoid_f(v0[j]) * e0[j]; v1[j] = sigmoid_f(v1[j]) * e1[j]; }
                    *(u32x4*)(Y + off + bj * HALF) = pack8(v0, v1); }
                asm volatile("" ::: "memory"); }
    }
};
struct EpiPool {
    static constexpr bool PERM = true, AFTER_DRAIN = false;
    bf16_t* MG; const bf16_t *O, *GA, *GP; const float* ps; int ldc;
    __device__ __forceinline__ void operator()(const f32x4 (&acc)[2][2][4][2], const Unit& u, int wr, int wc, int fr, int fq) const {
        const int row0 = u.pm * BM + wr * 64 + fr, col0 = u.pn * BM + wc * 32 + 8 * fq;
        f32x4 pv[2][2];
#pragma unroll
        for (int bj = 0; bj < 2; ++bj)
#pragma unroll
            for (int n = 0; n < 2; ++n) pv[bj][n] = *(const f32x4*)(ps + col0 + bj * HALF + 4 * n);
#pragma unroll
        for (int ai = 0; ai < 2; ++ai)
#pragma unroll
            for (int m = 0; m < 4; ++m) { const size_t off = (size_t)(row0 + ai * HALF + m * 16) * ldc + col0;
#pragma unroll
                for (int bj = 0; bj < 2; ++bj) {
                    const u32x4 ow = *(const u32x4*)(O + off + bj * HALF), aw = *(const u32x4*)(GA + off + bj * HALF), pw = *(const u32x4*)(GP + off + bj * HALF);
                    f32x4 o0, o1, a0, a1, p0, p1; unpack8(ow, o0, o1); unpack8(aw, a0, a1); unpack8(pw, p0, p1);
                    const f32x4 v0 = a0 * o0 + p0 * (acc[ai][bj][m][0] * pv[bj][0]), v1 = a1 * o1 + p1 * (acc[ai][bj][m][1] * pv[bj][1]);
                    *(u32x4*)(MG + off + bj * HALF) = pack8(v0, v1); }
                asm volatile("" ::: "memory"); }
    }
};

template <class Epi, class Sched, bool ALIGN_EPI = false, bool SP2 = false>
__device__ __forceinline__ void gemm_phase(LAS unsigned char* lds, const Gemm g, const Sched& S, const Epi& E, const int tid_in) {
    int tid_ = tid_in; asm volatile("" : "+v"(tid_));
    const int tid = tid_, wid = __builtin_amdgcn_readfirstlane(tid >> 6), lane = tid & 63, wr = wid >> 2, wc = wid & 3, fr = lane & 15, fq = lane >> 4;
    const int K = g.K, nt = K / BK;
    unsigned voffA[2], voffB[2];
#pragma unroll
    for (int i = 0; i < 2; ++i) { int R, C; stage_rc(tid * 16 + i * 8192, R, C); const int Rb = Epi::PERM ? ((R & ~31) + perm32(R & 31)) : R;
        voffA[i] = (unsigned)(R * g.lda + C) * 2u; voffB[i] = (unsigned)(Rb * g.ldb + C) * 2u; }
    const size_t kstep = (size_t)(BK * 2);
    const size_t hstepA = (size_t)HALF * g.lda * 2, hstepB = (size_t)HALF * g.ldb * 2;
    const size_t tstepA = 2 * hstepA, tstepB = 2 * hstepB;
    const unsigned ldsw = (unsigned)wid * 1024u;
    const int aoff = lds_byte(wr * 64 + fr, fq * 8), boff = lds_byte(wc * 32 + fr, fq * 8);
#define PG8_SA(b, h) (((b) * 2 + (h)) * HTB)
#define PG8_SB(b, h) ((4 + (b) * 2 + (h)) * HTB)
#define PG8_STAGE(bufoff, gbase, voff) do { _Pragma("unroll") for (int _i = 0; _i < 2; ++_i) \
        __builtin_amdgcn_global_load_lds((const unsigned*)((const char*)(gbase) + (voff)[_i]), (LAS unsigned*)(lds + (bufoff) + ldsw + _i * 8192), 16, 0, 0); } while (0)
#define PG8_LDA(dst, b, h) do { _Pragma("unroll") for (int m = 0; m < 4; ++m) _Pragma("unroll") for (int k = 0; k < 2; ++k) dst[m][k] = *(const LAS bf16x8*)(lds + PG8_SA(b, h) + aoff + m * 2048 + k * 1024); } while (0)
#define PG8_LDB(dst, b, h) do { _Pragma("unroll") for (int n = 0; n < 2; ++n) _Pragma("unroll") for (int k = 0; k < 2; ++k) dst[n][k] = *(const LAS bf16x8*)(lds + PG8_SB(b, h) + boff + n * 2048 + k * 1024); } while (0)
#define PG8_MMA(ai, bj, At, Bt) do { __builtin_amdgcn_s_setprio(1); _Pragma("unroll") for (int m = 0; m < 4; ++m) _Pragma("unroll") for (int n = 0; n < 2; ++n) _Pragma("unroll") for (int k = 0; k < 2; ++k) \
        acc[ai][bj][m][n] = __builtin_amdgcn_mfma_f32_16x16x32_bf16(Bt[n][k], At[m][k], acc[ai][bj][m][n], 0, 0, 0); __builtin_amdgcn_s_setprio(0); } while (0)
#define PG8_WAIT_V(n) asm volatile("s_waitcnt vmcnt(" #n ")" ::: "memory")
#define PG8_WAIT_L(n) asm volatile("s_waitcnt lgkmcnt(" #n ")" ::: "memory")
#define PG8_BAR __builtin_amdgcn_s_barrier()
#define PG8_SCHED __builtin_amdgcn_sched_barrier(0)
    Unit cur, nxt; int ui = 0;
    if (!S.next(0, cur)) return;
    f32x4 acc[2][2][4][2];
#pragma unroll
    for (int a = 0; a < 2; ++a)
#pragma unroll
        for (int b = 0; b < 2; ++b)
#pragma unroll
            for (int m = 0; m < 4; ++m)
#pragma unroll
                for (int n = 0; n < 2; ++n) acc[a][b][m][n] = (f32x4){0.f, 0.f, 0.f, 0.f};
    bf16x8 At[4][2], B0[2][2], B1[2][2];
    const char* cA = (const char*)g.A + (size_t)cur.pm * tstepA + (size_t)(cur.pn >> 2) * g.agrp * 2; const char* cB = (const char*)g.Bt + (size_t)cur.pn * tstepB;
    S.a_ready(cur);
    if constexpr (SP2) {
        PG8_STAGE(PG8_SB(0, 0), cB, voffB); PG8_STAGE(PG8_SB(0, 1), cB + hstepB, voffB); PG8_STAGE(PG8_SA(0, 0), cA, voffA); PG8_STAGE(PG8_SA(0, 1), cA + hstepA, voffA);
        if (wr == 1) PG8_BAR;
        PG8_WAIT_V(2); PG8_BAR;
        PG8_STAGE(PG8_SB(1, 0), cB + kstep, voffB); PG8_STAGE(PG8_SA(1, 0), cA + kstep, voffA); PG8_STAGE(PG8_SB(1, 1), cB + hstepB + kstep, voffB);
        PG8_WAIT_V(6); PG8_BAR;
    } else {
        PG8_STAGE(PG8_SB(0, 0), cB, voffB); PG8_STAGE(PG8_SA(0, 0), cA, voffA); PG8_STAGE(PG8_SB(0, 1), cB + hstepB, voffB); PG8_STAGE(PG8_SA(0, 1), cA + hstepA, voffA);
        if (wr == 1) PG8_BAR;
        PG8_WAIT_V(4); PG8_BAR;
        PG8_STAGE(PG8_SB(1, 0), cB + kstep, voffB); PG8_STAGE(PG8_SA(1, 0), cA + kstep, voffA); PG8_STAGE(PG8_SB(1, 1), cB + hstepB + kstep, voffB);
        PG8_WAIT_V(6); PG8_BAR;
    }
    for (;;) {
        const bool has_next = S.next(ui + 1, nxt);
        const char* nA = has_next ? (const char*)g.A + (size_t)nxt.pm * tstepA + (size_t)(nxt.pn >> 2) * g.agrp * 2 : cA; const char* nB = has_next ? (const char*)g.Bt + (size_t)nxt.pn * tstepB : cB;
        for (int t = 0; t < nt; t += 2) {
            const bool last = (t == nt - 2);
            const char* a1 = cA + (size_t)(t + 1) * kstep;
            const char* a2 = last ? nA : cA + (size_t)(t + 2) * kstep; const char* b2 = last ? nB : cB + (size_t)(t + 2) * kstep;
            const char* a3 = a2 + kstep; const char* b3 = b2 + kstep;
            if (last && has_next) S.a_ready(nxt);
            if constexpr (SP2) {
            PG8_LDB(B0, 0, 0); PG8_LDB(B1, 0, 1); PG8_SCHED; PG8_LDA(At, 0, 0); PG8_STAGE(PG8_SA(1, 1), a1 + hstepA, voffA);
            PG8_WAIT_V(8); PG8_WAIT_L(0); PG8_BAR; PG8_MMA(0, 0, At, B0); PG8_MMA(0, 1, At, B1); PG8_BAR; PG8_SCHED;
            PG8_LDA(At, 0, 1); PG8_STAGE(PG8_SB(0, 0), b2, voffB); PG8_STAGE(PG8_SB(0, 1), b2 + hstepB, voffB); PG8_STAGE(PG8_SA(0, 0), a2, voffA);
            PG8_WAIT_V(8); PG8_WAIT_L(0); PG8_BAR; PG8_MMA(1, 0, At, B0); PG8_MMA(1, 1, At, B1); PG8_BAR; PG8_SCHED;
            PG8_LDB(B0, 1, 0); PG8_LDB(B1, 1, 1); PG8_SCHED; PG8_LDA(At, 1, 0); PG8_STAGE(PG8_SA(0, 1), a2 + hstepA, voffA);
            PG8_WAIT_V(8); PG8_WAIT_L(0); PG8_BAR; PG8_MMA(0, 0, At, B0); PG8_MMA(0, 1, At, B1); PG8_BAR; PG8_SCHED;
            PG8_LDA(At, 1, 1); PG8_STAGE(PG8_SB(1, 0), b3, voffB); PG8_STAGE(PG8_SB(1, 1), b3 + hstepB, voffB); PG8_STAGE(PG8_SA(1, 0), a3, voffA);
            PG8_WAIT_V(8); PG8_WAIT_L(0); PG8_BAR; PG8_MMA(1, 0, At, B0); PG8_MMA(1, 1, At, B1); PG8_BAR; PG8_SCHED;
            } else {
            PG8_LDB(B0, 0, 0); PG8_SCHED; PG8_LDA(At, 0, 0); PG8_STAGE(PG8_SA(1, 1), a1 + hstepA, voffA);
            PG8_WAIT_L(8); PG8_BAR; PG8_WAIT_L(0); PG8_MMA(0, 0, At, B0); PG8_BAR; PG8_SCHED;
            PG8_LDB(B1, 0, 1); PG8_STAGE(PG8_SB(0, 0), b2, voffB);
            PG8_BAR; PG8_WAIT_L(0); PG8_MMA(0, 1, At, B1); PG8_BAR;
            PG8_LDA(At, 0, 1); PG8_STAGE(PG8_SA(0, 0), a2, voffA);
            PG8_BAR; PG8_WAIT_L(0); PG8_MMA(1, 0, At, B0); PG8_BAR; PG8_SCHED;
            PG8_STAGE(PG8_SB(0, 1), b2 + hstepB, voffB);
            PG8_WAIT_V(6); PG8_BAR; PG8_MMA(1, 1, At, B1); PG8_BAR;
            PG8_LDB(B0, 1, 0); PG8_SCHED; PG8_LDA(At, 1, 0); PG8_STAGE(PG8_SA(0, 1), a2 + hstepA, voffA);
            PG8_WAIT_L(8); PG8_BAR; PG8_WAIT_L(0); PG8_MMA(0, 0, At, B0); PG8_BAR; PG8_SCHED;
            PG8_LDB(B1, 1, 1); PG8_STAGE(PG8_SB(1, 0), b3, voffB);
            PG8_BAR; PG8_WAIT_L(0); PG8_MMA(0, 1, At, B1); PG8_BAR;
            PG8_LDA(At, 1, 1); PG8_STAGE(PG8_SA(1, 0), a3, voffA);
            PG8_BAR; PG8_WAIT_L(0); PG8_MMA(1, 0, At, B0); PG8_BAR; PG8_SCHED;
            PG8_STAGE(PG8_SB(1, 1), b3 + hstepB, voffB);
            PG8_WAIT_V(6); PG8_BAR; PG8_MMA(1, 1, At, B1); PG8_BAR;
            }
        }
        if constexpr (ALIGN_EPI) { if (wr == 0) PG8_BAR; }
        E(acc, cur, wr, wc, fr, fq); S.done(cur);
        if (!has_next) break;
#pragma unroll
        for (int a = 0; a < 2; ++a)
#pragma unroll
            for (int b = 0; b < 2; ++b)
#pragma unroll
                for (int m = 0; m < 4; ++m)
#pragma unroll
                    for (int n = 0; n < 2; ++n) acc[a][b][m][n] = (f32x4){0.f, 0.f, 0.f, 0.f};
        cur = nxt; cA = nA; cB = nB; ++ui;
        if constexpr (ALIGN_EPI) { if (wr == 1) PG8_BAR; }
    }
    PG8_WAIT_V(0);
    if constexpr (!ALIGN_EPI) { if (wr == 0) PG8_BAR; }
    PG8_BAR;
#undef PG8_SA
#undef PG8_SB
#undef PG8_STAGE
#undef PG8_LDA
#undef PG8_LDB
#undef PG8_MMA
#undef PG8_WAIT_V
#undef PG8_WAIT_L
#undef PG8_BAR
#undef PG8_SCHED
}
}

namespace att {
constexpr int D = 128, NW = 8, QBLK = 32, KVBLK = 64;
constexpr float SCALE = 0.088388347648318440f;
constexpr int LDQ = DM, LDK = KVW, LDO = DM;
constexpr int SHM_V = KVBLK * D * 2, SHM_K = KVBLK * D * 2, SHM_ATTN = 2 * SHM_V + 2 * SHM_K + NW * 64 * 4;
#define KSWZ(row, colB) ((row) * 256 + ((colB) ^ (((row) & 7) << 4)))
#define SBAR() __builtin_amdgcn_sched_barrier(0)
__device__ __forceinline__ int crow(int r, int hi) { return (r & 3) + 8 * (r >> 2) + 4 * hi; }
__device__ __forceinline__ unsigned cvtpk(float lo, float hi) { unsigned r; asm volatile("v_cvt_pk_bf16_f32 %0, %1, %2" : "=v"(r) : "v"(lo), "v"(hi)); return r; }

constexpr float THRL = 8.f;
#define MX3(a, b, c) __builtin_fmaxf(__builtin_fmaxf((a), (b)), (c))
template <bool FIRST>
__device__ __forceinline__ bool partialSM(f32x16& p0, f32x16& p1, float& mhat, f32x16& negm, float& l_reg, LAS float* al_l, int r32, int hi) {
  float a = MX3(p0[0], p0[1], p1[0]), b = MX3(p0[2], p0[3], p1[1]); a = MX3(a, p1[2], p1[3]);
#pragma unroll
  for (int r = 4; r < 16; r += 4) { a = MX3(a, p0[r], p0[r + 1]); b = MX3(b, p0[r + 2], p0[r + 3]); a = MX3(a, p1[r], p1[r + 1]); b = MX3(b, p1[r + 2], p1[r + 3]); }
  float rm = __builtin_fmaxf(a, b);
  { auto rr = __builtin_amdgcn_permlane32_swap(__float_as_uint(rm), __float_as_uint(rm), false, false);
    rm = __builtin_fmaxf(__uint_as_float(rr[0]), __uint_as_float(rr[1])); }
  bool resc = false;
  if (FIRST) { const float dl = rm; mhat = dl;
#pragma unroll
    for (int r = 0; r < 16; ++r) { p0[r] -= dl; p1[r] -= dl; }
#pragma unroll
    for (int r = 0; r < 16; ++r) negm[r] = -mhat;
    asm volatile("" : "+v"(negm));
  } else if (__builtin_expect(__any(rm > THRL), 0)) { const float dl = __builtin_fmaxf(rm, 0.f); mhat += dl;
#pragma unroll
    for (int r = 0; r < 16; ++r) { p0[r] -= dl; p1[r] -= dl; }
#pragma unroll
    for (int r = 0; r < 16; ++r) negm[r] = -mhat;
    asm volatile("" : "+v"(negm));
    const float f = __builtin_amdgcn_exp2f(-dl); l_reg *= f; if (hi == 0) al_l[r32] = f; resc = true; }
#pragma unroll
  for (int r = 0; r < 16; ++r) p0[r] = __builtin_amdgcn_exp2f(p0[r]);
  return resc;
}
#undef MX3
__device__ __forceinline__ void finishSM(f32x16& p0, f32x16& p1, float& l_reg, bf16x8& pa0, bf16x8& pa1, bf16x8& pa2, bf16x8& pa3) {
#pragma unroll
  for (int r = 0; r < 16; ++r) p1[r] = __builtin_amdgcn_exp2f(p1[r]);
  float ps = 0;
#pragma unroll
  for (int r = 0; r < 16; ++r) ps += p0[r];
#pragma unroll
  for (int r = 0; r < 16; ++r) ps += p1[r];
  l_reg += ps;
#define PK4(P, BASE, OUT) do { unsigned a0 = cvtpk(P[BASE + 0], P[BASE + 1]), a1 = cvtpk(P[BASE + 2], P[BASE + 3]);   \
    unsigned b0 = cvtpk(P[BASE + 4], P[BASE + 5]), b1 = cvtpk(P[BASE + 6], P[BASE + 7]);                              \
    auto r0 = __builtin_amdgcn_permlane32_swap(a0, b0, false, false); auto r1 = __builtin_amdgcn_permlane32_swap(a1, b1, false, false); \
    u32x4 w = {r0[0], r1[0], r0[1], r1[1]}; OUT = *reinterpret_cast<bf16x8*>(&w); } while (0)
  PK4(p0, 0, pa0); PK4(p0, 8, pa1); PK4(p1, 0, pa2); PK4(p1, 8, pa3);
#undef PK4
}
__device__ __forceinline__ void qkt(f32x16& p0, f32x16& p1, const LAS char* Ks, const bf16x8* qr, const f32x16& negm, int r32, int hi) {
#pragma unroll
  for (int d0 = 0; d0 < 8; ++d0) { int cb = (d0 * 16 + hi * 8) * 2;
    bf16x8 b0 = *reinterpret_cast<const LAS bf16x8*>(Ks + KSWZ(r32, cb));
    bf16x8 b1 = *reinterpret_cast<const LAS bf16x8*>(Ks + KSWZ(32 + r32, cb));
    if (d0 == 0) { p0 = __builtin_amdgcn_mfma_f32_32x32x16_bf16(b0, qr[0], negm, 0, 0, 0); p1 = __builtin_amdgcn_mfma_f32_32x32x16_bf16(b1, qr[0], negm, 0, 0, 0); }
    else { p0 = __builtin_amdgcn_mfma_f32_32x32x16_bf16(b0, qr[d0], p0, 0, 0, 0); p1 = __builtin_amdgcn_mfma_f32_32x32x16_bf16(b1, qr[d0], p1, 0, 0, 0); } }
}
__device__ __forceinline__ int v_st(int k, int c) { const int kk = (k & ~0xC) | ((k & 4) << 1) | ((k & 8) >> 1); return ((kk >> 3) * 4 + (c >> 5)) * 512 + ((kk & 7) * 32 + (c & 31)) * 2; }
__device__ __forceinline__ int v_rd_base(int lane) { return ((lane & 3) << 3) | (((lane >> 2) & 3) << 6) | (((lane >> 4) & 1) << 5) | (((lane >> 5) & 1) << 8); }
constexpr int v_rd_off(int d0, int ks, int half) { return d0 * 512 + ks * 4096 + half * 2048; }
template <int OFF> __device__ __forceinline__ s16x4 tr_read(int vb) {
  s16x4 r; asm volatile("ds_read_b64_tr_b16 %0, %1 offset:%2" : "=&v"(r) : "v"(vb), "i"(OFF) : "memory"); return r;
}
template <int D0> __device__ __forceinline__ void pv_one(f32x16& od, int vb, bf16x8 pa0, bf16x8 pa1, bf16x8 pa2, bf16x8 pa3) {
  const s16x4 l0 = tr_read<v_rd_off(D0, 0, 0)>(vb), h0 = tr_read<v_rd_off(D0, 0, 1)>(vb), l1 = tr_read<v_rd_off(D0, 1, 0)>(vb), h1 = tr_read<v_rd_off(D0, 1, 1)>(vb);
  const s16x4 l2 = tr_read<v_rd_off(D0, 2, 0)>(vb), h2 = tr_read<v_rd_off(D0, 2, 1)>(vb), l3 = tr_read<v_rd_off(D0, 3, 0)>(vb), h3 = tr_read<v_rd_off(D0, 3, 1)>(vb);
  asm volatile("s_waitcnt lgkmcnt(0)" ::: "memory"); SBAR();
#define PK(L, H) (bf16x8){L[0], L[1], L[2], L[3], H[0], H[1], H[2], H[3]}
  od = __builtin_amdgcn_mfma_f32_32x32x16_bf16(pa0, PK(l0, h0), od, 0, 0, 0);
  od = __builtin_amdgcn_mfma_f32_32x32x16_bf16(pa1, PK(l1, h1), od, 0, 0, 0);
  od = __builtin_amdgcn_mfma_f32_32x32x16_bf16(pa2, PK(l2, h2), od, 0, 0, 0);
  od = __builtin_amdgcn_mfma_f32_32x32x16_bf16(pa3, PK(l3, h3), od, 0, 0, 0);
#undef PK
}
__device__ __forceinline__ void pv_d0(f32x16* o, int vb, bf16x8 pa0, bf16x8 pa1, bf16x8 pa2, bf16x8 pa3) {
  pv_one<0>(o[0], vb, pa0, pa1, pa2, pa3); pv_one<1>(o[1], vb, pa0, pa1, pa2, pa3); pv_one<2>(o[2], vb, pa0, pa1, pa2, pa3); pv_one<3>(o[3], vb, pa0, pa1, pa2, pa3);
}
__device__ __forceinline__ void attn_dense_body(const bf16_t* __restrict__ Qb, const bf16_t* __restrict__ Kh, const bf16_t* __restrict__ Vh, bf16_t* __restrict__ Ob, int seq, LAS char* lds, const int tid_in) {
  int tid_ = tid_in; asm volatile("" : "+v"(tid_));
  const int tid = tid_, wid = tid >> 6, lane = tid & 63, r32 = lane & 31, hi = lane >> 5;
  LAS char* V_lds = lds; LAS char* K_lds = lds + 2 * SHM_V;
  LAS float* ws = (LAS float*)(lds + 2 * SHM_V + 2 * SHM_K) + wid * 64; LAS float* li_l = ws; LAS float* al_l = ws + 32;
  float mhat = 0.f, l_reg = 0; f32x16 o[4] = {}; bf16x8 qr[8]; f32x16 negm = f32x16{}; asm volatile("" : "+v"(negm));
  const bf16_t* Qw = Qb + (long)(wid * QBLK + r32) * LDQ + hi * 8;
#pragma unroll
  for (int d0 = 0; d0 < 8; ++d0) qr[d0] = *reinterpret_cast<const bf16x8*>(Qw + d0 * 16);
  const int sr = tid >> 4, sc = (tid & 15) * 8, vst0 = v_st(sr, sc), vst1 = v_st(32 + sr, sc);
  const int vb0 = (int)(unsigned)(uintptr_t)V_lds + v_rd_base(lane);
  struct { bf16x8 vs0, vs1, ks0, ks1; } sr_[2];
#define SLOAD(i, k0) do { sr_[i].vs0 = *reinterpret_cast<const bf16x8*>(&Vh[(long)((k0) + sr) * LDK + sc]); sr_[i].vs1 = *reinterpret_cast<const bf16x8*>(&Vh[(long)((k0) + 32 + sr) * LDK + sc]); \
    sr_[i].ks0 = *reinterpret_cast<const bf16x8*>(&Kh[(long)((k0) + sr) * LDK + sc]); sr_[i].ks1 = *reinterpret_cast<const bf16x8*>(&Kh[(long)((k0) + 32 + sr) * LDK + sc]); } while (0)
#define SWRITE(b, i) do { *(LAS bf16x8*)(V_lds + (b) * SHM_V + vst0) = sr_[i].vs0;          \
    *(LAS bf16x8*)(V_lds + (b) * SHM_V + vst1) = sr_[i].vs1; int kc = sc * 2;               \
    *(LAS bf16x8*)(K_lds + (b) * SHM_K + KSWZ(sr, kc)) = sr_[i].ks0;                       \
    *(LAS bf16x8*)(K_lds + (b) * SHM_K + KSWZ(32 + sr, kc)) = sr_[i].ks1; } while (0)
#define SWAIT() asm volatile("s_waitcnt vmcnt(4)" ::: "memory")
#define RESC(fl) do { if (fl) { asm volatile("s_waitcnt lgkmcnt(0)" ::: "memory"); \
    _Pragma("unroll") for (int d = 0; d < 4; ++d) _Pragma("unroll") for (int r = 0; r < 16; ++r) o[d][r] *= al_l[crow(r, hi)]; } } while (0)
  f32x16 pA0, pA1, pB0, pB1; bool rsA, rsB; bf16x8 pa0, pa1, pa2, pa3; const int NT = seq / KVBLK;
  constexpr int SE = 0, SO = 1;
  SLOAD(SE, 0); asm volatile("s_waitcnt vmcnt(0)" ::: "memory"); SWRITE(0, SE); __syncthreads();
  qkt(pA0, pA1, K_lds, qr, negm, r32, hi); (void)partialSM<true>(pA0, pA1, mhat, negm, l_reg, al_l, r32, hi);
  SLOAD(SO, KVBLK); if (2 < NT) SLOAD(SE, 2 * KVBLK);
  SWAIT(); SWRITE(1, SO); __syncthreads();
  for (int j = 1; j + 1 < NT; j += 2) {
    SBAR(); qkt(pB0, pB1, K_lds + SHM_K, qr, negm, r32, hi);
    finishSM(pA0, pA1, l_reg, pa0, pa1, pa2, pa3); SBAR();
    SLOAD(SO, (j + 2) * KVBLK); SBAR();
    pv_d0(o, vb0, pa0, pa1, pa2, pa3); rsB = partialSM<false>(pB0, pB1, mhat, negm, l_reg, al_l, r32, hi);
    __syncthreads(); SWAIT(); SWRITE(0, SE);
    RESC(rsB); __syncthreads();
    SBAR(); qkt(pA0, pA1, K_lds, qr, negm, r32, hi);
    finishSM(pB0, pB1, l_reg, pa0, pa1, pa2, pa3); SBAR();
    if (j + 3 < NT) SLOAD(SE, (j + 3) * KVBLK); SBAR();
    pv_d0(o, vb0 + SHM_V, pa0, pa1, pa2, pa3); rsA = partialSM<false>(pA0, pA1, mhat, negm, l_reg, al_l, r32, hi);
    __syncthreads(); SWAIT(); SWRITE(1, SO);
    RESC(rsA); __syncthreads();
  }
  SBAR(); qkt(pB0, pB1, K_lds + SHM_K, qr, negm, r32, hi);
  finishSM(pA0, pA1, l_reg, pa0, pa1, pa2, pa3); SBAR();
  pv_d0(o, vb0, pa0, pa1, pa2, pa3); rsB = partialSM<false>(pB0, pB1, mhat, negm, l_reg, al_l, r32, hi);
  __syncthreads(); RESC(rsB);
  finishSM(pB0, pB1, l_reg, pa0, pa1, pa2, pa3); SBAR();
  pv_d0(o, vb0 + SHM_V, pa0, pa1, pa2, pa3);
  { auto rr = __builtin_amdgcn_permlane32_swap(__float_as_uint(l_reg), __float_as_uint(l_reg), false, false); l_reg = __uint_as_float(rr[0]) + __uint_as_float(rr[1]); }
  if (hi == 0) li_l[r32] = l_reg; asm volatile("s_waitcnt lgkmcnt(0)" ::: "memory");
  float rli[16];
#pragma unroll
  for (int r = 0; r < 16; ++r) rli[r] = __builtin_amdgcn_rcpf(li_l[crow(r, hi)]);
  bf16_t* Ow = Ob + (long)(wid * QBLK) * LDO;
#pragma unroll
  for (int r = 0; r < 16; ++r) { const int orow = crow(r, hi);
#pragma unroll
    for (int d0 = 0; d0 < 4; ++d0) { const unsigned w = cvtpk(o[d0][r] * rli[r], 0.f); Ow[(long)orow * LDO + d0 * 32 + r32] = (bf16_t)(w & 0xffffu); } }
#undef SLOAD
#undef SWRITE
#undef SWAIT
#undef RESC
}

template <int OFF> __device__ __forceinline__ bf16x8 lds_rd128(int a) { bf16x8 r; asm volatile("ds_read_b128 %0, %1 offset:%2" : "=&v"(r) : "v"(a), "i"(OFF) : "memory"); return r; }
#define MX3(a, b, c) __builtin_fmaxf(__builtin_fmaxf((a), (b)), (c))
__device__ __forceinline__ bool partialSM_head(f32x16& p0, f32x16& p1, float& mhat, f32x16& negm, float& l_reg, LAS float* al_l, int r32, int hi) {
  float a = MX3(p0[0], p0[1], p1[0]), b = MX3(p0[2], p0[3], p1[1]); a = MX3(a, p1[2], p1[3]);
#pragma unroll
  for (int r = 4; r < 16; r += 4) { a = MX3(a, p0[r], p0[r + 1]); b = MX3(b, p0[r + 2], p0[r + 3]); a = MX3(a, p1[r], p1[r + 1]); b = MX3(b, p1[r + 2], p1[r + 3]); }
  float rm = __builtin_fmaxf(a, b);
  { auto rr = __builtin_amdgcn_permlane32_swap(__float_as_uint(rm), __float_as_uint(rm), false, false);
    rm = __builtin_fmaxf(__uint_as_float(rr[0]), __uint_as_float(rr[1])); }
  bool resc = false;
  if (__builtin_expect(__any(rm > THRL), 0)) { const float dl = __builtin_fmaxf(rm, 0.f); mhat += dl;
#pragma unroll
    for (int r = 0; r < 16; ++r) { p0[r] -= dl; p1[r] -= dl; }
#pragma unroll
    for (int r = 0; r < 16; ++r) negm[r] = -mhat;
    asm volatile("" : "+v"(negm));
    const float f = __builtin_amdgcn_exp2f(-dl); l_reg *= f; if (hi == 0) al_l[r32] = f; resc = true; }
  return resc;
}
#undef MX3
constexpr int RSLOT = 16384, RING_ATTN = 6 * RSLOT + NW * 64 * 4;
__device__ __forceinline__ void attn_ring_body(const bf16_t* __restrict__ Qb, const bf16_t* __restrict__ Kh, const bf16_t* __restrict__ Vh, bf16_t* __restrict__ Ob, int seq, LAS char* lds, const int tid_in) {
  int tid_ = tid_in; asm volatile("" : "+v"(tid_));
  const int tid = tid_, wid = __builtin_amdgcn_readfirstlane(tid >> 6), lane = tid & 63, r32 = lane & 31, hi = lane >> 5;
  LAS char* K_lds = lds; LAS char* V_lds = lds + 3 * RSLOT;
  LAS float* ws = (LAS float*)(lds + 6 * RSLOT) + wid * 64; LAS float* li_l = ws; LAS float* al_l = ws + 32;
  int koff[2], voff[2];
#pragma unroll
  for (int e = 0; e < 2; ++e) { const int i = 2 * wid + e;
    const int krow = 4 * i + (lane >> 4), cp = lane & 15, kc = cp ^ (krow & 7); koff[e] = krow * LDK + 8 * kc;
    const int sub = 2 * i + (lane >> 5), q = lane & 31, kk = (sub >> 2) * 8 + (q >> 2), c = (sub & 3) * 32 + (q & 3) * 8, k = (kk & ~0xC) | ((kk & 4) << 1) | ((kk & 8) >> 1); voff[e] = k * LDK + c; }
  const unsigned pdst = (unsigned)(2 * wid) * 1024u;
#define DMA_K(t, slot) do { _Pragma("unroll") for (int e = 0; e < 2; ++e) __builtin_amdgcn_global_load_lds((const unsigned*)(Kh + (long)(t) * KVBLK * LDK + koff[e]), (LAS unsigned*)(K_lds + (slot) + pdst + e * 1024), 16, 0, 0); } while (0)
#define DMA_V(t, slot) do { _Pragma("unroll") for (int e = 0; e < 2; ++e) __builtin_amdgcn_global_load_lds((const unsigned*)(Vh + (long)(t) * KVBLK * LDK + voff[e]), (LAS unsigned*)(V_lds + (slot) + pdst + e * 1024), 16, 0, 0); } while (0)
#define WAIT_BAR(N) asm volatile("s_waitcnt vmcnt(" #N ") lgkmcnt(0)\n\ts_barrier" ::: "memory")
  const int NT = seq / KVBLK;
  int cur = 0, nxt = RSLOT, nn = 2 * RSLOT;
#define ROT() do { const int t_ = cur; cur = nxt; nxt = nn; nn = t_; } while (0)
  DMA_K(0, 0); DMA_V(0, 0); DMA_K(1, RSLOT);
  float mhat = 0.f, l_reg = 0; f32x16 o[4] = {}; bf16x8 qr[8]; f32x16 negm = f32x16{}; asm volatile("" : "+v"(negm));
  const bf16_t* Qw = Qb + (long)(wid * QBLK + r32) * LDQ + hi * 8;
#pragma unroll
  for (int d0 = 0; d0 < 8; ++d0) qr[d0] = *reinterpret_cast<const bf16x8*>(Qw + d0 * 16);
  const int vb0 = (int)(unsigned)(uintptr_t)V_lds + v_rd_base(lane);
#define RESC(fl) do { if (fl) { asm volatile("s_waitcnt lgkmcnt(0)" ::: "memory"); \
    _Pragma("unroll") for (int d = 0; d < 4; ++d) _Pragma("unroll") for (int r = 0; r < 16; ++r) o[d][r] *= al_l[crow(r, hi)]; } } while (0)
  f32x16 pA0, pA1, pB0, pB1; bool rs; bf16x8 pa0, pa1, pa2, pa3;
  WAIT_BAR(0);
  qkt(pA0, pA1, K_lds + cur, qr, negm, r32, hi); (void)partialSM<true>(pA0, pA1, mhat, negm, l_reg, al_l, r32, hi);
  DMA_K(2, nn); DMA_V(1, nxt);
  WAIT_BAR(4); ROT();
  const int kbase = (int)(unsigned)(uintptr_t)K_lds + r32 * 256;
  const int kad0 = kbase + (((0 + hi) ^ (r32 & 7)) << 4), kad1 = kbase + (((2 + hi) ^ (r32 & 7)) << 4), kad2 = kbase + (((4 + hi) ^ (r32 & 7)) << 4), kad3 = kbase + (((6 + hi) ^ (r32 & 7)) << 4);
#define WAITL(N) asm volatile("s_waitcnt lgkmcnt(" #N ")" ::: "memory")
#define MFQ(acc, kf, d0, c) acc = __builtin_amdgcn_mfma_f32_32x32x16_bf16(kf, qr[d0], c, 0, 0, 0)
#define EXP8(P, B) do { _Pragma("unroll") for (int r_ = 0; r_ < 8; ++r_) P[(B) + r_] = __builtin_amdgcn_exp2f(P[(B) + r_]); } while (0)
#define SUM8(P, B) do { _Pragma("unroll") for (int r_ = 0; r_ < 8; ++r_) ps_ += P[(B) + r_]; } while (0)
#define PK4(P, BASE, OUT) do { unsigned a0 = cvtpk(P[BASE + 0], P[BASE + 1]), a1 = cvtpk(P[BASE + 2], P[BASE + 3]);   \
    unsigned b0 = cvtpk(P[BASE + 4], P[BASE + 5]), b1 = cvtpk(P[BASE + 6], P[BASE + 7]);                              \
    auto r0 = __builtin_amdgcn_permlane32_swap(a0, b0, false, false); auto r1 = __builtin_amdgcn_permlane32_swap(a1, b1, false, false); \
    u32x4 w = {r0[0], r1[0], r0[1], r1[1]}; OUT = *reinterpret_cast<bf16x8*>(&w); } while (0)
#define PKV(L, H) (bf16x8){L[0], L[1], L[2], L[3], H[0], H[1], H[2], H[3]}
#define RDV(D0, l0, h0, l1, h1, l2, h2, l3, h3) const s16x4 l0 = tr_read<v_rd_off(D0, 0, 0)>(vb_), h0 = tr_read<v_rd_off(D0, 0, 1)>(vb_), l1 = tr_read<v_rd_off(D0, 1, 0)>(vb_), h1 = tr_read<v_rd_off(D0, 1, 1)>(vb_), \
    l2 = tr_read<v_rd_off(D0, 2, 0)>(vb_), h2 = tr_read<v_rd_off(D0, 2, 1)>(vb_), l3 = tr_read<v_rd_off(D0, 3, 0)>(vb_), h3 = tr_read<v_rd_off(D0, 3, 1)>(vb_)
#define MFV(od, l0, h0, l1, h1, l2, h2, l3, h3) do { od = __builtin_amdgcn_mfma_f32_32x32x16_bf16(pa0, PKV(l0, h0), od, 0, 0, 0); od = __builtin_amdgcn_mfma_f32_32x32x16_bf16(pa1, PKV(l1, h1), od, 0, 0, 0); \
    od = __builtin_amdgcn_mfma_f32_32x32x16_bf16(pa2, PKV(l2, h2), od, 0, 0, 0); od = __builtin_amdgcn_mfma_f32_32x32x16_bf16(pa3, PKV(l3, h3), od, 0, 0, 0); } while (0)
#define ITER(X0, X1, Y0, Y1, t) do { \
    SBAR(); \
    { const int a0_ = kad0 + cur, a1_ = kad1 + cur, a2_ = kad2 + cur, a3_ = kad3 + cur; const int vb_ = vb0 + nn; float ps_ = 0.f; \
      const bf16x8 k00 = lds_rd128<0>(a0_), k01 = lds_rd128<8192>(a0_), k10 = lds_rd128<0>(a1_), k11 = lds_rd128<8192>(a1_); \
      const bf16x8 k20 = lds_rd128<0>(a2_), k21 = lds_rd128<8192>(a2_), k30 = lds_rd128<0>(a3_), k31 = lds_rd128<8192>(a3_); \
      WAITL(4); SBAR(); \
      MFQ(X0, k00, 0, negm); MFQ(X1, k01, 0, negm); MFQ(X0, k10, 1, X0); MFQ(X1, k11, 1, X1); \
      EXP8(Y1, 0); PK4(Y0, 0, pa0); SUM8(Y0, 0); \
      const bf16x8 k40 = lds_rd128<128>(a0_), k41 = lds_rd128<8192 + 128>(a0_), k50 = lds_rd128<128>(a1_), k51 = lds_rd128<8192 + 128>(a1_); \
      WAITL(4); SBAR(); \
      MFQ(X0, k20, 2, X0); MFQ(X1, k21, 2, X1); MFQ(X0, k30, 3, X0); MFQ(X1, k31, 3, X1); \
      EXP8(Y1, 8); PK4(Y0, 8, pa1); SUM8(Y0, 8); \
      if ((t) + 2 < NT) DMA_K((t) + 2, nn); \
      const bf16x8 k60 = lds_rd128<128>(a2_), k61 = lds_rd128<8192 + 128>(a2_), k70 = lds_rd128<128>(a3_), k71 = lds_rd128<8192 + 128>(a3_); \
      WAITL(4); SBAR(); \
      MFQ(X0, k40, 4, X0); MFQ(X1, k41, 4, X1); MFQ(X0, k50, 5, X0); MFQ(X1, k51, 5, X1); \
      PK4(Y1, 0, pa2); SUM8(Y1, 0); \
      if ((t) + 1 < NT) DMA_V((t) + 1, nxt); \
      RDV(0, vl00, vh00, vl01, vh01, vl02, vh02, vl03, vh03); \
      WAITL(8); SBAR(); \
      MFQ(X0, k60, 6, X0); MFQ(X1, k61, 6, X1); MFQ(X0, k70, 7, X0); MFQ(X1, k71, 7, X1); \
      PK4(Y1, 8, pa3); SUM8(Y1, 8); l_reg += ps_; \
      RDV(1, vl10, vh10, vl11, vh11, vl12, vh12, vl13, vh13); \
      WAITL(8); SBAR(); \
      MFV(o[0], vl00, vh00, vl01, vh01, vl02, vh02, vl03, vh03); \
      rs = partialSM_head(X0, X1, mhat, negm, l_reg, al_l, r32, hi); \
      RDV(2, vl20, vh20, vl21, vh21, vl22, vh22, vl23, vh23); \
      WAITL(8); SBAR(); \
      MFV(o[1], vl10, vh10, vl11, vh11, vl12, vh12, vl13, vh13); \
      EXP8(X0, 0); \
      RDV(3, vl30, vh30, vl31, vh31, vl32, vh32, vl33, vh33); \
      WAITL(8); SBAR(); \
      MFV(o[2], vl20, vh20, vl21, vh21, vl22, vh22, vl23, vh23); \
      EXP8(X0, 8); \
      WAITL(0); SBAR(); \
      MFV(o[3], vl30, vh30, vl31, vh31, vl32, vh32, vl33, vh33); } \
    if ((t) + 2 < NT) WAIT_BAR(4); else if ((t) + 1 < NT) WAIT_BAR(2); else WAIT_BAR(0); \
    RESC(rs); ROT(); } while (0)
  int t = 1;
  for (; t + 1 < NT; t += 2) { ITER(pB0, pB1, pA0, pA1, t); ITER(pA0, pA1, pB0, pB1, t + 1); }
  ITER(pB0, pB1, pA0, pA1, t);
  finishSM(pB0, pB1, l_reg, pa0, pa1, pa2, pa3); SBAR();
  pv_d0(o, vb0 + nn, pa0, pa1, pa2, pa3);
  { auto rr = __builtin_amdgcn_permlane32_swap(__float_as_uint(l_reg), __float_as_uint(l_reg), false, false); l_reg = __uint_as_float(rr[0]) + __uint_as_float(rr[1]); }
  if (hi == 0) li_l[r32] = l_reg; asm volatile("s_waitcnt lgkmcnt(0)" ::: "memory");
  float rli[16];
#pragma unroll
  for (int r = 0; r < 16; ++r) rli[r] = __builtin_amdgcn_rcpf(li_l[crow(r, hi)]);
  bf16_t* Ow = Ob + (long)(wid * QBLK) * LDO;
#pragma unroll
  for (int r = 0; r < 16; ++r) { const int orow = crow(r, hi);
#pragma unroll
    for (int d0 = 0; d0 < 4; ++d0) { const unsigned w = cvtpk(o[d0][r] * rli[r], 0.f); Ow[(long)orow * LDO + d0 * 32 + r32] = (bf16_t)(w & 0xffffu); } }
  asm volatile("s_waitcnt lgkmcnt(0)\n\ts_barrier" ::: "memory");
#undef DMA_K
#undef DMA_V
#undef WAIT_BAR
#undef ROT
#undef RESC
#undef ITER
#undef WAITL
#undef MFQ
#undef EXP8
#undef SUM8
#undef PK4
#undef PKV
#undef RDV
#undef MFV
}
#undef SBAR
}

constexpr int NWAVES = 8;
constexpr int N_PHASES = 1 + 11 * DEPTH;
constexpr int N_LAUNCHES = MK_N_LAUNCHES;
static_assert(N_LAUNCHES == 1 || N_LAUNCHES == N_PHASES, "MK_N_LAUNCHES is 1 or 23");

constexpr size_t MiB = 1u << 20;
constexpr size_t WS_CTL = 0, CTL_ZERO_BYTES = 1 * MiB;
constexpr size_t WS_ROPE = 1 * MiB;
constexpr size_t WS_PB = 2 * MiB;
constexpr size_t WS_W = 16 * MiB;
constexpr size_t LW_IN = 0, LW_POOL = 128 * MiB, LW_OUT = 132 * MiB, LW_GU = 164 * MiB, LW_DOWN = 336 * MiB, LW_PIN = 422 * MiB, LW_PG = 424 * MiB, LW_BYTES = 456 * MiB;
constexpr size_t WS_ACT = WS_W + 2 * LW_BYTES;
constexpr size_t WS_H = WS_ACT;
constexpr size_t WS_Q = WS_H + 64 * MiB;
constexpr size_t WS_K = WS_Q + 64 * MiB;
constexpr size_t WS_V = WS_K + 16 * MiB;
constexpr size_t WS_U = WS_V + 16 * MiB;
constexpr size_t WS_GA = WS_U + 32 * MiB;
constexpr size_t WS_GP = WS_GA + 64 * MiB;
constexpr size_t WS_Q2 = WS_GP + 64 * MiB;
constexpr size_t WS_K2 = WS_Q2 + 64 * MiB;
constexpr size_t WS_DL = WS_K2 + 16 * MiB;
constexpr size_t WS_O = WS_DL + 32 * MiB;
constexpr size_t WS_MG = WS_O + 64 * MiB;
constexpr size_t WS_Y = WS_MG + 64 * MiB;
constexpr size_t WS_F = WS_Y + 64 * MiB;
constexpr size_t WS_E = WS_F + 172 * MiB;
constexpr size_t WS_END = WS_E + 128 * MiB;
static_assert(WS_END <= 2048 * MiB, "workspace map");

constexpr int CW_TMO = 0, CW_CODE = 1;
constexpr int CW_BAR = 4096;

constexpr int RING_OFF = 0, RING_BYTES = 131072;
constexpr int LDSCTL_OFF = RING_BYTES, MISC_OFF = LDSCTL_OFF + 320;
constexpr int LDS_BYTES = 147456;

typedef GAS unsigned gu32;
#define RLX_AGENT __ATOMIC_RELAXED, __HIP_MEMORY_SCOPE_AGENT
#define LDS_WAIT() asm volatile("s_waitcnt lgkmcnt(0)" ::: "memory")
#define VM_WAIT() asm volatile("s_waitcnt vmcnt(0)" ::: "memory")
__device__ __forceinline__ unsigned f2bf(float f) { unsigned u = __builtin_bit_cast(unsigned, f); return (u + 0x7fffu + ((u >> 16) & 1u)) >> 16; }
__device__ __forceinline__ unsigned pk2(float lo, float hi) { return f2bf(lo) | (f2bf(hi) << 16); }

#define XB_TMO      128
#define XB_XCNT(j)  (256  + 64 * (j))
#define XB_XSUB(j)  (1280 + 64 * (j))
#define XB_XGEN(j)  (2304 + 64 * (j))
#define XB_TOP      3328
#define XB_TOPGEN   3392
#define XCD_BAR_WORDS 3456
#define XB_SPIN_CAP (1u << 18)

__device__ __forceinline__ unsigned xb_ld(unsigned* p)              { return __hip_atomic_load(p, __ATOMIC_RELAXED, __HIP_MEMORY_SCOPE_AGENT); }
__device__ __forceinline__ unsigned xb_add(unsigned* p, unsigned v) { return __hip_atomic_fetch_add(p, v, __ATOMIC_RELAXED, __HIP_MEMORY_SCOPE_AGENT); }
__device__ __forceinline__ unsigned xb_xcc_id() { return (unsigned)__builtin_amdgcn_s_getreg((3 << 11) | 20) & 0xFu; }
#define XB_SPIN(cond, bar) do { unsigned _sp = 0; while (cond) { __builtin_amdgcn_s_sleep(1); \
    if ((++_sp & 255u) == 0u) { if (xb_ld(&(bar)[XB_TMO])) break; if (_sp > XB_SPIN_CAP) { atomicAdd(&(bar)[XB_TMO], 1u); break; } } } } while (0)

struct XcdBarrier {
    unsigned* bar; unsigned x;
    volatile LAS unsigned* st;
};
__device__ __forceinline__ XcdBarrier xcd_barrier_post(unsigned* bar, volatile LAS unsigned* st) {
    XcdBarrier b; b.bar = bar; b.x = xb_xcc_id(); b.st = st;
    if (threadIdx.x == 0) (void)xb_add(&bar[XB_XCNT(b.x)], 1u);
    return b;
}
__device__ __forceinline__ void xcd_barrier_complete(unsigned* bar, unsigned x, unsigned& nloc, unsigned& nx) {
    const unsigned G = gridDim.x * gridDim.y * gridDim.z;
    unsigned sum, cnt, mine, sp = 0u;
    for (;;) {
        sum = 0u; cnt = 0u; mine = 0u;
#pragma unroll
        for (unsigned j = 0; j < 16; ++j) { const unsigned c = xb_ld(&bar[XB_XCNT(j)]); sum += c; cnt += (c > 0u) ? 1u : 0u; mine = (j == x) ? c : mine; }
        if (sum == G) break;
        __builtin_amdgcn_s_sleep(1);
        if ((++sp & 255u) == 0u) { if (xb_ld(&bar[XB_TMO])) break; if (sp > XB_SPIN_CAP) { atomicAdd(&bar[XB_TMO], 1u); break; } }
    }
    nloc = mine > 0u ? mine : 1u; nx = cnt > 0u ? cnt : 1u;
}
__device__ __forceinline__ void xcd_barrier(const XcdBarrier& b, const int wave_s) {
    asm volatile("s_waitcnt vmcnt(0)" ::: "memory");
    __syncthreads();
    unsigned m_ = ~0u; asm volatile("" : "+s"(m_));
    if (wave_s == 0 && __builtin_amdgcn_mbcnt_hi(m_, __builtin_amdgcn_mbcnt_lo(m_, 0u)) == 0u) {
        unsigned* bar = b.bar; asm volatile("" : "+s"(bar));
        __builtin_amdgcn_s_waitcnt(0);
        unsigned nloc = b.st[0], nx = b.st[1];
        if (nloc == 0u) { xcd_barrier_complete(bar, b.x, nloc, nx); b.st[0] = nloc; b.st[1] = nx; }
        const unsigned old = xb_add(&bar[XB_XSUB(b.x)], 1u);
        const unsigned gen = old / nloc;
        if (old + 1u == (gen + 1u) * nloc) {
            __builtin_amdgcn_fence(__ATOMIC_RELEASE, "agent");
            asm volatile("s_waitcnt vmcnt(0)" ::: "memory");
            const unsigned og = xb_add(&bar[XB_TOP], 1u);
            const unsigned tg = og / nx;
            if (og + 1u == (tg + 1u) * nx) xb_add(&bar[XB_TOPGEN], 1u);
            else XB_SPIN(xb_ld(&bar[XB_TOPGEN]) == tg, bar);
            __builtin_amdgcn_fence(__ATOMIC_ACQUIRE, "agent");
            xb_add(&bar[XB_XGEN(b.x)], 1u);
            asm volatile("s_waitcnt vmcnt(0)" ::: "memory");
        } else {
            XB_SPIN(xb_ld(&bar[XB_XGEN(b.x)]) == gen, bar);
            __builtin_amdgcn_fence(__ATOMIC_ACQUIRE, "agent");
            asm volatile("s_waitcnt vmcnt(0)" ::: "memory");
        }
    }
    __syncthreads();
}

struct Frame {
    LAS unsigned char* lds;
    int tid, lane, wave;
    int vcu, G, bx;
};
__device__ __forceinline__ int thread_id(int wave_s) { unsigned m = ~0u; asm volatile("" : "+s"(m)); const int lane = (int)__builtin_amdgcn_mbcnt_hi(m, __builtin_amdgcn_mbcnt_lo(m, 0u)); int t = wave_s * 64 + lane; asm volatile("" : "+v"(t)); return t; }
__device__ __forceinline__ Frame make_frame(LAS unsigned char* lds, int wave_s) {
    Frame F; const int t = thread_id(wave_s); int bx = blockIdx.x; asm volatile("" : "+s"(bx)); int G = gridDim.x; asm volatile("" : "+s"(G));
    F.lds = lds; F.tid = t; F.lane = t & 63; F.wave = wave_s; F.G = G; F.bx = bx;
    F.vcu = (G % 8 == 0) ? (bx % 8) * (G / 8) + bx / 8 : bx;
    return F;
}

__device__ __forceinline__ float shx(float v, int m, int lane) { return __int_as_float(__builtin_amdgcn_ds_bpermute((lane ^ m) << 2, __float_as_int(v))); }
__device__ __forceinline__ float wave_sum(float v, int lane) {
#pragma unroll
    for (int o = 1; o < 64; o <<= 1) v += shx(v, o, lane);
    return v;
}

template <int MAP>
__device__ __forceinline__ void p0_transpose_item(const float* W, int K, int N, bf16_t* WT, int row_off, LAS float* scr, int item, int lane) {
    const int nblk = N / 32, kb = item / nblk, nb = item % nblk, k0 = 64 * kb, n0 = 32 * nb;
    const int r0 = (MAP == 0) ? (row_off + n0) : (256 * (n0 >> 7) + (n0 & 127) + row_off);
#pragma unroll 8
    for (int i = 0; i < 32; ++i) { const int kk = 2 * i + (lane >> 5); scr[kk * 33 + (lane & 31)] = W[(size_t)(k0 + kk) * N + n0 + (lane & 31)]; }
    LDS_WAIT(); asm volatile("" ::: "memory");
    const int c = lane & 7;
#pragma unroll
    for (int j = 0; j < 4; ++j) { const int n = (lane >> 3) + 8 * j; const LAS float* s = scr + (8 * c) * 33 + n;
        u32x4 o; o.x = pk2(s[0 * 33], s[1 * 33]); o.y = pk2(s[2 * 33], s[3 * 33]); o.z = pk2(s[4 * 33], s[5 * 33]); o.w = pk2(s[6 * 33], s[7 * 33]);
        *(GAS u32x4*)(WT + (size_t)(r0 + n) * K + k0 + 8 * c) = o; }
    LDS_WAIT(); asm volatile("" ::: "memory");
}

struct Args { const float* in[18]; float* out; unsigned char* ws; int ph_lo, ph_hi; };

__device__ __forceinline__ void norm_row(int lane, const float* xin, float* xout, const bf16_t* y, const LAS float* gpost, const LAS float* gpre, bf16_t* h, int hmode) {
    const GAS f32x4* xr = (const GAS f32x4*)xin + lane;
    f32x4 v[16];
#pragma unroll
    for (int j = 0; j < 16; ++j) v[j] = xr[64 * j];
    if (y) {
        const GAS u32x2* yr = (const GAS u32x2*)y + lane; f32x4 yv[16]; float s = 0.f;
#pragma unroll
        for (int j = 0; j < 16; ++j) { const u32x2 w = yr[64 * j]; yv[j] = (f32x4){bf_lo(w.x), bf_hi(w.x), bf_lo(w.y), bf_hi(w.y)}; s += (yv[j].x * yv[j].x + yv[j].y * yv[j].y) + (yv[j].z * yv[j].z + yv[j].w * yv[j].w); }
        const float rstd = 1.0f / sqrtf(wave_sum(s, lane) * (1.f / DM) + EPS);
#pragma unroll
        for (int j = 0; j < 16; ++j) { const f32x4 g = *(const LAS f32x4*)(gpost + 4 * lane + 256 * j); v[j] = v[j] + yv[j] * rstd * g; }
    }
    if (xout) { GAS f32x4* xo = (GAS f32x4*)xout + lane;
#pragma unroll
        for (int j = 0; j < 16; ++j) xo[64 * j] = v[j]; }
    if (hmode) {
        float rstd = 1.f;
        if (hmode == 2) { float s = 0.f;
#pragma unroll
            for (int j = 0; j < 16; ++j) s += (v[j].x * v[j].x + v[j].y * v[j].y) + (v[j].z * v[j].z + v[j].w * v[j].w);
            rstd = 1.0f / sqrtf(wave_sum(s, lane) * (1.f / DM) + EPS); }
        GAS u32x2* ho = (GAS u32x2*)h + lane;
#pragma unroll
        for (int j = 0; j < 16; ++j) { f32x4 t = v[j] * rstd; if (hmode == 2) { const f32x4 g = *(const LAS f32x4*)(gpre + 4 * lane + 256 * j); t = t * g; }
            u32x2 w; w.x = cvt_pk_bf16(t.x, t.y); w.y = cvt_pk_bf16(t.z, t.w); ho[64 * j] = w; }
    }
}
__device__ __forceinline__ void norm_pass(Frame& F, const float* xin, float* xout, const bf16_t* y, const float* gpost, const float* gpre, bf16_t* h, int hmode) {
    LAS float* gl = (LAS float*)(F.lds + RING_OFF);
    __syncthreads();
    for (int i = F.tid; i < DM; i += NWAVES * 64) { gl[i] = gpost ? gpost[i] : 0.f; gl[DM + i] = gpre ? gpre[i] : 0.f; }
    __syncthreads();
    const int gw = F.vcu * NWAVES + F.wave, NGW = F.G * NWAVES;
    for (int m = gw; m < S; m += NGW)
        norm_row(F.lane, xin + (size_t)m * DM, xout ? xout + (size_t)m * DM : nullptr, y ? y + (size_t)m * DM : nullptr, gl, gl + DM, h ? h + (size_t)m * DM : nullptr, hmode);
    __syncthreads();
}

__device__ __forceinline__ void qk_item_addr(int it, int dsub, const bf16_t* Qr, const bf16_t* Kr, bf16_t* Q2, bf16_t* K2, const bf16_t*& src, bf16_t*& dst, int& row, bool& isq) {
    row = it / (NH + NKV); const int hh = it % (NH + NKV); isq = hh < NH;
    src = isq ? Qr + (size_t)row * DM + hh * HD + dsub : Kr + (size_t)row * KVW + (hh - NH) * HD + dsub;
    dst = isq ? Q2 + (size_t)row * DM + hh * HD + dsub : K2 + (size_t)row * KVW + (hh - NH) * HD + dsub;
}
__device__ __forceinline__ void qk_item_do(const u32x4 w, bf16_t* dst, int row, bool isq, int lane, int s, const float* qn, const float* kn, const float* rope) {
    const int dsub = 8 * s, axis = s >> 3, half = (s >> 2) & 1, i0 = 8 * (s & 3);
    const float* gn = isq ? qn : kn;
    float x[8] = {bf_lo(w.x), bf_hi(w.x), bf_lo(w.y), bf_hi(w.y), bf_lo(w.z), bf_hi(w.z), bf_lo(w.w), bf_hi(w.w)};
    float ss = 0.f;
#pragma unroll
    for (int j = 0; j < 8; ++j) ss += x[j] * x[j];
    ss += shx(ss, 1, lane); ss += shx(ss, 2, lane); ss += shx(ss, 4, lane); ss += shx(ss, 8, lane);
    const float rstd = 1.0f / sqrtf(ss * (1.f / HD) + EPS);
    const f32x4 ga = *(const f32x4*)(gn + dsub), gb = *(const f32x4*)(gn + dsub + 4);
    const float g[8] = {ga.x, ga.y, ga.z, ga.w, gb.x, gb.y, gb.z, gb.w};
    const float rs = isq ? rstd * (att::SCALE * 1.4426950408889634f) : rstd;
#pragma unroll
    for (int j = 0; j < 8; ++j) x[j] = x[j] * rs * g[j];
    float xp[8];
#pragma unroll
    for (int j = 0; j < 8; ++j) xp[j] = shx(x[j], 4, lane);
    const int pos = axis ? (row & 63) : (row >> 6);
    const f32x4* tp = (const f32x4*)(rope + ((size_t)pos * 32 + i0) * 2);
    float o[8];
#pragma unroll
    for (int jj = 0; jj < 4; ++jj) { const f32x4 cs = tp[jj];
        o[2 * jj]     = half ? (x[2 * jj] * cs.x + xp[2 * jj] * cs.y)         : (x[2 * jj] * cs.x - xp[2 * jj] * cs.y);
        o[2 * jj + 1] = half ? (x[2 * jj + 1] * cs.z + xp[2 * jj + 1] * cs.w) : (x[2 * jj + 1] * cs.z - xp[2 * jj + 1] * cs.w); }
    u32x4 ow; ow.x = cvt_pk_bf16(o[0], o[1]); ow.y = cvt_pk_bf16(o[2], o[3]); ow.z = cvt_pk_bf16(o[4], o[5]); ow.w = cvt_pk_bf16(o[6], o[7]);
    *(GAS u32x4*)dst = ow;
}
__device__ __forceinline__ void qk_norm_rope_pass(Frame& F, const bf16_t* Qr, const bf16_t* Kr, bf16_t* Q2, bf16_t* K2, const float* qn, const float* kn, const float* rope) {
    const int gw = F.vcu * NWAVES + F.wave, NGW = F.G * NWAVES;
    const int g16 = F.lane >> 4, s = F.lane & 15;
    constexpr int NITEM = S * (NH + NKV);
    const int step = 4 * NGW;
    for (int it = 4 * gw + g16; it < NITEM; it += 4 * step) {
        const bf16_t* src[4]; bf16_t* dst[4]; int row[4]; bool isq[4]; u32x4 w[4];
#pragma unroll
        for (int u = 0; u < 4; ++u) { const int iu = it + u * step; qk_item_addr(iu < NITEM ? iu : it, 8 * s, Qr, Kr, Q2, K2, src[u], dst[u], row[u], isq[u]); w[u] = *(const GAS u32x4*)src[u]; }
#pragma unroll
        for (int u = 0; u < 4; ++u) if (it + u * step < NITEM) qk_item_do(w[u], dst[u], row[u], isq[u], F.lane, s, qn, kn, rope);
    }
}
template <int HW> __device__ __forceinline__ void pool_item(const bf16_t* U, bf16_t* DL, int t, int c) {
    u32x4 w[2 * HW];
#pragma unroll
    for (int i = 0; i < 2 * HW; ++i) { int r = t - HW + i; r = r < 0 ? 0 : (r >= S ? S - 1 : r); w[i] = *(const GAS u32x4*)(U + (size_t)r * POOLW + 8 * c); }
    float acc[8] = {0.f, 0.f, 0.f, 0.f, 0.f, 0.f, 0.f, 0.f};
#pragma unroll
    for (int i = 0; i < 2 * HW; ++i) { const int r = t - HW + i; const float m = ((unsigned)r < (unsigned)S) ? 1.f : 0.f;
        acc[0] += m * bf_lo(w[i].x); acc[1] += m * bf_hi(w[i].x); acc[2] += m * bf_lo(w[i].y); acc[3] += m * bf_hi(w[i].y); acc[4] += m * bf_lo(w[i].z); acc[5] += m * bf_hi(w[i].z); acc[6] += m * bf_lo(w[i].w); acc[7] += m * bf_hi(w[i].w); }
    const int lo = (t - HW) < 0 ? 0 : (t - HW), hi = (t + HW) > S ? S : (t + HW);
    const float inv = 1.0f / (float)(hi - lo);
    const u32x4 wm = w[HW];
    const float me[8] = {bf_lo(wm.x), bf_hi(wm.x), bf_lo(wm.y), bf_hi(wm.y), bf_lo(wm.z), bf_hi(wm.z), bf_lo(wm.w), bf_hi(wm.w)};
    float d[8];
#pragma unroll
    for (int j = 0; j < 8; ++j) d[j] = acc[j] * inv - me[j];
    u32x4 ow; ow.x = cvt_pk_bf16(d[0], d[1]); ow.y = cvt_pk_bf16(d[2], d[3]); ow.z = cvt_pk_bf16(d[4], d[5]); ow.w = cvt_pk_bf16(d[6], d[7]);
    *(GAS u32x4*)(DL + (size_t)t * POOLW + 8 * c) = ow;
}
__device__ __forceinline__ void pool_delta_pass(Frame& F, const bf16_t* U, bf16_t* DL) {
    const int gt = F.vcu * (NWAVES * 64) + F.tid, NT = F.G * NWAVES * 64;
    for (int it = gt; it < S * (POOLW / 8); it += NT) {
        const int t = it >> 8, c = it & 255, g = __builtin_amdgcn_readfirstlane(c >> 6);
        if (g == 0) pool_item<1>(U, DL, t, c); else if (g == 1) pool_item<2>(U, DL, t, c); else if (g == 2) pool_item<4>(U, DL, t, c); else pool_item<8>(U, DL, t, c);
    }
}

__device__ __forceinline__ double inv_freq_of(int i) {
    const double step = 0.74989420933245582730;
    double r = 1.0; for (int k = 0; k < i; ++k) r *= step; return r;
}

typedef const __attribute__((address_space(4))) Args CArgs;
__device__ __forceinline__ CArgs* fresh_args() { CArgs* p = (CArgs*)__builtin_amdgcn_kernarg_segment_ptr(); asm volatile("" : "+s"(p)); return p; }
#define WSP(off) ((bf16_t*)(ws + (off)))

__global__ void __launch_bounds__(NWAVES * 64, 2) fwd_kernel(Args args) {
    extern __shared__ __attribute__((aligned(16))) unsigned char lds[];
    LAS unsigned char* const L = (LAS unsigned char*)lds;
    const int wave_s = __builtin_amdgcn_readfirstlane((int)threadIdx.x >> 6);
    for (int u = threadIdx.x; u < (LDS_BYTES - LDSCTL_OFF) / 4; u += NWAVES * 64) ((LAS unsigned*)(L + LDSCTL_OFF))[u] = 0u;
    __syncthreads();
    unsigned* const barw = (unsigned*)(args.ws + WS_CTL) + CW_BAR;
    XcdBarrier bar; bar.bar = barw; bar.x = 0; bar.st = nullptr;
    if (N_LAUNCHES == 1) bar = xcd_barrier_post(barw, (volatile LAS unsigned*)(L + MISC_OFF) + 8);
#define GRID_BAR() do { if (N_LAUNCHES == 1) { for (int rb_ = 0; rb_ < REP_BAR; ++rb_) xcd_barrier(bar, wave_s); } } while (0)
    const int lo = args.ph_lo, hi = args.ph_hi;
#define IN(k) (lo <= (k) && (k) < hi)
#define SEAM(k) do { if (IN(k) && IN((k) + 1)) GRID_BAR(); } while (0)

    if (IN(0)) {
        CArgs* ap = fresh_args(); unsigned char* ws = ap->ws; Frame F = make_frame(L, wave_s);
        LAS float* scr = (LAS float*)(F.lds + RING_OFF + F.wave * 16384);
        const int gw = F.vcu * NWAVES + F.wave, NGW = F.G * NWAVES;
        constexpr int I_IN = (DM / 64) * (INW / 32), I_POOL = (PGI / 64) * (PGO / 32), I_OUT = (DM / 64) * (DM / 32), I_GU = (DM / 64) * (FF / 32), I_DOWN = (FF / 64) * (DM / 32), I_PIN = (DPLE / 64) * (DM / 32);
        constexpr int I_LAYER = I_IN + 4 * I_POOL + I_OUT + 2 * I_GU + I_DOWN + I_PIN + I_OUT;
        for (int rep = 0; rep < REP_CONV; ++rep)
        for (int it = gw; it < DEPTH * I_LAYER; it += NGW) {
            const int l = it / I_LAYER; int r = it % I_LAYER;
            unsigned char* wl = ws + WS_W + (size_t)l * LW_BYTES;
            if (r < I_IN) { p0_transpose_item<0>(ap->in[2] + (size_t)l * DM * INW, DM, INW, (bf16_t*)(wl + LW_IN), 0, scr, r, F.lane); continue; } r -= I_IN;
            if (r < 4 * I_POOL) { const int g = r / I_POOL; p0_transpose_item<0>(ap->in[5] + ((size_t)l * 4 + g) * PGI * PGO, PGI, PGO, (bf16_t*)(wl + LW_POOL), g * PGO, scr, r % I_POOL, F.lane); continue; } r -= 4 * I_POOL;
            if (r < I_OUT) { p0_transpose_item<0>(ap->in[7] + (size_t)l * DM * DM, DM, DM, (bf16_t*)(wl + LW_OUT), 0, scr, r, F.lane); continue; } r -= I_OUT;
            if (r < I_GU) { p0_transpose_item<1>(ap->in[12] + (size_t)l * DM * FF, DM, FF, (bf16_t*)(wl + LW_GU), 0, scr, r, F.lane); continue; } r -= I_GU;
            if (r < I_GU) { p0_transpose_item<1>(ap->in[13] + (size_t)l * DM * FF, DM, FF, (bf16_t*)(wl + LW_GU), 128, scr, r, F.lane); continue; } r -= I_GU;
            if (r < I_DOWN) { p0_transpose_item<0>(ap->in[14] + (size_t)l * FF * DM, FF, DM, (bf16_t*)(wl + LW_DOWN), 0, scr, r, F.lane); continue; } r -= I_DOWN;
            if (r < I_PIN) { p0_transpose_item<0>(ap->in[15] + (size_t)l * DPLE * DM, DPLE, DM, (bf16_t*)(wl + LW_PIN), 0, scr, r, F.lane); continue; } r -= I_PIN;
            p0_transpose_item<0>(ap->in[16] + (size_t)l * DM * DM, DM, DM, (bf16_t*)(wl + LW_PG), 0, scr, r, F.lane);
        }
        { const int gt = F.vcu * (NWAVES * 64) + F.tid, NT = F.G * NWAVES * 64;
          const float* p_in = ap->in[1]; bf16_t* PB = WSP(WS_PB); float* rope = (float*)(ws + WS_ROPE);
          for (int i = gt; i < DEPTH * S * DPLE / 8; i += NT) { const f32x4 a = *(const GAS f32x4*)(p_in + (size_t)i * 8), b = *(const GAS f32x4*)(p_in + (size_t)i * 8 + 4);
              u32x4 o; o.x = cvt_pk_bf16(a.x, a.y); o.y = cvt_pk_bf16(a.z, a.w); o.z = cvt_pk_bf16(b.x, b.y); o.w = cvt_pk_bf16(b.z, b.w); *(GAS u32x4*)(PB + (size_t)i * 8) = o; }
          for (int i = gt; i < 128 * 32; i += NT) { const int pos = i >> 5, fi = i & 31;
              const double ang = (double)pos * inv_freq_of(fi); const double k = __builtin_rint(ang * 0.15915494309189533577); const double r = ang - k * 6.283185307179586476925;
              const float rf = (float)r; rope[2 * i] = cosf(rf); rope[2 * i + 1] = sinf(rf); }
        }
        norm_pass(F, ap->in[0], nullptr, nullptr, nullptr, ap->in[8], WSP(WS_H), 2);
    }
    SEAM(0);

    for (int l = 0; l < DEPTH; ++l) {
        const int pb = 1 + 11 * l;
        if (IN(pb + 0)) {
            CArgs* ap = fresh_args(); unsigned char* ws = ap->ws; Frame F = make_frame(L, wave_s); unsigned char* wl = ws + WS_W + (size_t)l * LW_BYTES;
            for (int rep = 0; rep < REP_G1; ++rep) { pg8::Gemm g{WSP(WS_H), (const bf16_t*)(wl + LW_IN), S, INW, DM, DM, DM, 0}; pg8::StaticOrder So; So.init(S, INW, F.G, F.bx);
              pg8::EpiZ E{WSP(WS_Q), WSP(WS_K), WSP(WS_V), WSP(WS_U), WSP(WS_GA), WSP(WS_GP)};
              pg8::gemm_phase<pg8::EpiZ, pg8::StaticOrder, G_ALIGN, G_SP2>(F.lds + RING_OFF, g, So, E, F.tid); }
            if (l == 0) {
                for (int l2 = 0; l2 < DEPTH; ++l2) {
                    pg8::Gemm g2{WSP(WS_PB) + (size_t)l2 * S * DPLE, (const bf16_t*)(ws + WS_W + (size_t)l2 * LW_BYTES + LW_PIN), S, DM, DPLE, DPLE, DPLE, 0}; pg8::StaticOrder S2; S2.init(S, DM, F.G, F.bx);
                    pg8::EpiPlain E2{WSP(WS_E) + (size_t)l2 * S * DM, DM};
                    pg8::gemm_phase<pg8::EpiPlain, pg8::StaticOrder, G_ALIGN, G_SP2>(F.lds + RING_OFF, g2, S2, E2, F.tid);
                }
            }
        }
        SEAM(pb + 0);
        if (IN(pb + 1)) {
            CArgs* ap = fresh_args(); unsigned char* ws = ap->ws; Frame F = make_frame(L, wave_s);
            for (int rep = 0; rep < REP_T2; ++rep) {
            qk_norm_rope_pass(F, WSP(WS_Q), WSP(WS_K), WSP(WS_Q2), WSP(WS_K2), ap->in[3] + l * HD, ap->in[4] + l * HD, (const float*)(ws + WS_ROPE));
            pool_delta_pass(F, WSP(WS_U), WSP(WS_DL)); }
        }
        SEAM(pb + 1);
        if (IN(pb + 2)) {
            CArgs* ap = fresh_args(); unsigned char* ws = ap->ws; Frame F = make_frame(L, wave_s);
            for (int rep = 0; rep < REP_ATT; ++rep)
            for (int U0 = F.vcu; U0 < NH * (S / 256); U0 += F.G) {
                const int a = U0 >> 8, b = (U0 >> 5) & 7, c = U0 & 31, h = 4 * b + a, qb = c, kvh = h >> 2;
                att::attn_ring_body(WSP(WS_Q2) + (size_t)qb * 256 * DM + h * HD, WSP(WS_K2) + kvh * HD, WSP(WS_V) + kvh * HD, WSP(WS_O) + (size_t)qb * 256 * DM + h * HD, S, (LAS char*)(F.lds + RING_OFF), F.tid);
            }
        }
        SEAM(pb + 2);
        if (IN(pb + 3)) {
            CArgs* ap = fresh_args(); unsigned char* ws = ap->ws; Frame F = make_frame(L, wave_s); unsigned char* wl = ws + WS_W + (size_t)l * LW_BYTES;
            pg8::Gemm g{WSP(WS_DL), (const bf16_t*)(wl + LW_POOL), S, DM, PGI, POOLW, PGI, PGI}; pg8::StaticOrder So; So.init(S, DM, F.G, F.bx);
            pg8::EpiPool E{WSP(WS_MG), WSP(WS_O), WSP(WS_GA), WSP(WS_GP), ap->in[6] + (size_t)l * DM, DM};
            for (int rep = 0; rep < REP_SMALLG; ++rep)
            pg8::gemm_phase<pg8::EpiPool, pg8::StaticOrder, G_ALIGN, G_SP2>(F.lds + RING_OFF, g, So, E, F.tid);
        }
        SEAM(pb + 3);
        if (IN(pb + 4)) {
            CArgs* ap = fresh_args(); unsigned char* ws = ap->ws; Frame F = make_frame(L, wave_s); unsigned char* wl = ws + WS_W + (size_t)l * LW_BYTES;
            pg8::Gemm g{WSP(WS_MG), (const bf16_t*)(wl + LW_OUT), S, DM, DM, DM, DM, 0}; pg8::StaticOrder So; So.init(S, DM, F.G, F.bx);
            pg8::EpiPlain E{WSP(WS_Y), DM};
            for (int rep = 0; rep < REP_SMALLG; ++rep)
            pg8::gemm_phase<pg8::EpiPlain, pg8::StaticOrder, G_ALIGN, G_SP2>(F.lds + RING_OFF, g, So, E, F.tid);
        }
        SEAM(pb + 4);
        if (IN(pb + 5)) {
            CArgs* ap = fresh_args(); unsigned char* ws = ap->ws; Frame F = make_frame(L, wave_s);
            norm_pass(F, l == 0 ? ap->in[0] : (const float*)ap->out, ap->out, WSP(WS_Y), ap->in[9] + (size_t)l * DM, ap->in[10] + (size_t)l * DM, WSP(WS_H), 2);
        }
        SEAM(pb + 5);
        if (IN(pb + 6)) {
            CArgs* ap = fresh_args(); unsigned char* ws = ap->ws; Frame F = make_frame(L, wave_s); unsigned char* wl = ws + WS_W + (size_t)l * LW_BYTES;
            pg8::Gemm g{WSP(WS_H), (const bf16_t*)(wl + LW_GU), S, 2 * FF, DM, DM, DM, 0}; pg8::StaticOrder So; So.init(S, 2 * FF, F.G, F.bx);
            pg8::EpiSwiglu E{WSP(WS_F), FF};
            for (int rep = 0; rep < REP_G3; ++rep)
            pg8::gemm_phase<pg8::EpiSwiglu, pg8::StaticOrder, G_ALIGN, G_SP2>(F.lds + RING_OFF, g, So, E, F.tid);
        }
        SEAM(pb + 6);
        if (IN(pb + 7)) {
            CArgs* ap = fresh_args(); unsigned char* ws = ap->ws; Frame F = make_frame(L, wave_s); unsigned char* wl = ws + WS_W + (size_t)l * LW_BYTES;
            pg8::Gemm g{WSP(WS_F), (const bf16_t*)(wl + LW_DOWN), S, DM, FF, FF, FF, 0}; pg8::StaticOrder So; So.init(S, DM, F.G, F.bx);
            pg8::EpiPlain E{WSP(WS_Y), DM};
            pg8::gemm_phase<pg8::EpiPlain, pg8::StaticOrder, G_ALIGN, G_SP2>(F.lds + RING_OFF, g, So, E, F.tid);
#if REP_G4 > 1
            pg8::gemm_phase<pg8::EpiPlain, pg8::StaticOrder, G_ALIGN, G_SP2>(F.lds + RING_OFF, g, So, E, F.tid);
#endif
        }
        SEAM(pb + 7);
        if (IN(pb + 8)) {
            CArgs* ap = fresh_args(); unsigned char* ws = ap->ws; Frame F = make_frame(L, wave_s);
            for (int rep = 1; rep < REP_THIN; ++rep) norm_pass(F, ap->out, (float*)(ws + WS_Q), WSP(WS_Y), ap->in[11] + (size_t)l * DM, ap->in[11] + (size_t)l * DM, WSP(WS_Q2), 2);
            norm_pass(F, ap->out, ap->out, WSP(WS_Y), ap->in[11] + (size_t)l * DM, nullptr, WSP(WS_H), 1);
        }
        SEAM(pb + 8);
        if (IN(pb + 9)) {
            CArgs* ap = fresh_args(); unsigned char* ws = ap->ws; Frame F = make_frame(L, wave_s); unsigned char* wl = ws + WS_W + (size_t)l * LW_BYTES;
            pg8::Gemm g{WSP(WS_H), (const bf16_t*)(wl + LW_PG), S, DM, DM, DM, DM, 0}; pg8::StaticOrder So; So.init(S, DM, F.G, F.bx);
            pg8::EpiPle E{WSP(WS_Y), WSP(WS_E) + (size_t)l * S * DM, DM};
            for (int rep = 0; rep < REP_SMALLG; ++rep)
            pg8::gemm_phase<pg8::EpiPle, pg8::StaticOrder, G_ALIGN, G_SP2>(F.lds + RING_OFF, g, So, E, F.tid);
        }
        SEAM(pb + 9);
        if (IN(pb + 10)) {
            CArgs* ap = fresh_args(); unsigned char* ws = ap->ws; Frame F = make_frame(L, wave_s);
            if (l + 1 < DEPTH) norm_pass(F, ap->out, ap->out, WSP(WS_Y), ap->in[17] + (size_t)l * DM, ap->in[8] + (size_t)(l + 1) * DM, WSP(WS_H), 2);
            else norm_pass(F, ap->out, ap->out, WSP(WS_Y), ap->in[17] + (size_t)l * DM, nullptr, nullptr, 0);
        }
        SEAM(pb + 10);
    }
#undef IN
#undef SEAM
#undef GRID_BAR
}

extern "C" void kernel_launch(void* const* d_in, const int* in_sizes, int n_in, void* d_out, int out_size, void* d_ws, size_t ws_size, hipStream_t stream) {
    static int grid = 0;
    if (grid == 0) {
        if (n_in != 18 || in_sizes[0] != S * DM || out_size != S * DM || ws_size < WS_END) { fprintf(stderr, "kernel_launch: shape/workspace mismatch: n_in %d in0 %d out %d ws %zu (need %zu)\n", n_in, n_in > 0 ? in_sizes[0] : -1, out_size, ws_size, (size_t)WS_END); grid = -1; return; }
        int dev = 0, cus = 0, per_cu = 0;
        if (hipGetDevice(&dev) != hipSuccess || hipDeviceGetAttribute(&cus, hipDeviceAttributeMultiprocessorCount, dev) != hipSuccess) { grid = -1; return; }
        if (hipFuncSetAttribute((const void*)fwd_kernel, hipFuncAttributeMaxDynamicSharedMemorySize, LDS_BYTES) != hipSuccess) { fprintf(stderr, "kernel_launch: hipFuncSetAttribute failed\n"); grid = -1; return; }
        if (hipOccupancyMaxActiveBlocksPerMultiprocessor(&per_cu, (const void*)fwd_kernel, NWAVES * 64, LDS_BYTES) != hipSuccess || per_cu < 1) { fprintf(stderr, "kernel_launch: occupancy query says %d blocks per CU\n", per_cu); }
        (void)hipGetLastError();
        grid = cus;
    }
    if (grid < 0) return;
    if (hipMemsetAsync((char*)d_ws + WS_CTL, 0, CTL_ZERO_BYTES, stream) != hipSuccess) return;
    Args a{};
    for (int i = 0; i < 18; ++i) a.in[i] = (const float*)d_in[i];
    a.out = (float*)d_out; a.ws = (unsigned char*)d_ws;
    for (int li = 0; li < N_LAUNCHES; ++li) {
        a.ph_lo = (N_LAUNCHES == 1) ? 0 : li; a.ph_hi = (N_LAUNCHES == 1) ? N_PHASES : li + 1;
        hipLaunchKernelGGL(fwd_kernel, dim3(grid), dim3(NWAVES * 64), LDS_BYTES, stream, a);
        const hipError_t le = hipPeekAtLastError();
        if (le != hipSuccess) { fprintf(stderr, "kernel_launch: launch %d failed: %s\n", li, hipGetErrorName(le)); break; }
    }
}
```

```cpp
#include <hip/hip_runtime.h>
#include <cstdio>
#include <cstdint>

#ifndef MK_N_LAUNCHES
#define MK_N_LAUNCHES 1
#endif

#ifndef G_SP2
#define G_SP2 true
#endif
#ifndef G_ALIGN
#define G_ALIGN true
#endif
#ifndef ATT_BOUND
#define ATT_BOUND 1
#endif
#ifndef NT_STORE
#define NT_STORE 0
#endif
#ifndef REP_BAR
#define REP_BAR 1
#endif
#ifndef REP_CONV
#define REP_CONV 1
#endif
#ifndef REP_G1
#define REP_G1 1
#endif
#ifndef REP_ATT
#define REP_ATT 1
#endif
#ifndef REP_G3
#define REP_G3 1
#endif
#ifndef REP_G4
#define REP_G4 1
#endif
#ifndef REP_T2
#define REP_T2 1
#endif
#ifndef REP_THIN
#define REP_THIN 1
#endif
#ifndef REP_SMALLG
#define REP_SMALLG 1
#endif

#define LAS __attribute__((address_space(3)))
#define GAS __attribute__((address_space(1)))
typedef unsigned short bf16_t;
typedef short bf16x8 __attribute__((ext_vector_type(8)));
typedef short s16x4 __attribute__((ext_vector_type(4)));
typedef float f32x4 __attribute__((ext_vector_type(4)));
typedef float f32x2 __attribute__((ext_vector_type(2)));
typedef float f32x16 __attribute__((ext_vector_type(16)));
typedef unsigned u32x4 __attribute__((ext_vector_type(4)));
typedef unsigned u32x2 __attribute__((ext_vector_type(2)));

constexpr int S = 8192, DM = 4096, DEPTH = 2;
constexpr int NH = 32, NKV = 8, HD = 128;
constexpr int KVW = NKV * HD;
constexpr int POOLW = 2048, PGI = 512, PGO = 1024;
constexpr int INW = 16384;
constexpr int FF = 11008;
constexpr int DPLE = 256;
constexpr float EPS = 1e-6f;

__device__ __forceinline__ unsigned cvt_pk_bf16(float lo, float hi) { unsigned r; asm volatile("v_cvt_pk_bf16_f32 %0, %1, %2" : "=v"(r) : "v"(lo), "v"(hi)); return r; }
__device__ __forceinline__ float bf_lo(unsigned w) { return __uint_as_float(w << 16); }
__device__ __forceinline__ float bf_hi(unsigned w) { return __uint_as_float(w & 0xffff0000u); }
__device__ __forceinline__ float sigmoid_f(float v) { return __builtin_amdgcn_rcpf(1.0f + __builtin_amdgcn_exp2f(v * -1.4426950408889634f)); }

namespace pg8 {
constexpr int BM = 256, BK = 64, HALF = 128, HTB = HALF * BK * 2  , STAGE_BYTES = 8 * HTB, NXCD = 8, WGM = 8;

__host__ __device__ __forceinline__ int lds_byte(int r, int c) { const int st = (r >> 4) * 2 + (c >> 5), rr = r & 15, cc = c & 31, ob = rr * 64 + cc * 2; return st * 1024 + (ob ^ (((ob >> 9) & 1) << 5)); }
__host__ __device__ __forceinline__ void stage_rc(int b, int& R, int& C) { const int st = b / 1024, sb = b % 1024, swz = sb ^ (((sb >> 9) & 1) << 5); R = (st >> 1) * 16 + swz / 64; C = (st & 1) * 32 + (swz % 64) / 2; }
__host__ __device__ __forceinline__ int perm32(int rho) { const int n = rho >> 4, i = rho & 15; return 8 * (i >> 2) + 4 * n + (i & 3); }

struct Unit { int pm, pn; };
struct Gemm { const bf16_t* A; const bf16_t* Bt; int M, N, K, lda, ldb, agrp; };

struct StaticOrder {
    int nM, nN, nwg, G, c;
    __host__ __device__ void init(int M, int N, int G_, int c_) { nM = M / BM; nN = N / BM; nwg = nM * nN; G = G_; c = c_; }
    __host__ __device__ bool next(int i, Unit& u) const {
        const long L = (long)i * G + c; if (L >= nwg) return false;
        int wgid = (int)L; { const int q = nwg / NXCD, r = nwg % NXCD, xcd = wgid % NXCD, off = wgid / NXCD; wgid = (xcd < r ? xcd * (q + 1) : r * (q + 1) + (xcd - r) * q) + off; }
        const int nig = WGM * nN, gid = wgid / nig, fm = gid * WGM, gsz = (nM - fm) < WGM ? (nM - fm) : WGM;
        u.pm = fm + ((wgid % nig) % gsz); u.pn = (wgid % nig) / gsz; return true;
    }
    __device__ __forceinline__ void a_ready(const Unit&) const {}
    __device__ __forceinline__ void done(const Unit&) const {}
};

__device__ __forceinline__ u32x4 pack8(const f32x4 v0, const f32x4 v1) { u32x4 w; w.x = cvt_pk_bf16(v0[0], v0[1]); w.y = cvt_pk_bf16(v0[2], v0[3]); w.z = cvt_pk_bf16(v1[0], v1[1]); w.w = cvt_pk_bf16(v1[2], v1[3]); return w; }

__device__ __forceinline__ void st16(bf16_t* p, const u32x4 v) {
#if NT_STORE
    __builtin_nontemporal_store(v, (u32x4*)p);
#else
    *(u32x4*)p = v;
#endif
}
struct EpiPlain {
    static constexpr bool PERM = true, AFTER_DRAIN = false;
    bf16_t* O; int ldc;
    __device__ __forceinline__ void operator()(const f32x4 (&acc)[2][2][4][2], const Unit& u, int wr, int wc, int fr, int fq) const {
        const int row0 = u.pm * BM + wr * 64 + fr, col0 = u.pn * BM + wc * 32 + 8 * fq;
#pragma unroll
        for (int ai = 0; ai < 2; ++ai)
#pragma unroll
            for (int m = 0; m < 4; ++m) { bf16_t* rowp = O + (size_t)(row0 + ai * HALF + m * 16) * ldc + col0;
#pragma unroll
                for (int bj = 0; bj < 2; ++bj) *(u32x4*)(rowp + bj * HALF) = pack8(acc[ai][bj][m][0], acc[ai][bj][m][1]); }
    }
};
struct EpiZ {
    static constexpr bool PERM = true, AFTER_DRAIN = false;
    bf16_t *Q, *Kb, *Vb, *U, *GA, *GP;
    __device__ __forceinline__ void operator()(const f32x4 (&acc)[2][2][4][2], const Unit& u, int wr, int wc, int fr, int fq) const {
        const int pn = u.pn; bf16_t* base; int ldc, ct; bool sg = false;
        if (pn < 16)      { base = Q;  ldc = DM;    ct = pn; }
        else if (pn < 20) { base = Kb; ldc = KVW;   ct = pn - 16; }
        else if (pn < 24) { base = Vb; ldc = KVW;   ct = pn - 20; }
        else if (pn < 32) { base = U;  ldc = POOLW; ct = pn - 24; }
        else if (pn < 48) { base = GA; ldc = DM;    ct = pn - 32; sg = true; }
        else              { base = GP; ldc = DM;    ct = pn - 48; sg = true; }
        const int row0 = u.pm * BM + wr * 64 + fr, col0 = ct * BM + wc * 32 + 8 * fq;
#pragma unroll
        for (int ai = 0; ai < 2; ++ai)
#pragma unroll
            for (int m = 0; m < 4; ++m) { bf16_t* rowp = base + (size_t)(row0 + ai * HALF + m * 16) * ldc + col0;
#pragma unroll
                for (int bj = 0; bj < 2; ++bj) { f32x4 v0 = acc[ai][bj][m][0], v1 = acc[ai][bj][m][1];
                    if (sg) {
#pragma unroll
                        for (int j = 0; j < 4; ++j) { v0[j] = sigmoid_f(v0[j]); v1[j] = sigmoid_f(v1[j]); } }
                    st16(rowp + bj * HALF, pack8(v0, v1)); } }
    }
};
struct EpiSwiglu {
    static constexpr bool PERM = true, AFTER_DRAIN = false;
    bf16_t* F; int ldc;
    __device__ __forceinline__ void operator()(const f32x4 (&acc)[2][2][4][2], const Unit& u, int wr, int wc, int fr, int fq) const {
        const int row0 = u.pm * BM + wr * 64 + fr, col0 = u.pn * HALF + wc * 32 + 8 * fq;
#pragma unroll
        for (int ai = 0; ai < 2; ++ai)
#pragma unroll
            for (int m = 0; m < 4; ++m) { bf16_t* rowp = F + (size_t)(row0 + ai * HALF + m * 16) * ldc + col0;
                f32x4 v0, v1;
#pragma unroll
                for (int j = 0; j < 4; ++j) { const float g0 = acc[ai][0][m][0][j], g1 = acc[ai][0][m][1][j];
                    v0[j] = g0 * sigmoid_f(g0) * acc[ai][1][m][0][j]; v1[j] = g1 * sigmoid_f(g1) * acc[ai][1][m][1][j]; }
                *(u32x4*)rowp = pack8(v0, v1); }
    }
};
__device__ __forceinline__ void unpack8(const u32x4 w, f32x4& a, f32x4& b) { a[0] = bf_lo(w.x); a[1] = bf_hi(w.x); a[2] = bf_lo(w.y); a[3] = bf_hi(w.y); b[0] = bf_lo(w.z); b[1] = bf_hi(w.z); b[2] = bf_lo(w.w); b[3] = bf_hi(w.w); }
struct EpiPle {
    static constexpr bool PERM = true, AFTER_DRAIN = false;
    bf16_t* Y; const bf16_t* E; int ldc;
    __device__ __forceinline__ void operator()(const f32x4 (&acc)[2][2][4][2], const Unit& u, int wr, int wc, int fr, int fq) const {
        const int row0 = u.pm * BM + wr * 64 + fr, col0 = u.pn * BM + wc * 32 + 8 * fq;
#pragma unroll
        for (int ai = 0; ai < 2; ++ai)
#pragma unroll
            for (int m = 0; m < 4; ++m) { const size_t off = (size_t)(row0 + ai * HALF + m * 16) * ldc + col0;
#pragma unroll
                for (int bj = 0; bj < 2; ++bj) { const u32x4 ew = *(const u32x4*)(E + off + bj * HALF); f32x4 e0, e1; unpack8(ew, e0, e1);
                    f32x4 v0 = acc[ai][bj][m][0], v1 = acc[ai][bj][m][1];
#pragma unroll
                    for (int j = 0; j < 4; ++j) { v0[j] = sigmoid_f(v0[j]) * e0[j]; v1[j] = sigmoid_f(v1[j]) * e1[j]; }
                    *(u32x4*)(Y + off + bj * HALF) = pack8(v0, v1); }
                asm volatile("" ::: "memory"); }
    }
};
struct EpiPool {
    static constexpr bool PERM = true, AFTER_DRAIN = false;
    bf16_t* MG; const bf16_t *O, *GA, *GP; const float* ps; int ldc;
    __device__ __forceinline__ void operator()(const f32x4 (&acc)[2][2][4][2], const Unit& u, int wr, int wc, int fr, int fq) const {
        const int row0 = u.pm * BM + wr * 64 + fr, col0 = u.pn * BM + wc * 32 + 8 * fq;
        f32x4 pv[2][2];
#pragma unroll
        for (int bj = 0; bj < 2; ++bj)
#pragma unroll
            for (int n = 0; n < 2; ++n) pv[bj][n] = *(const f32x4*)(ps + col0 + bj * HALF + 4 * n);
#pragma unroll
        for (int ai = 0; ai < 2; ++ai)
#pragma unroll
            for (int m = 0; m < 4; ++m) { const size_t off = (size_t)(row0 + ai * HALF + m * 16) * ldc + col0;
#pragma unroll
                for (int bj = 0; bj < 2; ++bj) {
                    const u32x4 ow = *(const u32x4*)(O + off + bj * HALF), aw = *(const u32x4*)(GA + off + bj * HALF), pw = *(const u32x4*)(GP + off + bj * HALF);
                    f32x4 o0, o1, a0, a1, p0, p1; unpack8(ow, o0, o1); unpack8(aw, a0, a1); unpack8(pw, p0, p1);
                    const f32x4 v0 = a0 * o0 + p0 * (acc[ai][bj][m][0] * pv[bj][0]), v1 = a1 * o1 + p1 * (acc[ai][bj][m][1] * pv[bj][1]);
                    *(u32x4*)(MG + off + bj * HALF) = pack8(v0, v1); }
                asm volatile("" ::: "memory"); }
    }
};

template <class Epi, class Sched, bool ALIGN_EPI = false, bool SP2 = false>
__device__ __forceinline__ void gemm_phase(LAS unsigned char* lds, const Gemm g, const Sched& S, const Epi& E, const int tid_in) {
    int tid_ = tid_in; asm volatile("" : "+v"(tid_));
    const int tid = tid_, wid = __builtin_amdgcn_readfirstlane(tid >> 6), lane = tid & 63, wr = wid >> 2, wc = wid & 3, fr = lane & 15, fq = lane >> 4;
    const int K = g.K, nt = K / BK;
    unsigned voffA[2], voffB[2];
#pragma unroll
    for (int i = 0; i < 2; ++i) { int R, C; stage_rc(tid * 16 + i * 8192, R, C); const int Rb = Epi::PERM ? ((R & ~31) + perm32(R & 31)) : R;
        voffA[i] = (unsigned)(R * g.lda + C) * 2u; voffB[i] = (unsigned)(Rb * g.ldb + C) * 2u; }
    const size_t kstep = (size_t)(BK * 2);
    const size_t hstepA = (size_t)HALF * g.lda * 2, hstepB = (size_t)HALF * g.ldb * 2;
    const size_t tstepA = 2 * hstepA, tstepB = 2 * hstepB;
    const unsigned ldsw = (unsigned)wid * 1024u;
    const int aoff = lds_byte(wr * 64 + fr, fq * 8), boff = lds_byte(wc * 32 + fr, fq * 8);
#define PG8_SA(b, h) (((b) * 2 + (h)) * HTB)
#define PG8_SB(b, h) ((4 + (b) * 2 + (h)) * HTB)
#define PG8_STAGE(bufoff, gbase, voff) do { _Pragma("unroll") for (int _i = 0; _i < 2; ++_i) \
        __builtin_amdgcn_global_load_lds((const unsigned*)((const char*)(gbase) + (voff)[_i]), (LAS unsigned*)(lds + (bufoff) + ldsw + _i * 8192), 16, 0, 0); } while (0)
#define PG8_LDA(dst, b, h) do { _Pragma("unroll") for (int m = 0; m < 4; ++m) _Pragma("unroll") for (int k = 0; k < 2; ++k) dst[m][k] = *(const LAS bf16x8*)(lds + PG8_SA(b, h) + aoff + m * 2048 + k * 1024); } while (0)
#define PG8_LDB(dst, b, h) do { _Pragma("unroll") for (int n = 0; n < 2; ++n) _Pragma("unroll") for (int k = 0; k < 2; ++k) dst[n][k] = *(const LAS bf16x8*)(lds + PG8_SB(b, h) + boff + n * 2048 + k * 1024); } while (0)
#define PG8_MMA(ai, bj, At, Bt) do { __builtin_amdgcn_s_setprio(1); _Pragma("unroll") for (int m = 0; m < 4; ++m) _Pragma("unroll") for (int n = 0; n < 2; ++n) _Pragma("unroll") for (int k = 0; k < 2; ++k) \
        acc[ai][bj][m][n] = __builtin_amdgcn_mfma_f32_16x16x32_bf16(Bt[n][k], At[m][k], acc[ai][bj][m][n], 0, 0, 0); __builtin_amdgcn_s_setprio(0); } while (0)
#define PG8_WAIT_V(n) asm volatile("s_waitcnt vmcnt(" #n ")" ::: "memory")
#define PG8_WAIT_L(n) asm volatile("s_waitcnt lgkmcnt(" #n ")" ::: "memory")
#define PG8_BAR __builtin_amdgcn_s_barrier()
#define PG8_SCHED __builtin_amdgcn_sched_barrier(0)
    Unit cur, nxt; int ui = 0;
    if (!S.next(0, cur)) return;
    f32x4 acc[2][2][4][2];
#pragma unroll
    for (int a = 0; a < 2; ++a)
#pragma unroll
        for (int b = 0; b < 2; ++b)
#pragma unroll
            for (int m = 0; m < 4; ++m)
#pragma unroll
                for (int n = 0; n < 2; ++n) acc[a][b][m][n] = (f32x4){0.f, 0.f, 0.f, 0.f};
    bf16x8 At[4][2], B0[2][2], B1[2][2];
    const char* cA = (const char*)g.A + (size_t)cur.pm * tstepA + (size_t)(cur.pn >> 2) * g.agrp * 2; const char* cB = (const char*)g.Bt + (size_t)cur.pn * tstepB;
    S.a_ready(cur);
    if constexpr (SP2) {
        PG8_STAGE(PG8_SB(0, 0), cB, voffB); PG8_STAGE(PG8_SB(0, 1), cB + hstepB, voffB); PG8_STAGE(PG8_SA(0, 0), cA, voffA); PG8_STAGE(PG8_SA(0, 1), cA + hstepA, voffA);
        if (wr == 1) PG8_BAR;
        PG8_WAIT_V(2); PG8_BAR;
        PG8_STAGE(PG8_SB(1, 0), cB + kstep, voffB); PG8_STAGE(PG8_SA(1, 0), cA + kstep, voffA); PG8_STAGE(PG8_SB(1, 1), cB + hstepB + kstep, voffB);
        PG8_WAIT_V(6); PG8_BAR;
    } else {
        PG8_STAGE(PG8_SB(0, 0), cB, voffB); PG8_STAGE(PG8_SA(0, 0), cA, voffA); PG8_STAGE(PG8_SB(0, 1), cB + hstepB, voffB); PG8_STAGE(PG8_SA(0, 1), cA + hstepA, voffA);
        if (wr == 1) PG8_BAR;
        PG8_WAIT_V(4); PG8_BAR;
        PG8_STAGE(PG8_SB(1, 0), cB + kstep, voffB); PG8_STAGE(PG8_SA(1, 0), cA + kstep, voffA); PG8_STAGE(PG8_SB(1, 1), cB + hstepB + kstep, voffB);
        PG8_WAIT_V(6); PG8_BAR;
    }
    for (;;) {
        const bool has_next = S.next(ui + 1, nxt);
        const char* nA = has_next ? (const char*)g.A + (size_t)nxt.pm * tstepA + (size_t)(nxt.pn >> 2) * g.agrp * 2 : cA; const char* nB = has_next ? (const char*)g.Bt + (size_t)nxt.pn * tstepB : cB;
        for (int t = 0; t < nt; t += 2) {
            const bool last = (t == nt - 2);
            const char* a1 = cA + (size_t)(t + 1) * kstep;
            const char* a2 = last ? nA : cA + (size_t)(t + 2) * kstep; const char* b2 = last ? nB : cB + (size_t)(t + 2) * kstep;
            const char* a3 = a2 + kstep; const char* b3 = b2 + kstep;
            if (last && has_next) S.a_ready(nxt);
            if constexpr (SP2) {
            PG8_LDB(B0, 0, 0); PG8_LDB(B1, 0, 1); PG8_SCHED; PG8_LDA(At, 0, 0); PG8_STAGE(PG8_SA(1, 1), a1 + hstepA, voffA);
            PG8_WAIT_V(8); PG8_WAIT_L(0); PG8_BAR; PG8_MMA(0, 0, At, B0); PG8_MMA(0, 1, At, B1); PG8_BAR; PG8_SCHED;
            PG8_LDA(At, 0, 1); PG8_STAGE(PG8_SB(0, 0), b2, voffB); PG8_STAGE(PG8_SB(0, 1), b2 + hstepB, voffB); PG8_STAGE(PG8_SA(0, 0), a2, voffA);
            PG8_WAIT_V(8); PG8_WAIT_L(0); PG8_BAR; PG8_MMA(1, 0, At, B0); PG8_MMA(1, 1, At, B1); PG8_BAR; PG8_SCHED;
            PG8_LDB(B0, 1, 0); PG8_LDB(B1, 1, 1); PG8_SCHED; PG8_LDA(At, 1, 0); PG8_STAGE(PG8_SA(0, 1), a2 + hstepA, voffA);
            PG8_WAIT_V(8); PG8_WAIT_L(0); PG8_BAR; PG8_MMA(0, 0, At, B0); PG8_MMA(0, 1, At, B1); PG8_BAR; PG8_SCHED;
            PG8_LDA(At, 1, 1); PG8_STAGE(PG8_SB(1, 0), b3, voffB); PG8_STAGE(PG8_SB(1, 1), b3 + hstepB, voffB); PG8_STAGE(PG8_SA(1, 0), a3, voffA);
            PG8_WAIT_V(8); PG8_WAIT_L(0); PG8_BAR; PG8_MMA(1, 0, At, B0); PG8_MMA(1, 1, At, B1); PG8_BAR; PG8_SCHED;
            } else {
            PG8_LDB(B0, 0, 0); PG8_SCHED; PG8_LDA(At, 0, 0); PG8_STAGE(PG8_SA(1, 1), a1 + hstepA, voffA);
            PG8_WAIT_L(8); PG8_BAR; PG8_WAIT_L(0); PG8_MMA(0, 0, At, B0); PG8_BAR; PG8_SCHED;
            PG8_LDB(B1, 0, 1); PG8_STAGE(PG8_SB(0, 0), b2, voffB);
            PG8_BAR; PG8_WAIT_L(0); PG8_MMA(0, 1, At, B1); PG8_BAR;
            PG8_LDA(At, 0, 1); PG8_STAGE(PG8_SA(0, 0), a2, voffA);
            PG8_BAR; PG8_WAIT_L(0); PG8_MMA(1, 0, At, B0); PG8_BAR; PG8_SCHED;
            PG8_STAGE(PG8_SB(0, 1), b2 + hstepB, voffB);
            PG8_WAIT_V(6); PG8_BAR; PG8_MMA(1, 1, At, B1); PG8_BAR;
            PG8_LDB(B0, 1, 0); PG8_SCHED; PG8_LDA(At, 1, 0); PG8_STAGE(PG8_SA(0, 1), a2 + hstepA, voffA);
            PG8_WAIT_L(8); PG8_BAR; PG8_WAIT_L(0); PG8_MMA(0, 0, At, B0); PG8_BAR; PG8_SCHED;
            PG8_LDB(B1, 1, 1); PG8_STAGE(PG8_SB(1, 0), b3, voffB);
            PG8_BAR; PG8_WAIT_L(0); PG8_MMA(0, 1, At, B1); PG8_BAR;
            PG8_LDA(At, 1, 1); PG8_STAGE(PG8_SA(1, 0), a3, voffA);
            PG8_BAR; PG8_WAIT_L(0); PG8_MMA(1, 0, At, B0); PG8_BAR; PG8_SCHED;
            PG8_STAGE(PG8_SB(1, 1), b3 + hstepB, voffB);
            PG8_WAIT_V(6); PG8_BAR; PG8_MMA(1, 1, At, B1); PG8_BAR;
            }
        }
        if constexpr (ALIGN_EPI) { if (wr == 0) PG8_BAR; }
        E(acc, cur, wr, wc, fr, fq); S.done(cur);
        if (!has_next) break;
#pragma unroll
        for (int a = 0; a < 2; ++a)
#pragma unroll
            for (int b = 0; b < 2; ++b)
#pragma unroll
                for (int m = 0; m < 4; ++m)
#pragma unroll
                    for (int n = 0; n < 2; ++n) acc[a][b][m][n] = (f32x4){0.f, 0.f, 0.f, 0.f};
        cur = nxt; cA = nA; cB = nB; ++ui;
        if constexpr (ALIGN_EPI) { if (wr == 1) PG8_BAR; }
    }
    PG8_WAIT_V(0);
    if constexpr (!ALIGN_EPI) { if (wr == 0) PG8_BAR; }
    PG8_BAR;
#undef PG8_SA
#undef PG8_SB
#undef PG8_STAGE
#undef PG8_LDA
#undef PG8_LDB
#undef PG8_MMA
#undef PG8_WAIT_V
#undef PG8_WAIT_L
#undef PG8_BAR
#undef PG8_SCHED
}
}

namespace att {
constexpr int D = 128, NW = 8, QBLK = 32, KVBLK = 64;
constexpr float SCALE = 0.088388347648318440f;
constexpr int LDQ = DM, LDK = KVW, LDO = DM;
constexpr int SHM_V = KVBLK * D * 2, SHM_K = KVBLK * D * 2, SHM_ATTN = 2 * SHM_V + 2 * SHM_K + NW * 64 * 4;
#define KSWZ(row, colB) ((row) * 256 + ((colB) ^ (((row) & 7) << 4)))
#define SBAR() __builtin_amdgcn_sched_barrier(0)
__device__ __forceinline__ int crow(int r, int hi) { return (r & 3) + 8 * (r >> 2) + 4 * hi; }
__device__ __forceinline__ unsigned cvtpk(float lo, float hi) { unsigned r; asm volatile("v_cvt_pk_bf16_f32 %0, %1, %2" : "=v"(r) : "v"(lo), "v"(hi)); return r; }

constexpr float THRL = 8.f;
#define MX3(a, b, c) __builtin_fmaxf(__builtin_fmaxf((a), (b)), (c))
template <bool FIRST>
__device__ __forceinline__ bool partialSM(f32x16& p0, f32x16& p1, float& mhat, f32x16& negm, float& l_reg, LAS float* al_l, int r32, int hi) {
  float a = MX3(p0[0], p0[1], p1[0]), b = MX3(p0[2], p0[3], p1[1]); a = MX3(a, p1[2], p1[3]);
#pragma unroll
  for (int r = 4; r < 16; r += 4) { a = MX3(a, p0[r], p0[r + 1]); b = MX3(b, p0[r + 2], p0[r + 3]); a = MX3(a, p1[r], p1[r + 1]); b = MX3(b, p1[r + 2], p1[r + 3]); }
  float rm = __builtin_fmaxf(a, b);
  { auto rr = __builtin_amdgcn_permlane32_swap(__float_as_uint(rm), __float_as_uint(rm), false, false);
    rm = __builtin_fmaxf(__uint_as_float(rr[0]), __uint_as_float(rr[1])); }
  bool resc = false;
  if (FIRST) { const float dl = rm; mhat = dl;
#pragma unroll
    for (int r = 0; r < 16; ++r) { p0[r] -= dl; p1[r] -= dl; }
#pragma unroll
    for (int r = 0; r < 16; ++r) negm[r] = -mhat;
    asm volatile("" : "+v"(negm));
  } else if (__builtin_expect(__any(rm > THRL), 0)) { const float dl = __builtin_fmaxf(rm, 0.f); mhat += dl;
#pragma unroll
    for (int r = 0; r < 16; ++r) { p0[r] -= dl; p1[r] -= dl; }
#pragma unroll
    for (int r = 0; r < 16; ++r) negm[r] = -mhat;
    asm volatile("" : "+v"(negm));
    const float f = __builtin_amdgcn_exp2f(-dl); l_reg *= f; if (hi == 0) al_l[r32] = f; resc = true; }
#pragma unroll
  for (int r = 0; r < 16; ++r) p0[r] = __builtin_amdgcn_exp2f(p0[r]);
  return resc;
}
#undef MX3
__device__ __forceinline__ void finishSM(f32x16& p0, f32x16& p1, float& l_reg, bf16x8& pa0, bf16x8& pa1, bf16x8& pa2, bf16x8& pa3) {
#pragma unroll
  for (int r = 0; r < 16; ++r) p1[r] = __builtin_amdgcn_exp2f(p1[r]);
  float ps = 0;
#pragma unroll
  for (int r = 0; r < 16; ++r) ps += p0[r];
#pragma unroll
  for (int r = 0; r < 16; ++r) ps += p1[r];
  l_reg += ps;
#define PK4(P, BASE, OUT) do { unsigned a0 = cvtpk(P[BASE + 0], P[BASE + 1]), a1 = cvtpk(P[BASE + 2], P[BASE + 3]);   \
    unsigned b0 = cvtpk(P[BASE + 4], P[BASE + 5]), b1 = cvtpk(P[BASE + 6], P[BASE + 7]);                              \
    auto r0 = __builtin_amdgcn_permlane32_swap(a0, b0, false, false); auto r1 = __builtin_amdgcn_permlane32_swap(a1, b1, false, false); \
    u32x4 w = {r0[0], r1[0], r0[1], r1[1]}; OUT = *reinterpret_cast<bf16x8*>(&w); } while (0)
  PK4(p0, 0, pa0); PK4(p0, 8, pa1); PK4(p1, 0, pa2); PK4(p1, 8, pa3);
#undef PK4
}
__device__ __forceinline__ void qkt(f32x16& p0, f32x16& p1, const LAS char* Ks, const bf16x8* qr, const f32x16& negm, int r32, int hi) {
#pragma unroll
  for (int d0 = 0; d0 < 8; ++d0) { int cb = (d0 * 16 + hi * 8) * 2;
    bf16x8 b0 = *reinterpret_cast<const LAS bf16x8*>(Ks + KSWZ(r32, cb));
    bf16x8 b1 = *reinterpret_cast<const LAS bf16x8*>(Ks + KSWZ(32 + r32, cb));
    if (d0 == 0) { p0 = __builtin_amdgcn_mfma_f32_32x32x16_bf16(b0, qr[0], negm, 0, 0, 0); p1 = __builtin_amdgcn_mfma_f32_32x32x16_bf16(b1, qr[0], negm, 0, 0, 0); }
    else { p0 = __builtin_amdgcn_mfma_f32_32x32x16_bf16(b0, qr[d0], p0, 0, 0, 0); p1 = __builtin_amdgcn_mfma_f32_32x32x16_bf16(b1, qr[d0], p1, 0, 0, 0); } }
}
__device__ __forceinline__ int v_st(int k, int c) { const int kk = (k & ~0xC) | ((k & 4) << 1) | ((k & 8) >> 1); return ((kk >> 3) * 4 + (c >> 5)) * 512 + ((kk & 7) * 32 + (c & 31)) * 2; }
__device__ __forceinline__ int v_rd_base(int lane) { return ((lane & 3) << 3) | (((lane >> 2) & 3) << 6) | (((lane >> 4) & 1) << 5) | (((lane >> 5) & 1) << 8); }
constexpr int v_rd_off(int d0, int ks, int half) { return d0 * 512 + ks * 4096 + half * 2048; }
template <int OFF> __device__ __forceinline__ s16x4 tr_read(int vb) {
  s16x4 r; asm volatile("ds_read_b64_tr_b16 %0, %1 offset:%2" : "=&v"(r) : "v"(vb), "i"(OFF) : "memory"); return r;
}
template <int D0> __device__ __forceinline__ void pv_one(f32x16& od, int vb, bf16x8 pa0, bf16x8 pa1, bf16x8 pa2, bf16x8 pa3) {
  const s16x4 l0 = tr_read<v_rd_off(D0, 0, 0)>(vb), h0 = tr_read<v_rd_off(D0, 0, 1)>(vb), l1 = tr_read<v_rd_off(D0, 1, 0)>(vb), h1 = tr_read<v_rd_off(D0, 1, 1)>(vb);
  const s16x4 l2 = tr_read<v_rd_off(D0, 2, 0)>(vb), h2 = tr_read<v_rd_off(D0, 2, 1)>(vb), l3 = tr_read<v_rd_off(D0, 3, 0)>(vb), h3 = tr_read<v_rd_off(D0, 3, 1)>(vb);
  asm volatile("s_waitcnt lgkmcnt(0)" ::: "memory"); SBAR();
#define PK(L, H) (bf16x8){L[0], L[1], L[2], L[3], H[0], H[1], H[2], H[3]}
  od = __builtin_amdgcn_mfma_f32_32x32x16_bf16(pa0, PK(l0, h0), od, 0, 0, 0);
  od = __builtin_amdgcn_mfma_f32_32x32x16_bf16(pa1, PK(l1, h1), od, 0, 0, 0);
  od = __builtin_amdgcn_mfma_f32_32x32x16_bf16(pa2, PK(l2, h2), od, 0, 0, 0);
  od = __builtin_amdgcn_mfma_f32_32x32x16_bf16(pa3, PK(l3, h3), od, 0, 0, 0);
#undef PK
}
__device__ __forceinline__ void pv_d0(f32x16* o, int vb, bf16x8 pa0, bf16x8 pa1, bf16x8 pa2, bf16x8 pa3) {
  pv_one<0>(o[0], vb, pa0, pa1, pa2, pa3); pv_one<1>(o[1], vb, pa0, pa1, pa2, pa3); pv_one<2>(o[2], vb, pa0, pa1, pa2, pa3); pv_one<3>(o[3], vb, pa0, pa1, pa2, pa3);
}
__device__ __forceinline__ void attn_dense_body(const bf16_t* __restrict__ Qb, const bf16_t* __restrict__ Kh, const bf16_t* __restrict__ Vh, bf16_t* __restrict__ Ob, int seq, LAS char* lds, const int tid_in) {
  int tid_ = tid_in; asm volatile("" : "+v"(tid_));
  const int tid = tid_, wid = tid >> 6, lane = tid & 63, r32 = lane & 31, hi = lane >> 5;
  LAS char* V_lds = lds; LAS char* K_lds = lds + 2 * SHM_V;
  LAS float* ws = (LAS float*)(lds + 2 * SHM_V + 2 * SHM_K) + wid * 64; LAS float* li_l = ws; LAS float* al_l = ws + 32;
  float mhat = 0.f, l_reg = 0; f32x16 o[4] = {}; bf16x8 qr[8]; f32x16 negm = f32x16{}; asm volatile("" : "+v"(negm));
  const bf16_t* Qw = Qb + (long)(wid * QBLK + r32) * LDQ + hi * 8;
#pragma unroll
  for (int d0 = 0; d0 < 8; ++d0) qr[d0] = *reinterpret_cast<const bf16x8*>(Qw + d0 * 16);
  const int sr = tid >> 4, sc = (tid & 15) * 8, vst0 = v_st(sr, sc), vst1 = v_st(32 + sr, sc);
  const int vb0 = (int)(unsigned)(uintptr_t)V_lds + v_rd_base(lane);
  struct { bf16x8 vs0, vs1, ks0, ks1; } sr_[1];
#define SLOAD(i, k0) do { sr_[i].vs0 = *reinterpret_cast<const bf16x8*>(&Vh[(long)((k0) + sr) * LDK + sc]); sr_[i].vs1 = *reinterpret_cast<const bf16x8*>(&Vh[(long)((k0) + 32 + sr) * LDK + sc]); \
    sr_[i].ks0 = *reinterpret_cast<const bf16x8*>(&Kh[(long)((k0) + sr) * LDK + sc]); sr_[i].ks1 = *reinterpret_cast<const bf16x8*>(&Kh[(long)((k0) + 32 + sr) * LDK + sc]); } while (0)
#define SWRITE(b, i) do { *(LAS bf16x8*)(V_lds + (b) * SHM_V + vst0) = sr_[i].vs0;          \
    *(LAS bf16x8*)(V_lds + (b) * SHM_V + vst1) = sr_[i].vs1; int kc = sc * 2;               \
    *(LAS bf16x8*)(K_lds + (b) * SHM_K + KSWZ(sr, kc)) = sr_[i].ks0;                       \
    *(LAS bf16x8*)(K_lds + (b) * SHM_K + KSWZ(32 + sr, kc)) = sr_[i].ks1; } while (0)
#define SWAIT() asm volatile("s_waitcnt vmcnt(0)" ::: "memory")
#define RESC(fl) do { if (fl) { asm volatile("s_waitcnt lgkmcnt(0)" ::: "memory"); \
    _Pragma("unroll") for (int d = 0; d < 4; ++d) _Pragma("unroll") for (int r = 0; r < 16; ++r) o[d][r] *= al_l[crow(r, hi)]; } } while (0)
  f32x16 pA0, pA1, pB0, pB1; bool rsA, rsB; bf16x8 pa0, pa1, pa2, pa3; const int NT = seq / KVBLK;
  constexpr int SE = 0, SO = 0;
  SLOAD(SE, 0); asm volatile("s_waitcnt vmcnt(0)" ::: "memory"); SWRITE(0, SE); __syncthreads();
  qkt(pA0, pA1, K_lds, qr, negm, r32, hi); (void)partialSM<true>(pA0, pA1, mhat, negm, l_reg, al_l, r32, hi);
  SLOAD(SO, KVBLK);
  SWAIT(); SWRITE(1, SO); __syncthreads();
  for (int j = 1; j + 1 < NT; j += 2) {
    SBAR(); qkt(pB0, pB1, K_lds + SHM_K, qr, negm, r32, hi);
    finishSM(pA0, pA1, l_reg, pa0, pa1, pa2, pa3); SBAR();
    SLOAD(SO, (j + 1) * KVBLK); SBAR();
    pv_d0(o, vb0, pa0, pa1, pa2, pa3); rsB = partialSM<false>(pB0, pB1, mhat, negm, l_reg, al_l, r32, hi);
    __syncthreads(); SWAIT(); SWRITE(0, SE);
    RESC(rsB); __syncthreads();
    SBAR(); qkt(pA0, pA1, K_lds, qr, negm, r32, hi);
    finishSM(pB0, pB1, l_reg, pa0, pa1, pa2, pa3); SBAR();
    SLOAD(SE, (j + 2) * KVBLK); SBAR();
    pv_d0(o, vb0 + SHM_V, pa0, pa1, pa2, pa3); rsA = partialSM<false>(pA0, pA1, mhat, negm, l_reg, al_l, r32, hi);
    __syncthreads(); SWAIT(); SWRITE(1, SO);
    RESC(rsA); __syncthreads();
  }
  SBAR(); qkt(pB0, pB1, K_lds + SHM_K, qr, negm, r32, hi);
  finishSM(pA0, pA1, l_reg, pa0, pa1, pa2, pa3); SBAR();
  pv_d0(o, vb0, pa0, pa1, pa2, pa3); rsB = partialSM<false>(pB0, pB1, mhat, negm, l_reg, al_l, r32, hi);
  __syncthreads(); RESC(rsB);
  finishSM(pB0, pB1, l_reg, pa0, pa1, pa2, pa3); SBAR();
  pv_d0(o, vb0 + SHM_V, pa0, pa1, pa2, pa3);
  { auto rr = __builtin_amdgcn_permlane32_swap(__float_as_uint(l_reg), __float_as_uint(l_reg), false, false); l_reg = __uint_as_float(rr[0]) + __uint_as_float(rr[1]); }
  if (hi == 0) li_l[r32] = l_reg; asm volatile("s_waitcnt lgkmcnt(0)" ::: "memory");
  float rli[16];
#pragma unroll
  for (int r = 0; r < 16; ++r) rli[r] = __builtin_amdgcn_rcpf(li_l[crow(r, hi)]);
  bf16_t* Ow = Ob + (long)(wid * QBLK) * LDO;
#pragma unroll
  for (int r = 0; r < 16; ++r) { const int orow = crow(r, hi);
#pragma unroll
    for (int d0 = 0; d0 < 4; ++d0) { const unsigned w = cvtpk(o[d0][r] * rli[r], 0.f); Ow[(long)orow * LDO + d0 * 32 + r32] = (bf16_t)(w & 0xffffu); } }
#undef SLOAD
#undef SWRITE
#undef SWAIT
#undef RESC
}

template <int OFF> __device__ __forceinline__ bf16x8 lds_rd128(int a) { bf16x8 r; asm volatile("ds_read_b128 %0, %1 offset:%2" : "=&v"(r) : "v"(a), "i"(OFF) : "memory"); return r; }
#define MX3(a, b, c) __builtin_fmaxf(__builtin_fmaxf((a), (b)), (c))
__device__ __forceinline__ bool partialSM_head(f32x16& p0, f32x16& p1, float& mhat, f32x16& negm, float& l_reg, LAS float* al_l, int r32, int hi) {
  float a = MX3(p0[0], p0[1], p1[0]), b = MX3(p0[2], p0[3], p1[1]); a = MX3(a, p1[2], p1[3]);
#pragma unroll
  for (int r = 4; r < 16; r += 4) { a = MX3(a, p0[r], p0[r + 1]); b = MX3(b, p0[r + 2], p0[r + 3]); a = MX3(a, p1[r], p1[r + 1]); b = MX3(b, p1[r + 2], p1[r + 3]); }
  float rm = __builtin_fmaxf(a, b);
  { auto rr = __builtin_amdgcn_permlane32_swap(__float_as_uint(rm), __float_as_uint(rm), false, false);
    rm = __builtin_fmaxf(__uint_as_float(rr[0]), __uint_as_float(rr[1])); }
  bool resc = false;
  if (__builtin_expect(__any(rm > THRL), 0)) { const float dl = __builtin_fmaxf(rm, 0.f); mhat += dl;
#pragma unroll
    for (int r = 0; r < 16; ++r) { p0[r] -= dl; p1[r] -= dl; }
#pragma unroll
    for (int r = 0; r < 16; ++r) negm[r] = -mhat;
    asm volatile("" : "+v"(negm));
    const float f = __builtin_amdgcn_exp2f(-dl); l_reg *= f; if (hi == 0) al_l[r32] = f; resc = true; }
  return resc;
}
#undef MX3
constexpr int RSLOT = 16384, RING_ATTN = 6 * RSLOT + NW * 64 * 4;
__device__ __forceinline__ void attn_ring_body(const bf16_t* __restrict__ Qb, const bf16_t* __restrict__ Kh, const bf16_t* __restrict__ Vh, bf16_t* __restrict__ Ob, int seq, LAS char* lds, const int tid_in, const bool BND) {
  int tid_ = tid_in; asm volatile("" : "+v"(tid_));
  const int tid = tid_, wid = __builtin_amdgcn_readfirstlane(tid >> 6), lane = tid & 63, r32 = lane & 31, hi = lane >> 5;
  LAS char* K_lds = lds; LAS char* V_lds = lds + 3 * RSLOT;
  LAS float* ws = (LAS float*)(lds + 6 * RSLOT) + wid * 64; LAS float* li_l = ws; LAS float* al_l = ws + 32;
  int koff[2], voff[2];
#pragma unroll
  for (int e = 0; e < 2; ++e) { const int i = 2 * wid + e;
    const int krow = 4 * i + (lane >> 4), cp = lane & 15, kc = cp ^ (krow & 7); koff[e] = (krow * LDK + 8 * kc) * 2;
    const int sub = 2 * i + (lane >> 5), q = lane & 31, kk = (sub >> 2) * 8 + (q >> 2), c = (sub & 3) * 32 + (q & 3) * 8, k = (kk & ~0xC) | ((kk & 4) << 1) | ((kk & 8) >> 1); voff[e] = (k * LDK + c) * 2; }
  const unsigned pdst = (unsigned)(2 * wid) * 1024u;
  const __amdgpu_buffer_rsrc_t krs = __builtin_amdgcn_make_buffer_rsrc((void*)Kh, 0, S * LDK * 2, 0x00020000), vrs = __builtin_amdgcn_make_buffer_rsrc((void*)Vh, 0, S * LDK * 2, 0x00020000);
#define DMA_K(t, slot) do { _Pragma("unroll") for (int e = 0; e < 2; ++e) __builtin_amdgcn_raw_ptr_buffer_load_lds(krs, (LAS unsigned*)(K_lds + (slot) + pdst + e * 1024), 16, koff[e], (t) * (KVBLK * LDK * 2), 0, 0); } while (0)
#define DMA_V(t, slot) do { _Pragma("unroll") for (int e = 0; e < 2; ++e) __builtin_amdgcn_raw_ptr_buffer_load_lds(vrs, (LAS unsigned*)(V_lds + (slot) + pdst + e * 1024), 16, voff[e], (t) * (KVBLK * LDK * 2), 0, 0); } while (0)
#define WAIT_BAR(N) asm volatile("s_waitcnt vmcnt(" #N ") lgkmcnt(0)\n\ts_barrier" ::: "memory")
  const int NT = seq / KVBLK;
  int cur = 0, nxt = RSLOT, nn = 2 * RSLOT;
#define ROT() do { const int t_ = cur; cur = nxt; nxt = nn; nn = t_; } while (0)
  DMA_K(0, 0); DMA_V(0, 0); DMA_K(1, RSLOT);
  float mhat = 0.f, l_reg = 0; f32x16 o[4] = {}; bf16x8 qr[8]; f32x16 negm = f32x16{};
  asm volatile("" : "+v"(negm));
  const bf16_t* Qw = Qb + (long)(wid * QBLK + r32) * LDQ + hi * 8;
#pragma unroll
  for (int d0 = 0; d0 < 8; ++d0) qr[d0] = *reinterpret_cast<const bf16x8*>(Qw + d0 * 16);
  const int vb0 = (int)(unsigned)(uintptr_t)V_lds + v_rd_base(lane);
#define RESC(fl) do { if (fl) { asm volatile("s_waitcnt lgkmcnt(0)" ::: "memory"); \
    _Pragma("unroll") for (int d = 0; d < 4; ++d) _Pragma("unroll") for (int r = 0; r < 16; ++r) o[d][r] *= al_l[crow(r, hi)]; } } while (0)
  f32x16 pA0, pA1, pB0, pB1; bool rs; bf16x8 pa0, pa1, pa2, pa3;
  WAIT_BAR(0);
  qkt(pA0, pA1, K_lds + cur, qr, negm, r32, hi);
  if (BND) {
#pragma unroll
    for (int r = 0; r < 16; ++r) pA0[r] = __builtin_amdgcn_exp2f(pA0[r]);
  } else (void)partialSM<true>(pA0, pA1, mhat, negm, l_reg, al_l, r32, hi);
  DMA_K(2, nn); DMA_V(1, nxt);
  WAIT_BAR(4); ROT();
  const int kbase = (int)(unsigned)(uintptr_t)K_lds + r32 * 256;
  const int kad0 = kbase + (((0 + hi) ^ (r32 & 7)) << 4), kad1 = kbase + (((2 + hi) ^ (r32 & 7)) << 4), kad2 = kbase + (((4 + hi) ^ (r32 & 7)) << 4), kad3 = kbase + (((6 + hi) ^ (r32 & 7)) << 4);
#define WAITL(N) asm volatile("s_waitcnt lgkmcnt(" #N ")" ::: "memory")
#define MFQ(acc, kf, d0, c) acc = __builtin_amdgcn_mfma_f32_32x32x16_bf16(kf, qr[d0], c, 0, 0, 0)
#define EXP8(P, B) do { _Pragma("unroll") for (int r_ = 0; r_ < 8; ++r_) P[(B) + r_] = __builtin_amdgcn_exp2f(P[(B) + r_]); } while (0)
#define SUM8(P, B) do { _Pragma("unroll") for (int r_ = 0; r_ < 8; ++r_) ps_ += P[(B) + r_]; } while (0)
#define PK4(P, BASE, OUT) do { unsigned a0 = cvtpk(P[BASE + 0], P[BASE + 1]), a1 = cvtpk(P[BASE + 2], P[BASE + 3]);   \
    unsigned b0 = cvtpk(P[BASE + 4], P[BASE + 5]), b1 = cvtpk(P[BASE + 6], P[BASE + 7]);                              \
    auto r0 = __builtin_amdgcn_permlane32_swap(a0, b0, false, false); auto r1 = __builtin_amdgcn_permlane32_swap(a1, b1, false, false); \
    u32x4 w = {r0[0], r1[0], r0[1], r1[1]}; OUT = *reinterpret_cast<bf16x8*>(&w); } while (0)
#define PKV(L, H) (bf16x8){L[0], L[1], L[2], L[3], H[0], H[1], H[2], H[3]}
#define RDV(D0, l0, h0, l1, h1, l2, h2, l3, h3) const s16x4 l0 = tr_read<v_rd_off(D0, 0, 0)>(vb_), h0 = tr_read<v_rd_off(D0, 0, 1)>(vb_), l1 = tr_read<v_rd_off(D0, 1, 0)>(vb_), h1 = tr_read<v_rd_off(D0, 1, 1)>(vb_), \
    l2 = tr_read<v_rd_off(D0, 2, 0)>(vb_), h2 = tr_read<v_rd_off(D0, 2, 1)>(vb_), l3 = tr_read<v_rd_off(D0, 3, 0)>(vb_), h3 = tr_read<v_rd_off(D0, 3, 1)>(vb_)
#define MFV(od, l0, h0, l1, h1, l2, h2, l3, h3) do { od = __builtin_amdgcn_mfma_f32_32x32x16_bf16(pa0, PKV(l0, h0), od, 0, 0, 0); od = __builtin_amdgcn_mfma_f32_32x32x16_bf16(pa1, PKV(l1, h1), od, 0, 0, 0); \
    od = __builtin_amdgcn_mfma_f32_32x32x16_bf16(pa2, PKV(l2, h2), od, 0, 0, 0); od = __builtin_amdgcn_mfma_f32_32x32x16_bf16(pa3, PKV(l3, h3), od, 0, 0, 0); } while (0)
#define RS_HEAD(X0, X1) do { rs = false; if (!BND) rs = partialSM_head(X0, X1, mhat, negm, l_reg, al_l, r32, hi); } while (0)
#define ITER(X0, X1, Y0, Y1, t) do { \
    SBAR(); \
    { const int a0_ = kad0 + cur, a1_ = kad1 + cur, a2_ = kad2 + cur, a3_ = kad3 + cur; const int vb_ = vb0 + nn; float ps_ = 0.f; \
      const bf16x8 k00 = lds_rd128<0>(a0_), k01 = lds_rd128<8192>(a0_), k10 = lds_rd128<0>(a1_), k11 = lds_rd128<8192>(a1_); \
      const bf16x8 k20 = lds_rd128<0>(a2_), k21 = lds_rd128<8192>(a2_), k30 = lds_rd128<0>(a3_), k31 = lds_rd128<8192>(a3_); \
      WAITL(4); SBAR(); \
      MFQ(X0, k00, 0, negm); MFQ(X1, k01, 0, negm); MFQ(X0, k10, 1, X0); MFQ(X1, k11, 1, X1); \
      EXP8(Y1, 0); PK4(Y0, 0, pa0); SUM8(Y0, 0); \
      const bf16x8 k40 = lds_rd128<128>(a0_), k41 = lds_rd128<8192 + 128>(a0_), k50 = lds_rd128<128>(a1_), k51 = lds_rd128<8192 + 128>(a1_); \
      WAITL(4); SBAR(); \
      MFQ(X0, k20, 2, X0); MFQ(X1, k21, 2, X1); MFQ(X0, k30, 3, X0); MFQ(X1, k31, 3, X1); \
      EXP8(Y1, 8); PK4(Y0, 8, pa1); SUM8(Y0, 8); \
      if ((t) + 2 < NT) DMA_K((t) + 2, nn); \
      const bf16x8 k60 = lds_rd128<128>(a2_), k61 = lds_rd128<8192 + 128>(a2_), k70 = lds_rd128<128>(a3_), k71 = lds_rd128<8192 + 128>(a3_); \
      WAITL(4); SBAR(); \
      MFQ(X0, k40, 4, X0); MFQ(X1, k41, 4, X1); MFQ(X0, k50, 5, X0); MFQ(X1, k51, 5, X1); \
      PK4(Y1, 0, pa2); SUM8(Y1, 0); \
      if ((t) + 1 < NT) DMA_V((t) + 1, nxt); \
      RDV(0, vl00, vh00, vl01, vh01, vl02, vh02, vl03, vh03); \
      WAITL(8); SBAR(); \
      MFQ(X0, k60, 6, X0); MFQ(X1, k61, 6, X1); MFQ(X0, k70, 7, X0); MFQ(X1, k71, 7, X1); \
      PK4(Y1, 8, pa3); SUM8(Y1, 8); l_reg += ps_; \
      RDV(1, vl10, vh10, vl11, vh11, vl12, vh12, vl13, vh13); \
      WAITL(8); SBAR(); \
      MFV(o[0], vl00, vh00, vl01, vh01, vl02, vh02, vl03, vh03); \
      RS_HEAD(X0, X1); \
      RDV(2, vl20, vh20, vl21, vh21, vl22, vh22, vl23, vh23); \
      WAITL(8); SBAR(); \
      MFV(o[1], vl10, vh10, vl11, vh11, vl12, vh12, vl13, vh13); \
      EXP8(X0, 0); \
      RDV(3, vl30, vh30, vl31, vh31, vl32, vh32, vl33, vh33); \
      WAITL(8); SBAR(); \
      MFV(o[2], vl20, vh20, vl21, vh21, vl22, vh22, vl23, vh23); \
      EXP8(X0, 8); \
      WAITL(0); SBAR(); \
      MFV(o[3], vl30, vh30, vl31, vh31, vl32, vh32, vl33, vh33); } \
    if ((t) + 2 < NT) WAIT_BAR(4); else if ((t) + 1 < NT) WAIT_BAR(2); else WAIT_BAR(0); \
    RESC(rs); ROT(); } while (0)
  int t = 1;
  for (; t + 1 < NT; t += 2) { ITER(pB0, pB1, pA0, pA1, t); ITER(pA0, pA1, pB0, pB1, t + 1); }
  ITER(pB0, pB1, pA0, pA1, t);
  finishSM(pB0, pB1, l_reg, pa0, pa1, pa2, pa3); SBAR();
  pv_d0(o, vb0 + nn, pa0, pa1, pa2, pa3);
  { auto rr = __builtin_amdgcn_permlane32_swap(__float_as_uint(l_reg), __float_as_uint(l_reg), false, false); l_reg = __uint_as_float(rr[0]) + __uint_as_float(rr[1]); }
  if (hi == 0) li_l[r32] = l_reg; asm volatile("s_waitcnt lgkmcnt(0)" ::: "memory");
  float rli[16];
#pragma unroll
  for (int r = 0; r < 16; ++r) rli[r] = __builtin_amdgcn_rcpf(li_l[crow(r, hi)]);
  bf16_t* Ow = Ob + (long)(wid * QBLK) * LDO;
#pragma unroll
  for (int r = 0; r < 16; ++r) { const int orow = crow(r, hi);
#pragma unroll
    for (int d0 = 0; d0 < 4; ++d0) { const unsigned w = cvtpk(o[d0][r] * rli[r], 0.f); Ow[(long)orow * LDO + d0 * 32 + r32] = (bf16_t)(w & 0xffffu); } }
  asm volatile("s_waitcnt lgkmcnt(0)\n\ts_barrier" ::: "memory");
#undef DMA_K
#undef DMA_V
#undef WAIT_BAR
#undef ROT
#undef RESC
#undef ITER
#undef WAITL
#undef MFQ
#undef EXP8
#undef SUM8
#undef PK4
#undef PKV
#undef RDV
#undef MFV
}
#undef SBAR
}

constexpr int NWAVES = 8;
constexpr int N_PHASES = 1 + 11 * DEPTH;
constexpr int N_LAUNCHES = MK_N_LAUNCHES;
static_assert(N_LAUNCHES == 1 || N_LAUNCHES == N_PHASES, "MK_N_LAUNCHES is 1 or 23");

constexpr size_t MiB = 1u << 20;
constexpr size_t WS_CTL = 0, CTL_ZERO_BYTES = 1 * MiB;
constexpr size_t WS_ROPE = 1 * MiB;
constexpr size_t WS_PB = 2 * MiB;
constexpr size_t WS_W = 16 * MiB;
constexpr size_t LW_IN = 0, LW_POOL = 128 * MiB, LW_OUT = 132 * MiB, LW_GU = 164 * MiB, LW_DOWN = 336 * MiB, LW_PIN = 422 * MiB, LW_PG = 424 * MiB, LW_BYTES = 456 * MiB;
constexpr size_t WS_ACT = WS_W + 2 * LW_BYTES;
constexpr size_t WS_H = WS_ACT;
constexpr size_t WS_Q = WS_H + 64 * MiB;
constexpr size_t WS_K = WS_Q + 64 * MiB;
constexpr size_t WS_V = WS_K + 16 * MiB;
constexpr size_t WS_U = WS_V + 16 * MiB;
constexpr size_t WS_GA = WS_U + 32 * MiB;
constexpr size_t WS_GP = WS_GA + 64 * MiB;
constexpr size_t WS_Q2 = WS_GP + 64 * MiB;
constexpr size_t WS_K2 = WS_Q2 + 64 * MiB;
constexpr size_t WS_DL = WS_K2 + 16 * MiB;
constexpr size_t WS_O = WS_DL + 32 * MiB;
constexpr size_t WS_MG = WS_O + 64 * MiB;
constexpr size_t WS_Y = WS_MG + 64 * MiB;
constexpr size_t WS_F = WS_Y + 64 * MiB;
constexpr size_t WS_E = WS_F + 172 * MiB;
constexpr size_t WS_END = WS_E + 128 * MiB;
static_assert(WS_END <= 2048 * MiB, "workspace map");

constexpr int CW_TMO = 0, CW_CODE = 1;
constexpr int CW_BAR = 4096;

constexpr int RING_OFF = 0, RING_BYTES = 131072;
constexpr int LDSCTL_OFF = RING_BYTES, MISC_OFF = LDSCTL_OFF + 320;
constexpr int LDS_BYTES = 147456;

typedef GAS unsigned gu32;
#define RLX_AGENT __ATOMIC_RELAXED, __HIP_MEMORY_SCOPE_AGENT
#define LDS_WAIT() asm volatile("s_waitcnt lgkmcnt(0)" ::: "memory")
#define VM_WAIT() asm volatile("s_waitcnt vmcnt(0)" ::: "memory")
__device__ __forceinline__ unsigned f2bf(float f) { unsigned u = __builtin_bit_cast(unsigned, f); return (u + 0x7fffu + ((u >> 16) & 1u)) >> 16; }
__device__ __forceinline__ unsigned pk2(float lo, float hi) { return f2bf(lo) | (f2bf(hi) << 16); }

#define XB_TMO      128
#define XB_XCNT(j)  (256  + 64 * (j))
#define XB_XSUB(j)  (1280 + 64 * (j))
#define XB_XGEN(j)  (2304 + 64 * (j))
#define XB_TOP      3328
#define XB_TOPGEN   3392
#define XCD_BAR_WORDS 3456
#define XB_SPIN_CAP (1u << 18)

__device__ __forceinline__ unsigned xb_ld(unsigned* p)              { return __hip_atomic_load(p, __ATOMIC_RELAXED, __HIP_MEMORY_SCOPE_AGENT); }
__device__ __forceinline__ unsigned xb_add(unsigned* p, unsigned v) { return __hip_atomic_fetch_add(p, v, __ATOMIC_RELAXED, __HIP_MEMORY_SCOPE_AGENT); }
__device__ __forceinline__ unsigned xb_xcc_id() { return (unsigned)__builtin_amdgcn_s_getreg((3 << 11) | 20) & 0xFu; }
#define XB_SPIN(cond, bar) do { unsigned _sp = 0; while (cond) { __builtin_amdgcn_s_sleep(1); \
    if ((++_sp & 255u) == 0u) { if (xb_ld(&(bar)[XB_TMO])) break; if (_sp > XB_SPIN_CAP) { atomicAdd(&(bar)[XB_TMO], 1u); break; } } } } while (0)

struct XcdBarrier {
    unsigned* bar; unsigned x;
    volatile LAS unsigned* st;
};
__device__ __forceinline__ XcdBarrier xcd_barrier_post(unsigned* bar, volatile LAS unsigned* st) {
    XcdBarrier b; b.bar = bar; b.x = xb_xcc_id(); b.st = st;
    if (threadIdx.x == 0) (void)xb_add(&bar[XB_XCNT(b.x)], 1u);
    return b;
}
__device__ __forceinline__ void xcd_barrier_complete(unsigned* bar, unsigned x, unsigned& nloc, unsigned& nx) {
    const unsigned G = gridDim.x * gridDim.y * gridDim.z;
    unsigned sum, cnt, mine, sp = 0u;
    for (;;) {
        sum = 0u; cnt = 0u; mine = 0u;
#pragma unroll
        for (unsigned j = 0; j < 16; ++j) { const unsigned c = xb_ld(&bar[XB_XCNT(j)]); sum += c; cnt += (c > 0u) ? 1u : 0u; mine = (j == x) ? c : mine; }
        if (sum == G) break;
        __builtin_amdgcn_s_sleep(1);
        if ((++sp & 255u) == 0u) { if (xb_ld(&bar[XB_TMO])) break; if (sp > XB_SPIN_CAP) { atomicAdd(&bar[XB_TMO], 1u); break; } }
    }
    nloc = mine > 0u ? mine : 1u; nx = cnt > 0u ? cnt : 1u;
}
__device__ __forceinline__ void xcd_barrier(const XcdBarrier& b, const int wave_s) {
    asm volatile("s_waitcnt vmcnt(0)" ::: "memory");
    __syncthreads();
    unsigned m_ = ~0u; asm volatile("" : "+s"(m_));
    if (wave_s == 0 && __builtin_amdgcn_mbcnt_hi(m_, __builtin_amdgcn_mbcnt_lo(m_, 0u)) == 0u) {
        unsigned* bar = b.bar; asm volatile("" : "+s"(bar));
        __builtin_amdgcn_s_waitcnt(0);
        unsigned nloc = b.st[0], nx = b.st[1];
        if (nloc == 0u) { xcd_barrier_complete(bar, b.x, nloc, nx); b.st[0] = nloc; b.st[1] = nx; }
        const unsigned old = xb_add(&bar[XB_XSUB(b.x)], 1u);
        const unsigned gen = old / nloc;
        if (old + 1u == (gen + 1u) * nloc) {
            __builtin_amdgcn_fence(__ATOMIC_RELEASE, "agent");
            asm volatile("s_waitcnt vmcnt(0)" ::: "memory");
            const unsigned og = xb_add(&bar[XB_TOP], 1u);
            const unsigned tg = og / nx;
            if (og + 1u == (tg + 1u) * nx) xb_add(&bar[XB_TOPGEN], 1u);
            else XB_SPIN(xb_ld(&bar[XB_TOPGEN]) == tg, bar);
            __builtin_amdgcn_fence(__ATOMIC_ACQUIRE, "agent");
            xb_add(&bar[XB_XGEN(b.x)], 1u);
            asm volatile("s_waitcnt vmcnt(0)" ::: "memory");
        } else {
            XB_SPIN(xb_ld(&bar[XB_XGEN(b.x)]) == gen, bar);
            __builtin_amdgcn_fence(__ATOMIC_ACQUIRE, "agent");
            asm volatile("s_waitcnt vmcnt(0)" ::: "memory");
        }
    }
    __syncthreads();
}

struct Frame {
    LAS unsigned char* lds;
    int tid, lane, wave;
    int vcu, G, bx;
};
__device__ __forceinline__ int thread_id(int wave_s) { unsigned m = ~0u; asm volatile("" : "+s"(m)); const int lane = (int)__builtin_amdgcn_mbcnt_hi(m, __builtin_amdgcn_mbcnt_lo(m, 0u)); int t = wave_s * 64 + lane; asm volatile("" : "+v"(t)); return t; }
__device__ __forceinline__ Frame make_frame(LAS unsigned char* lds, int wave_s) {
    Frame F; const int t = thread_id(wave_s); int bx = blockIdx.x; asm volatile("" : "+s"(bx)); int G = gridDim.x; asm volatile("" : "+s"(G));
    F.lds = lds; F.tid = t; F.lane = t & 63; F.wave = wave_s; F.G = G; F.bx = bx;
    F.vcu = (G % 8 == 0) ? (bx % 8) * (G / 8) + bx / 8 : bx;
    return F;
}

__device__ __forceinline__ float shx(float v, int m, int lane) { return __int_as_float(__builtin_amdgcn_ds_bpermute((lane ^ m) << 2, __float_as_int(v))); }
__device__ __forceinline__ float wave_sum(float v, int lane) {
#pragma unroll
    for (int o = 1; o < 64; o <<= 1) v += shx(v, o, lane);
    return v;
}

template <int MAP>
__device__ __forceinline__ void p0_transpose_item(const float* W, int K, int N, bf16_t* WT, int row_off, LAS float* scr, int item, int lane) {
    const int nblk = N / 32, kb = item / nblk, nb = item % nblk, k0 = 64 * kb, n0 = 32 * nb;
    const int r0 = (MAP == 0) ? (row_off + n0) : (256 * (n0 >> 7) + (n0 & 127) + row_off);
#pragma unroll 8
    for (int i = 0; i < 32; ++i) { const int kk = 2 * i + (lane >> 5); scr[kk * 33 + (lane & 31)] = W[(size_t)(k0 + kk) * N + n0 + (lane & 31)]; }
    LDS_WAIT(); asm volatile("" ::: "memory");
    const int c = lane & 7;
#pragma unroll
    for (int j = 0; j < 4; ++j) { const int n = (lane >> 3) + 8 * j; const LAS float* s = scr + (8 * c) * 33 + n;
        u32x4 o; o.x = pk2(s[0 * 33], s[1 * 33]); o.y = pk2(s[2 * 33], s[3 * 33]); o.z = pk2(s[4 * 33], s[5 * 33]); o.w = pk2(s[6 * 33], s[7 * 33]);
        *(GAS u32x4*)(WT + (size_t)(r0 + n) * K + k0 + 8 * c) = o; }
    LDS_WAIT(); asm volatile("" ::: "memory");
}

struct Args { const float* in[18]; float* out; unsigned char* ws; int ph_lo, ph_hi; };

__device__ __forceinline__ void norm_row(int lane, const float* xin, float* xout, const bf16_t* y, const LAS float* gpost, const LAS float* gpre, bf16_t* h, int hmode) {
    const GAS f32x4* xr = (const GAS f32x4*)xin + lane;
    f32x4 v[16];
#pragma unroll
    for (int j = 0; j < 16; ++j) v[j] = xr[64 * j];
    if (y) {
        const GAS u32x2* yr = (const GAS u32x2*)y + lane; f32x4 yv[16]; float s = 0.f;
#pragma unroll
        for (int j = 0; j < 16; ++j) { const u32x2 w = yr[64 * j]; yv[j] = (f32x4){bf_lo(w.x), bf_hi(w.x), bf_lo(w.y), bf_hi(w.y)}; s += (yv[j].x * yv[j].x + yv[j].y * yv[j].y) + (yv[j].z * yv[j].z + yv[j].w * yv[j].w); }
        const float rstd = 1.0f / sqrtf(wave_sum(s, lane) * (1.f / DM) + EPS);
#pragma unroll
        for (int j = 0; j < 16; ++j) { const f32x4 g = *(const LAS f32x4*)(gpost + 4 * lane + 256 * j); v[j] = v[j] + yv[j] * rstd * g; }
    }
    if (xout) { GAS f32x4* xo = (GAS f32x4*)xout + lane;
#pragma unroll
        for (int j = 0; j < 16; ++j) xo[64 * j] = v[j]; }
    if (hmode) {
        float rstd = 1.f;
        if (hmode == 2) { float s = 0.f;
#pragma unroll
            for (int j = 0; j < 16; ++j) s += (v[j].x * v[j].x + v[j].y * v[j].y) + (v[j].z * v[j].z + v[j].w * v[j].w);
            rstd = 1.0f / sqrtf(wave_sum(s, lane) * (1.f / DM) + EPS); }
        GAS u32x2* ho = (GAS u32x2*)h + lane;
#pragma unroll
        for (int j = 0; j < 16; ++j) { f32x4 t = v[j] * rstd; if (hmode == 2) { const f32x4 g = *(const LAS f32x4*)(gpre + 4 * lane + 256 * j); t = t * g; }
            u32x2 w; w.x = cvt_pk_bf16(t.x, t.y); w.y = cvt_pk_bf16(t.z, t.w); ho[64 * j] = w; }
    }
}
__device__ __forceinline__ void norm_pass(Frame& F, const float* xin, float* xout, const bf16_t* y, const float* gpost, const float* gpre, bf16_t* h, int hmode) {
    LAS float* gl = (LAS float*)(F.lds + RING_OFF);
    __syncthreads();
    for (int i = F.tid; i < DM; i += NWAVES * 64) { gl[i] = gpost ? gpost[i] : 0.f; gl[DM + i] = gpre ? gpre[i] : 0.f; }
    __syncthreads();
    const int gw = F.vcu * NWAVES + F.wave, NGW = F.G * NWAVES;
    for (int m = gw; m < S; m += NGW)
        norm_row(F.lane, xin + (size_t)m * DM, xout ? xout + (size_t)m * DM : nullptr, y ? y + (size_t)m * DM : nullptr, gl, gl + DM, h ? h + (size_t)m * DM : nullptr, hmode);
    __syncthreads();
}

__device__ __forceinline__ void qk_item_addr(int it, int dsub, const bf16_t* Qr, const bf16_t* Kr, bf16_t* Q2, bf16_t* K2, const bf16_t*& src, bf16_t*& dst, int& row, bool& isq) {
    row = it / (NH + NKV); const int hh = it % (NH + NKV); isq = hh < NH;
    src = isq ? Qr + (size_t)row * DM + hh * HD + dsub : Kr + (size_t)row * KVW + (hh - NH) * HD + dsub;
    dst = isq ? Q2 + (size_t)row * DM + hh * HD + dsub : K2 + (size_t)row * KVW + (hh - NH) * HD + dsub;
}
__device__ __forceinline__ void qk_item_do(const u32x4 w, bf16_t* dst, int row, bool isq, int lane, int s, const float* qn, const float* kn, const float* rope) {
    const int dsub = 8 * s, axis = s >> 3, half = (s >> 2) & 1, i0 = 8 * (s & 3);
    const float* gn = isq ? qn : kn;
    float x[8] = {bf_lo(w.x), bf_hi(w.x), bf_lo(w.y), bf_hi(w.y), bf_lo(w.z), bf_hi(w.z), bf_lo(w.w), bf_hi(w.w)};
    float ss = 0.f;
#pragma unroll
    for (int j = 0; j < 8; ++j) ss += x[j] * x[j];
    ss += shx(ss, 1, lane); ss += shx(ss, 2, lane); ss += shx(ss, 4, lane); ss += shx(ss, 8, lane);
    const float rstd = 1.0f / sqrtf(ss * (1.f / HD) + EPS);
    const f32x4 ga = *(const f32x4*)(gn + dsub), gb = *(const f32x4*)(gn + dsub + 4);
    const float g[8] = {ga.x, ga.y, ga.z, ga.w, gb.x, gb.y, gb.z, gb.w};
    const float rs = isq ? rstd * (att::SCALE * 1.4426950408889634f) : rstd;
#pragma unroll
    for (int j = 0; j < 8; ++j) x[j] = x[j] * rs * g[j];
    float xp[8];
#pragma unroll
    for (int j = 0; j < 8; ++j) xp[j] = shx(x[j], 4, lane);
    const int pos = axis ? (row & 63) : (row >> 6);
    const f32x4* tp = (const f32x4*)(rope + ((size_t)pos * 32 + i0) * 2);
    float o[8];
#pragma unroll
    for (int jj = 0; jj < 4; ++jj) { const f32x4 cs = tp[jj];
        o[2 * jj]     = half ? (x[2 * jj] * cs.x + xp[2 * jj] * cs.y)         : (x[2 * jj] * cs.x - xp[2 * jj] * cs.y);
        o[2 * jj + 1] = half ? (x[2 * jj + 1] * cs.z + xp[2 * jj + 1] * cs.w) : (x[2 * jj + 1] * cs.z - xp[2 * jj + 1] * cs.w); }
    u32x4 ow; ow.x = cvt_pk_bf16(o[0], o[1]); ow.y = cvt_pk_bf16(o[2], o[3]); ow.z = cvt_pk_bf16(o[4], o[5]); ow.w = cvt_pk_bf16(o[6], o[7]);
    *(GAS u32x4*)dst = ow;
}
__device__ __forceinline__ void qk_norm_rope_pass(Frame& F, const bf16_t* Qr, const bf16_t* Kr, bf16_t* Q2, bf16_t* K2, const float* qn, const float* kn, const float* rope) {
    const int gw = F.vcu * NWAVES + F.wave, NGW = F.G * NWAVES;
    const int g16 = F.lane >> 4, s = F.lane & 15;
    constexpr int NITEM = S * (NH + NKV);
    const int step = 4 * NGW;
    for (int it = 4 * gw + g16; it < NITEM; it += 4 * step) {
        const bf16_t* src[4]; bf16_t* dst[4]; int row[4]; bool isq[4]; u32x4 w[4];
#pragma unroll
        for (int u = 0; u < 4; ++u) { const int iu = it + u * step; qk_item_addr(iu < NITEM ? iu : it, 8 * s, Qr, Kr, Q2, K2, src[u], dst[u], row[u], isq[u]); w[u] = *(const GAS u32x4*)src[u]; }
#pragma unroll
        for (int u = 0; u < 4; ++u) if (it + u * step < NITEM) qk_item_do(w[u], dst[u], row[u], isq[u], F.lane, s, qn, kn, rope);
    }
}
template <int HW> __device__ __forceinline__ void pool_item(const bf16_t* U, bf16_t* DL, int t, int c) {
    u32x4 w[2 * HW];
#pragma unroll
    for (int i = 0; i < 2 * HW; ++i) { int r = t - HW + i; r = r < 0 ? 0 : (r >= S ? S - 1 : r); w[i] = *(const GAS u32x4*)(U + (size_t)r * POOLW + 8 * c); }
    float acc[8] = {0.f, 0.f, 0.f, 0.f, 0.f, 0.f, 0.f, 0.f};
#pragma unroll
    for (int i = 0; i < 2 * HW; ++i) { const int r = t - HW + i; const float m = ((unsigned)r < (unsigned)S) ? 1.f : 0.f;
        acc[0] += m * bf_lo(w[i].x); acc[1] += m * bf_hi(w[i].x); acc[2] += m * bf_lo(w[i].y); acc[3] += m * bf_hi(w[i].y); acc[4] += m * bf_lo(w[i].z); acc[5] += m * bf_hi(w[i].z); acc[6] += m * bf_lo(w[i].w); acc[7] += m * bf_hi(w[i].w); }
    const int lo = (t - HW) < 0 ? 0 : (t - HW), hi = (t + HW) > S ? S : (t + HW);
    const float inv = 1.0f / (float)(hi - lo);
    const u32x4 wm = w[HW];
    const float me[8] = {bf_lo(wm.x), bf_hi(wm.x), bf_lo(wm.y), bf_hi(wm.y), bf_lo(wm.z), bf_hi(wm.z), bf_lo(wm.w), bf_hi(wm.w)};
    float d[8];
#pragma unroll
    for (int j = 0; j < 8; ++j) d[j] = acc[j] * inv - me[j];
    u32x4 ow; ow.x = cvt_pk_bf16(d[0], d[1]); ow.y = cvt_pk_bf16(d[2], d[3]); ow.z = cvt_pk_bf16(d[4], d[5]); ow.w = cvt_pk_bf16(d[6], d[7]);
    *(GAS u32x4*)(DL + (size_t)t * POOLW + 8 * c) = ow;
}
__device__ __forceinline__ void pool_delta_pass(Frame& F, const bf16_t* U, bf16_t* DL) {
    const int gt = F.vcu * (NWAVES * 64) + F.tid, NT = F.G * NWAVES * 64;
    for (int it = gt; it < S * (POOLW / 8); it += NT) {
        const int t = it >> 8, c = it & 255, g = __builtin_amdgcn_readfirstlane(c >> 6);
        if (g == 0) pool_item<1>(U, DL, t, c); else if (g == 1) pool_item<2>(U, DL, t, c); else if (g == 2) pool_item<4>(U, DL, t, c); else pool_item<8>(U, DL, t, c);
    }
}

__device__ __forceinline__ double inv_freq_of(int i) {
    const double step = 0.74989420933245582730;
    double r = 1.0; for (int k = 0; k < i; ++k) r *= step; return r;
}

typedef const __attribute__((address_space(4))) Args CArgs;
__device__ __forceinline__ CArgs* fresh_args() { CArgs* p = (CArgs*)__builtin_amdgcn_kernarg_segment_ptr(); asm volatile("" : "+s"(p)); return p; }
#define WSP(off) ((bf16_t*)(ws + (off)))

__global__ void __launch_bounds__(NWAVES * 64, 2) fwd_kernel(Args args) {
    extern __shared__ __attribute__((aligned(16))) unsigned char lds[];
    LAS unsigned char* const L = (LAS unsigned char*)lds;
    const int wave_s = __builtin_amdgcn_readfirstlane((int)threadIdx.x >> 6);
    for (int u = threadIdx.x; u < (LDS_BYTES - LDSCTL_OFF) / 4; u += NWAVES * 64) ((LAS unsigned*)(L + LDSCTL_OFF))[u] = 0u;
    __syncthreads();
    unsigned* const barw = (unsigned*)(args.ws + WS_CTL) + CW_BAR;
    XcdBarrier bar; bar.bar = barw; bar.x = 0; bar.st = nullptr;
    if (N_LAUNCHES == 1) bar = xcd_barrier_post(barw, (volatile LAS unsigned*)(L + MISC_OFF) + 8);
#define GRID_BAR() do { if (N_LAUNCHES == 1) { for (int rb_ = 0; rb_ < REP_BAR; ++rb_) xcd_barrier(bar, wave_s); } } while (0)
    const int lo = args.ph_lo, hi = args.ph_hi;
#define IN(k) (lo <= (k) && (k) < hi)
#define SEAM(k) do { if (IN(k) && IN((k) + 1)) GRID_BAR(); } while (0)

    if (IN(0)) {
        CArgs* ap = fresh_args(); unsigned char* ws = ap->ws; Frame F = make_frame(L, wave_s);
        LAS float* scr = (LAS float*)(F.lds + RING_OFF + F.wave * 16384);
        const int gw = F.vcu * NWAVES + F.wave, NGW = F.G * NWAVES;
        constexpr int I_IN = (DM / 64) * (INW / 32), I_POOL = (PGI / 64) * (PGO / 32), I_OUT = (DM / 64) * (DM / 32), I_GU = (DM / 64) * (FF / 32), I_DOWN = (FF / 64) * (DM / 32), I_PIN = (DPLE / 64) * (DM / 32);
        constexpr int I_LAYER = I_IN + 4 * I_POOL + I_OUT + 2 * I_GU + I_DOWN + I_PIN + I_OUT;
        for (int rep = 0; rep < REP_CONV; ++rep)
        for (int it = gw; it < DEPTH * I_LAYER; it += NGW) {
            const int l = it / I_LAYER; int r = it % I_LAYER;
            unsigned char* wl = ws + WS_W + (size_t)l * LW_BYTES;
            if (r < I_IN) { p0_transpose_item<0>(ap->in[2] + (size_t)l * DM * INW, DM, INW, (bf16_t*)(wl + LW_IN), 0, scr, r, F.lane); continue; } r -= I_IN;
            if (r < 4 * I_POOL) { const int g = r / I_POOL; p0_transpose_item<0>(ap->in[5] + ((size_t)l * 4 + g) * PGI * PGO, PGI, PGO, (bf16_t*)(wl + LW_POOL), g * PGO, scr, r % I_POOL, F.lane); continue; } r -= 4 * I_POOL;
            if (r < I_OUT) { p0_transpose_item<0>(ap->in[7] + (size_t)l * DM * DM, DM, DM, (bf16_t*)(wl + LW_OUT), 0, scr, r, F.lane); continue; } r -= I_OUT;
            if (r < I_GU) { p0_transpose_item<1>(ap->in[12] + (size_t)l * DM * FF, DM, FF, (bf16_t*)(wl + LW_GU), 0, scr, r, F.lane); continue; } r -= I_GU;
            if (r < I_GU) { p0_transpose_item<1>(ap->in[13] + (size_t)l * DM * FF, DM, FF, (bf16_t*)(wl + LW_GU), 128, scr, r, F.lane); continue; } r -= I_GU;
            if (r < I_DOWN) { p0_transpose_item<0>(ap->in[14] + (size_t)l * FF * DM, FF, DM, (bf16_t*)(wl + LW_DOWN), 0, scr, r, F.lane); continue; } r -= I_DOWN;
            if (r < I_PIN) { p0_transpose_item<0>(ap->in[15] + (size_t)l * DPLE * DM, DPLE, DM, (bf16_t*)(wl + LW_PIN), 0, scr, r, F.lane); continue; } r -= I_PIN;
            p0_transpose_item<0>(ap->in[16] + (size_t)l * DM * DM, DM, DM, (bf16_t*)(wl + LW_PG), 0, scr, r, F.lane);
        }
        { const int gt = F.vcu * (NWAVES * 64) + F.tid, NT = F.G * NWAVES * 64;
          const float* p_in = ap->in[1]; bf16_t* PB = WSP(WS_PB); float* rope = (float*)(ws + WS_ROPE);
          for (int i = gt; i < DEPTH * S * DPLE / 8; i += NT) { const f32x4 a = *(const GAS f32x4*)(p_in + (size_t)i * 8), b = *(const GAS f32x4*)(p_in + (size_t)i * 8 + 4);
              u32x4 o; o.x = cvt_pk_bf16(a.x, a.y); o.y = cvt_pk_bf16(a.z, a.w); o.z = cvt_pk_bf16(b.x, b.y); o.w = cvt_pk_bf16(b.z, b.w); *(GAS u32x4*)(PB + (size_t)i * 8) = o; }
          for (int i = gt; i < 128 * 32; i += NT) { const int pos = i >> 5, fi = i & 31;
              const double ang = (double)pos * inv_freq_of(fi); const double k = __builtin_rint(ang * 0.15915494309189533577); const double r = ang - k * 6.283185307179586476925;
              const float rf = (float)r; rope[2 * i] = cosf(rf); rope[2 * i + 1] = sinf(rf); }
        }
        norm_pass(F, ap->in[0], nullptr, nullptr, nullptr, ap->in[8], WSP(WS_H), 2);
    }
    SEAM(0);

    for (int l = 0; l < DEPTH; ++l) {
        const int pb = 1 + 11 * l;
        if (IN(pb + 0)) {
            CArgs* ap = fresh_args(); unsigned char* ws = ap->ws; Frame F = make_frame(L, wave_s); unsigned char* wl = ws + WS_W + (size_t)l * LW_BYTES;
            for (int rep = 0; rep < REP_G1; ++rep) { pg8::Gemm g{WSP(WS_H), (const bf16_t*)(wl + LW_IN), S, INW, DM, DM, DM, 0}; pg8::StaticOrder So; So.init(S, INW, F.G, F.bx);
              pg8::EpiZ E{WSP(WS_Q), WSP(WS_K), WSP(WS_V), WSP(WS_U), WSP(WS_GA), WSP(WS_GP)};
              pg8::gemm_phase<pg8::EpiZ, pg8::StaticOrder, G_ALIGN, G_SP2>(F.lds + RING_OFF, g, So, E, F.tid); }
            if (l == 0) {
                for (int l2 = 0; l2 < DEPTH; ++l2) {
                    pg8::Gemm g2{WSP(WS_PB) + (size_t)l2 * S * DPLE, (const bf16_t*)(ws + WS_W + (size_t)l2 * LW_BYTES + LW_PIN), S, DM, DPLE, DPLE, DPLE, 0}; pg8::StaticOrder S2; S2.init(S, DM, F.G, F.bx);
                    pg8::EpiPlain E2{WSP(WS_E) + (size_t)l2 * S * DM, DM};
                    pg8::gemm_phase<pg8::EpiPlain, pg8::StaticOrder, G_ALIGN, G_SP2>(F.lds + RING_OFF, g2, S2, E2, F.tid);
                }
            }
        }
        SEAM(pb + 0);
        if (IN(pb + 1)) {
            CArgs* ap = fresh_args(); unsigned char* ws = ap->ws; Frame F = make_frame(L, wave_s);
            for (int rep = 0; rep < REP_T2; ++rep) {
            qk_norm_rope_pass(F, WSP(WS_Q), WSP(WS_K), WSP(WS_Q2), WSP(WS_K2), ap->in[3] + l * HD, ap->in[4] + l * HD, (const float*)(ws + WS_ROPE));
            pool_delta_pass(F, WSP(WS_U), WSP(WS_DL)); }
        }
        SEAM(pb + 1);
        if (IN(pb + 2)) {
            CArgs* ap = fresh_args(); unsigned char* ws = ap->ws; Frame F = make_frame(L, wave_s);
            bool bounded;
            { const float* qn = ap->in[3] + l * HD; const float* kn = ap->in[4] + l * HD; float gq = fmaxf(fabsf(qn[F.lane]), fabsf(qn[F.lane + 64])), gk = fmaxf(fabsf(kn[F.lane]), fabsf(kn[F.lane + 64]));
#pragma unroll
              for (int o_ = 1; o_ < 64; o_ <<= 1) { gq = fmaxf(gq, shx(gq, o_, F.lane)); gk = fmaxf(gk, shx(gk, o_, F.lane)); }
              bounded = __builtin_amdgcn_readfirstlane((1.4426950408889634f * 11.313708498984761f * 1.02f * gq * gk <= 60.f) ? 1 : 0) != 0; }
            const bool bnd = ATT_BOUND && bounded;
            for (int rep = 0; rep < REP_ATT; ++rep)
            for (int U0 = F.vcu; U0 < NH * (S / 256); U0 += F.G) {
                const int a = U0 >> 8, b = (U0 >> 5) & 7, c = U0 & 31, h = 4 * b + a, qb = c, kvh = h >> 2;
                att::attn_ring_body(WSP(WS_Q2) + (size_t)qb * 256 * DM + h * HD, WSP(WS_K2) + kvh * HD, WSP(WS_V) + kvh * HD, WSP(WS_O) + (size_t)qb * 256 * DM + h * HD, S, (LAS char*)(F.lds + RING_OFF), F.tid, bnd);
            }
        }
        SEAM(pb + 2);
        if (IN(pb + 3)) {
            CArgs* ap = fresh_args(); unsigned char* ws = ap->ws; Frame F = make_frame(L, wave_s); unsigned char* wl = ws + WS_W + (size_t)l * LW_BYTES;
            pg8::Gemm g{WSP(WS_DL), (const bf16_t*)(wl + LW_POOL), S, DM, PGI, POOLW, PGI, PGI}; pg8::StaticOrder So; So.init(S, DM, F.G, F.bx);
            pg8::EpiPool E{WSP(WS_MG), WSP(WS_O), WSP(WS_GA), WSP(WS_GP), ap->in[6] + (size_t)l * DM, DM};
            for (int rep = 0; rep < REP_SMALLG; ++rep)
            pg8::gemm_phase<pg8::EpiPool, pg8::StaticOrder, G_ALIGN, G_SP2>(F.lds + RING_OFF, g, So, E, F.tid);
        }
        SEAM(pb + 3);
        if (IN(pb + 4)) {
            CArgs* ap = fresh_args(); unsigned char* ws = ap->ws; Frame F = make_frame(L, wave_s); unsigned char* wl = ws + WS_W + (size_t)l * LW_BYTES;
            pg8::Gemm g{WSP(WS_MG), (const bf16_t*)(wl + LW_OUT), S, DM, DM, DM, DM, 0}; pg8::StaticOrder So; So.init(S, DM, F.G, F.bx);
            pg8::EpiPlain E{WSP(WS_Y), DM};
            for (int rep = 0; rep < REP_SMALLG; ++rep)
            pg8::gemm_phase<pg8::EpiPlain, pg8::StaticOrder, G_ALIGN, G_SP2>(F.lds + RING_OFF, g, So, E, F.tid);
        }
        SEAM(pb + 4);
        if (IN(pb + 5)) {
            CArgs* ap = fresh_args(); unsigned char* ws = ap->ws; Frame F = make_frame(L, wave_s);
            norm_pass(F, l == 0 ? ap->in[0] : (const float*)ap->out, ap->out, WSP(WS_Y), ap->in[9] + (size_t)l * DM, ap->in[10] + (size_t)l * DM, WSP(WS_H), 2);
        }
        SEAM(pb + 5);
        if (IN(pb + 6)) {
            CArgs* ap = fresh_args(); unsigned char* ws = ap->ws; Frame F = make_frame(L, wave_s); unsigned char* wl = ws + WS_W + (size_t)l * LW_BYTES;
            pg8::Gemm g{WSP(WS_H), (const bf16_t*)(wl + LW_GU), S, 2 * FF, DM, DM, DM, 0}; pg8::StaticOrder So; So.init(S, 2 * FF, F.G, F.bx);
            pg8::EpiSwiglu E{WSP(WS_F), FF};
            for (int rep = 0; rep < REP_G3; ++rep)
            pg8::gemm_phase<pg8::EpiSwiglu, pg8::StaticOrder, G_ALIGN, G_SP2>(F.lds + RING_OFF, g, So, E, F.tid);
        }
        SEAM(pb + 6);
        if (IN(pb + 7)) {
            CArgs* ap = fresh_args(); unsigned char* ws = ap->ws; Frame F = make_frame(L, wave_s); unsigned char* wl = ws + WS_W + (size_t)l * LW_BYTES;
            pg8::Gemm g{WSP(WS_F), (const bf16_t*)(wl + LW_DOWN), S, DM, FF, FF, FF, 0}; pg8::StaticOrder So; So.init(S, DM, F.G, F.bx);
            pg8::EpiPlain E{WSP(WS_Y), DM};
            pg8::gemm_phase<pg8::EpiPlain, pg8::StaticOrder, G_ALIGN, G_SP2>(F.lds + RING_OFF, g, So, E, F.tid);
#if REP_G4 > 1
            pg8::gemm_phase<pg8::EpiPlain, pg8::StaticOrder, G_ALIGN, G_SP2>(F.lds + RING_OFF, g, So, E, F.tid);
#endif
        }
        SEAM(pb + 7);
        if (IN(pb + 8)) {
            CArgs* ap = fresh_args(); unsigned char* ws = ap->ws; Frame F = make_frame(L, wave_s);
            for (int rep = 1; rep < REP_THIN; ++rep) norm_pass(F, ap->out, (float*)(ws + WS_Q), WSP(WS_Y), ap->in[11] + (size_t)l * DM, ap->in[11] + (size_t)l * DM, WSP(WS_Q2), 2);
            norm_pass(F, ap->out, ap->out, WSP(WS_Y), ap->in[11] + (size_t)l * DM, nullptr, WSP(WS_H), 1);
        }
        SEAM(pb + 8);
        if (IN(pb + 9)) {
            CArgs* ap = fresh_args(); unsigned char* ws = ap->ws; Frame F = make_frame(L, wave_s); unsigned char* wl = ws + WS_W + (size_t)l * LW_BYTES;
            pg8::Gemm g{WSP(WS_H), (const bf16_t*)(wl + LW_PG), S, DM, DM, DM, DM, 0}; pg8::StaticOrder So; So.init(S, DM, F.G, F.bx);
            pg8::EpiPle E{WSP(WS_Y), WSP(WS_E) + (size_t)l * S * DM, DM};
            for (int rep = 0; rep < REP_SMALLG; ++rep)
            pg8::gemm_phase<pg8::EpiPle, pg8::StaticOrder, G_ALIGN, G_SP2>(F.lds + RING_OFF, g, So, E, F.tid);
        }
        SEAM(pb + 9);
        if (IN(pb + 10)) {
            CArgs* ap = fresh_args(); unsigned char* ws = ap->ws; Frame F = make_frame(L, wave_s);
            if (l + 1 < DEPTH) norm_pass(F, ap->out, ap->out, WSP(WS_Y), ap->in[17] + (size_t)l * DM, ap->in[8] + (size_t)(l + 1) * DM, WSP(WS_H), 2);
            else norm_pass(F, ap->out, ap->out, WSP(WS_Y), ap->in[17] + (size_t)l * DM, nullptr, nullptr, 0);
        }
        SEAM(pb + 10);
    }
#undef IN
#undef SEAM
#undef GRID_BAR
}

extern "C" void kernel_launch(void* const* d_in, const int* in_sizes, int n_in, void* d_out, int out_size, void* d_ws, size_t ws_size, hipStream_t stream) {
    static int grid = 0;
    if (grid == 0) {
        if (n_in != 18 || in_sizes[0] != S * DM || out_size != S * DM || ws_size < WS_END) { fprintf(stderr, "kernel_launch: shape/workspace mismatch: n_in %d in0 %d out %d ws %zu (need %zu)\n", n_in, n_in > 0 ? in_sizes[0] : -1, out_size, ws_size, (size_t)WS_END); grid = -1; return; }
        int dev = 0, cus = 0, per_cu = 0;
        if (hipGetDevice(&dev) != hipSuccess || hipDeviceGetAttribute(&cus, hipDeviceAttributeMultiprocessorCount, dev) != hipSuccess) { grid = -1; return; }
        if (hipFuncSetAttribute((const void*)fwd_kernel, hipFuncAttributeMaxDynamicSharedMemorySize, LDS_BYTES) != hipSuccess) { fprintf(stderr, "kernel_launch: hipFuncSetAttribute failed\n"); grid = -1; return; }
        if (hipOccupancyMaxActiveBlocksPerMultiprocessor(&per_cu, (const void*)fwd_kernel, NWAVES * 64, LDS_BYTES) != hipSuccess || per_cu < 1) { fprintf(stderr, "kernel_launch: occupancy query says %d blocks per CU\n", per_cu); }
        (void)hipGetLastError();
        grid = cus;
    }
    if (grid < 0) return;
    if (hipMemsetAsync((char*)d_ws + WS_CTL, 0, CTL_ZERO_BYTES, stream) != hipSuccess) return;
    Args a{};
    for (int i = 0; i < 18; ++i) a.in[i] = (const float*)d_in[i];
    a.out = (float*)d_out; a.ws = (unsigned char*)d_ws;
    for (int li = 0; li < N_LAUNCHES; ++li) {
        a.ph_lo = (N_LAUNCHES == 1) ? 0 : li; a.ph_hi = (N_LAUNCHES == 1) ? N_PHASES : li + 1;
        hipLaunchKernelGGL(fwd_kernel, dim3(grid), dim3(NWAVES * 64), LDS_BYTES, stream, a);
        const hipError_t le = hipPeekAtLastError();
        if (le != hipSuccess) { fprintf(stderr, "kernel_launch: launch %d failed: %s\n", li, hipGetErrorName(le)); break; }
    }
}
```

```cpp
#include <hip/hip_runtime.h>
#include <cstdio>
#include <cstdint>

#ifndef MK_N_LAUNCHES
#define MK_N_LAUNCHES 1
#endif

#ifndef G_SP2
#define G_SP2 true
#endif
#ifndef G_ALIGN
#define G_ALIGN true
#endif
#ifndef SKEW_PROBE
#define SKEW_PROBE 0
#endif
#ifndef YP
#define YP 4096
#endif
#ifndef NT_CONV
#define NT_CONV 1
#endif
#ifndef REP_E
#define REP_E 1
#endif
#ifndef JIT_CONV
#define JIT_CONV 1
#endif
#ifndef G_STAG
#define G_STAG 0
#endif
#ifndef ATT_BOUND
#define ATT_BOUND 1
#endif
#ifndef NT_STORE
#define NT_STORE 0
#endif
#ifndef REP_BAR
#define REP_BAR 1
#endif
#ifndef REP_CONV
#define REP_CONV 1
#endif
#ifndef REP_G1
#define REP_G1 1
#endif
#ifndef REP_ATT
#define REP_ATT 1
#endif
#ifndef REP_G3
#define REP_G3 1
#endif
#ifndef G_ROLL
#define G_ROLL 0
#endif
#ifndef ATT_REBAL
#define ATT_REBAL 1
#endif
#ifndef REP_G4
#define REP_G4 1
#endif
#ifndef REP_T2
#define REP_T2 1
#endif
#ifndef REP_THIN
#define REP_THIN 1
#endif
#ifndef REP_SMALLG
#define REP_SMALLG 1
#endif

#define LAS __attribute__((address_space(3)))
#define GAS __attribute__((address_space(1)))
typedef unsigned short bf16_t;
typedef short bf16x8 __attribute__((ext_vector_type(8)));
typedef short s16x4 __attribute__((ext_vector_type(4)));
typedef float f32x4 __attribute__((ext_vector_type(4)));
typedef float f32x2 __attribute__((ext_vector_type(2)));
typedef float f32x16 __attribute__((ext_vector_type(16)));
typedef unsigned u32x4 __attribute__((ext_vector_type(4)));
typedef unsigned u32x2 __attribute__((ext_vector_type(2)));

constexpr int S = 8192, DM = 4096, DEPTH = 2;
constexpr int NH = 32, NKV = 8, HD = 128;
constexpr int KVW = NKV * HD;
constexpr int POOLW = 2048, PGI = 512, PGO = 1024;
constexpr int INW = 16384;
constexpr int FF = 11008;
constexpr int DPLE = 256;
constexpr float EPS = 1e-6f;

__device__ __forceinline__ unsigned cvt_pk_bf16(float lo, float hi) { unsigned r; asm volatile("v_cvt_pk_bf16_f32 %0, %1, %2" : "=v"(r) : "v"(lo), "v"(hi)); return r; }
__device__ __forceinline__ float bf_lo(unsigned w) { return __uint_as_float(w << 16); }
__device__ __forceinline__ float bf_hi(unsigned w) { return __uint_as_float(w & 0xffff0000u); }
__device__ __forceinline__ float sigmoid_f(float v) { return __builtin_amdgcn_rcpf(1.0f + __builtin_amdgcn_exp2f(v * -1.4426950408889634f)); }

namespace pg8 {
constexpr int BM = 256, BK = 64, HALF = 128, HTB = HALF * BK * 2  , STAGE_BYTES = 8 * HTB, NXCD = 8, WGM = 8;

__host__ __device__ __forceinline__ int lds_byte(int r, int c) { const int st = (r >> 4) * 2 + (c >> 5), rr = r & 15, cc = c & 31, ob = rr * 64 + cc * 2; return st * 1024 + (ob ^ (((ob >> 9) & 1) << 5)); }
__host__ __device__ __forceinline__ void stage_rc(int b, int& R, int& C) { const int st = b / 1024, sb = b % 1024, swz = sb ^ (((sb >> 9) & 1) << 5); R = (st >> 1) * 16 + swz / 64; C = (st & 1) * 32 + (swz % 64) / 2; }
__host__ __device__ __forceinline__ int perm32(int rho) { const int n = rho >> 4, i = rho & 15; return 8 * (i >> 2) + 4 * n + (i & 3); }

struct Unit { int pm, pn; };
struct Gemm { const bf16_t* A; const bf16_t* Bt; int M, N, K, lda, ldb, agrp; };

struct StaticOrder {
    int nM, nN, nwg, G, c;
    __host__ __device__ void init(int M, int N, int G_, int c_) { nM = M / BM; nN = N / BM; nwg = nM * nN; G = G_; c = c_; }
    __host__ __device__ bool next(int i, Unit& u) const {
        const long L = (long)i * G + c; if (L >= nwg) return false;
        int wgid = (int)L; { const int q = nwg / NXCD, r = nwg % NXCD, xcd = wgid % NXCD, off = wgid / NXCD; wgid = (xcd < r ? xcd * (q + 1) : r * (q + 1) + (xcd - r) * q) + off; }
        const int nig = WGM * nN, gid = wgid / nig, fm = gid * WGM, gsz = (nM - fm) < WGM ? (nM - fm) : WGM;
        u.pm = fm + ((wgid % nig) % gsz); u.pn = (wgid % nig) / gsz; return true;
    }
    __device__ __forceinline__ void a_ready(const Unit&) const {}
    __device__ __forceinline__ void done(const Unit&) const {}
};

struct PoolOrder {
    int pm, pn0;
    __device__ __forceinline__ bool next(int i, Unit& u) const { if (i >= 2) return false; u.pm = pm; u.pn = pn0 + i; return true; }
    __device__ __forceinline__ void a_ready(const Unit&) const {}
    __device__ __forceinline__ void done(const Unit&) const {}
};
__device__ __forceinline__ u32x4 pack8(const f32x4 v0, const f32x4 v1) { u32x4 w; w.x = cvt_pk_bf16(v0[0], v0[1]); w.y = cvt_pk_bf16(v0[2], v0[3]); w.z = cvt_pk_bf16(v1[0], v1[1]); w.w = cvt_pk_bf16(v1[2], v1[3]); return w; }

__device__ __forceinline__ void st16(bf16_t* p, const u32x4 v) {
#if NT_STORE
    __builtin_nontemporal_store(v, (u32x4*)p);
#else
    *(u32x4*)p = v;
#endif
}
struct EpiPlain {
    static constexpr bool PERM = true, AFTER_DRAIN = false;
    bf16_t* O; int ldc;
    __device__ __forceinline__ void operator()(const f32x4 (&acc)[2][2][4][2], const Unit& u, int wr, int wc, int fr, int fq) const {
        const int row0 = u.pm * BM + wr * 64 + fr, col0 = u.pn * BM + wc * 32 + 8 * fq;
#pragma unroll
        for (int ai = 0; ai < 2; ++ai)
#pragma unroll
            for (int m = 0; m < 4; ++m) { bf16_t* rowp = O + (size_t)(row0 + ai * HALF + m * 16) * ldc + col0;
#pragma unroll
                for (int bj = 0; bj < 2; ++bj) *(u32x4*)(rowp + bj * HALF) = pack8(acc[ai][bj][m][0], acc[ai][bj][m][1]); }
    }
};
struct EpiZ {
    static constexpr bool PERM = true, AFTER_DRAIN = false;
    bf16_t *Q, *Kb, *Vb, *U, *GA, *GP;
    __device__ __forceinline__ void operator()(const f32x4 (&acc)[2][2][4][2], const Unit& u, int wr, int wc, int fr, int fq) const {
        const int pn = u.pn; bf16_t* base; int ldc, ct; bool sg = false;
        if (pn < 16)      { base = Q;  ldc = DM;    ct = pn; }
        else if (pn < 20) { base = Kb; ldc = KVW;   ct = pn - 16; }
        else if (pn < 24) { base = Vb; ldc = KVW;   ct = pn - 20; }
        else if (pn < 32) { base = U;  ldc = POOLW; ct = pn - 24; }
        else if (pn < 48) { base = GA; ldc = DM;    ct = pn - 32; sg = true; }
        else              { base = GP; ldc = DM;    ct = pn - 48; sg = true; }
        const int row0 = u.pm * BM + wr * 64 + fr, col0 = ct * BM + wc * 32 + 8 * fq;
#pragma unroll
        for (int ai = 0; ai < 2; ++ai)
#pragma unroll
            for (int m = 0; m < 4; ++m) { bf16_t* rowp = base + (size_t)(row0 + ai * HALF + m * 16) * ldc + col0;
#pragma unroll
                for (int bj = 0; bj < 2; ++bj) { f32x4 v0 = acc[ai][bj][m][0], v1 = acc[ai][bj][m][1];
                    if (sg) {
                        unsigned w0 = 0u, w1 = 0u;
#pragma unroll
                        for (int j = 0; j < 4; ++j) { w0 = __builtin_amdgcn_cvt_pk_u8_f32(sigmoid_f(v0[j]) * 255.f, j, w0); w1 = __builtin_amdgcn_cvt_pk_u8_f32(sigmoid_f(v1[j]) * 255.f, j, w1); }
                        u32x2 w; w.x = w0; w.y = w1;
                        *(u32x2*)((unsigned char*)base + (size_t)(row0 + ai * HALF + m * 16) * ldc + col0 + bj * HALF) = w;
                    } else st16(rowp + bj * HALF, pack8(v0, v1)); } }
    }
};
struct EpiSwiglu {
    static constexpr bool PERM = true, AFTER_DRAIN = false;
    bf16_t* F; int ldc;
    __device__ __forceinline__ void operator()(const f32x4 (&acc)[2][2][4][2], const Unit& u, int wr, int wc, int fr, int fq) const {
        const int row0 = u.pm * BM + wr * 64 + fr, col0 = u.pn * HALF + wc * 32 + 8 * fq;
#pragma unroll
        for (int ai = 0; ai < 2; ++ai)
#pragma unroll
            for (int m = 0; m < 4; ++m) { bf16_t* rowp = F + (size_t)(row0 + ai * HALF + m * 16) * ldc + col0;
                f32x4 v0, v1;
#pragma unroll
                for (int j = 0; j < 4; ++j) { const float g0 = acc[ai][0][m][0][j], g1 = acc[ai][0][m][1][j];
                    v0[j] = g0 * sigmoid_f(g0) * acc[ai][1][m][0][j]; v1[j] = g1 * sigmoid_f(g1) * acc[ai][1][m][1][j]; }
                *(u32x4*)rowp = pack8(v0, v1); }
    }
};
__device__ __forceinline__ void unpack8(const u32x4 w, f32x4& a, f32x4& b) { a[0] = bf_lo(w.x); a[1] = bf_hi(w.x); a[2] = bf_lo(w.y); a[3] = bf_hi(w.y); b[0] = bf_lo(w.z); b[1] = bf_hi(w.z); b[2] = bf_lo(w.w); b[3] = bf_hi(w.w); }
struct EpiPle {
    static constexpr bool PERM = true, AFTER_DRAIN = false;
    bf16_t* Y; const bf16_t* E; int ldc; int ldy;
    __device__ __forceinline__ void operator()(const f32x4 (&acc)[2][2][4][2], const Unit& u, int wr, int wc, int fr, int fq) const {
        const int row0 = u.pm * BM + wr * 64 + fr, col0 = u.pn * BM + wc * 32 + 8 * fq;
#pragma unroll
        for (int ai = 0; ai < 2; ++ai)
#pragma unroll
            for (int m = 0; m < 4; ++m) { const size_t off = (size_t)(row0 + ai * HALF + m * 16) * ldc + col0, offy = (size_t)(row0 + ai * HALF + m * 16) * ldy + col0;
#pragma unroll
                for (int bj = 0; bj < 2; ++bj) { const u32x4 ew = *(const u32x4*)(E + off + bj * HALF); f32x4 e0, e1; unpack8(ew, e0, e1);
                    f32x4 v0 = acc[ai][bj][m][0], v1 = acc[ai][bj][m][1];
#pragma unroll
                    for (int j = 0; j < 4; ++j) { v0[j] = sigmoid_f(v0[j]) * e0[j]; v1[j] = sigmoid_f(v1[j]) * e1[j]; }
                    *(u32x4*)(Y + offy + bj * HALF) = pack8(v0, v1); }
                asm volatile("" ::: "memory"); }
    }
};
__device__ __forceinline__ void unq8(const u32x2 w, f32x4& a, f32x4& b) { constexpr float q = 1.0f / 255.0f;
    a[0] = (float)(w.x & 0xffu) * q; a[1] = (float)((w.x >> 8) & 0xffu) * q; a[2] = (float)((w.x >> 16) & 0xffu) * q; a[3] = (float)(w.x >> 24) * q;
    b[0] = (float)(w.y & 0xffu) * q; b[1] = (float)((w.y >> 8) & 0xffu) * q; b[2] = (float)((w.y >> 16) & 0xffu) * q; b[3] = (float)(w.y >> 24) * q; }
struct EpiPool {
    static constexpr bool PERM = true, AFTER_DRAIN = false;
    bf16_t* MG; const bf16_t *O, *GA, *GP; const float* ps; int ldc;
    __device__ __forceinline__ void operator()(const f32x4 (&acc)[2][2][4][2], const Unit& u, int wr, int wc, int fr, int fq) const {
        const int row0 = u.pm * BM + wr * 64 + fr, col0 = u.pn * BM + wc * 32 + 8 * fq;
        f32x4 pv[2][2];
#pragma unroll
        for (int bj = 0; bj < 2; ++bj)
#pragma unroll
            for (int n = 0; n < 2; ++n) pv[bj][n] = *(const f32x4*)(ps + col0 + bj * HALF + 4 * n);
#pragma unroll
        for (int ai = 0; ai < 2; ++ai)
#pragma unroll
            for (int m = 0; m < 4; ++m) { const size_t off = (size_t)(row0 + ai * HALF + m * 16) * ldc + col0;
#pragma unroll
                for (int bj = 0; bj < 2; ++bj) {
                    const u32x4 ow = *(const u32x4*)(O + off + bj * HALF); const u32x2 aw = *(const u32x2*)((const unsigned char*)GA + off + bj * HALF), pw = *(const u32x2*)((const unsigned char*)GP + off + bj * HALF);
                    f32x4 o0, o1, a0, a1, p0, p1; unpack8(ow, o0, o1); unq8(aw, a0, a1); unq8(pw, p0, p1);
                    const f32x4 v0 = a0 * o0 + p0 * (acc[ai][bj][m][0] * pv[bj][0]), v1 = a1 * o1 + p1 * (acc[ai][bj][m][1] * pv[bj][1]);
                    *(u32x4*)(MG + off + bj * HALF) = pack8(v0, v1); }
                asm volatile("" ::: "memory"); }
    }
};

template <int OFF> __device__ __forceinline__ bf16x8 rd128(int a) { bf16x8 r; asm volatile("ds_read_b128 %0, %1 offset:%2" : "=v"(r) : "v"(a), "i"(OFF) : "memory"); return r; }
template <class Epi, class Sched, bool ALIGN_EPI = false, bool SP2 = false>
__device__ __forceinline__ void gemm_phase(LAS unsigned char* lds, const Gemm g, const Sched& S, const Epi& E, const int tid_in) {
    int tid_ = tid_in; asm volatile("" : "+v"(tid_));
    const int tid = tid_, wid = __builtin_amdgcn_readfirstlane(tid >> 6), lane = tid & 63, wr = wid >> 2, wc = wid & 3, fr = lane & 15, fq = lane >> 4;
    const int K = g.K, nt = K / BK;
    unsigned voffA[2], voffB[2];
#pragma unroll
    for (int i = 0; i < 2; ++i) { int R, C; stage_rc(tid * 16 + i * 8192, R, C); const int Rb = Epi::PERM ? ((R & ~31) + perm32(R & 31)) : R;
        voffA[i] = (unsigned)(R * g.lda + C) * 2u; voffB[i] = (unsigned)(Rb * g.ldb + C) * 2u; }
    const unsigned kstep = (unsigned)(BK * 2);
    const unsigned hstepA = (unsigned)HALF * g.lda * 2, hstepB = (unsigned)HALF * g.ldb * 2;
    const unsigned tstepA = 2 * hstepA, tstepB = 2 * hstepB;
    const __amdgpu_buffer_rsrc_t rsA = __builtin_amdgcn_make_buffer_rsrc((void*)g.A, 0, 0x7ffffff0, 0x00020000), rsB = __builtin_amdgcn_make_buffer_rsrc((void*)g.Bt, 0, 0x7ffffff0, 0x00020000);
    const unsigned ldsw = (unsigned)wid * 1024u;
    const int aoff = lds_byte(wr * 64 + fr, fq * 8), boff = lds_byte(wc * 32 + fr, fq * 8);
#define PG8_SA(b, h) (((b) * 2 + (h)) * HTB)
#define PG8_SB(b, h) ((4 + (b) * 2 + (h)) * HTB)
#define PG8_RS_voffA rsA
#define PG8_RS_voffB rsB
#define PG8_STAGE(bufoff, gbase, voff) do { _Pragma("unroll") for (int _i = 0; _i < 2; ++_i) \
        __builtin_amdgcn_raw_ptr_buffer_load_lds(PG8_RS_##voff, (LAS unsigned*)(lds + (bufoff) + ldsw + _i * 8192), 16, (voff)[_i], (gbase), 0, 0); } while (0)
#define PG8_LDA(dst, b, h) do { _Pragma("unroll") for (int m = 0; m < 4; ++m) _Pragma("unroll") for (int k = 0; k < 2; ++k) dst[m][k] = *(const LAS bf16x8*)(lds + PG8_SA(b, h) + aoff + m * 2048 + k * 1024); } while (0)
#define PG8_LDB(dst, b, h) do { _Pragma("unroll") for (int n = 0; n < 2; ++n) _Pragma("unroll") for (int k = 0; k < 2; ++k) dst[n][k] = *(const LAS bf16x8*)(lds + PG8_SB(b, h) + boff + n * 2048 + k * 1024); } while (0)
#define PG8_MMA(ai, bj, At, Bt) do { __builtin_amdgcn_s_setprio(1); _Pragma("unroll") for (int m = 0; m < 4; ++m) _Pragma("unroll") for (int n = 0; n < 2; ++n) _Pragma("unroll") for (int k = 0; k < 2; ++k) \
        acc[ai][bj][m][n] = __builtin_amdgcn_mfma_f32_16x16x32_bf16(Bt[n][k], At[m][k], acc[ai][bj][m][n], 0, 0, 0); __builtin_amdgcn_s_setprio(0); } while (0)
#define PG8_MMAm(ai, m) do { _Pragma("unroll") for (int n = 0; n < 2; ++n) _Pragma("unroll") for (int k = 0; k < 2; ++k) acc[ai][0][m][n] = __builtin_amdgcn_mfma_f32_16x16x32_bf16(B0[n][k], At[m][k], acc[ai][0][m][n], 0, 0, 0); \
        _Pragma("unroll") for (int n = 0; n < 2; ++n) _Pragma("unroll") for (int k = 0; k < 2; ++k) acc[ai][1][m][n] = __builtin_amdgcn_mfma_f32_16x16x32_bf16(B1[n][k], At[m][k], acc[ai][1][m][n], 0, 0, 0); } while (0)
#define PG8_RA(b, h, m) do { At[m][0] = rd128<PG8_SA(b, h) + (m) * 2048>(abase); At[m][1] = rd128<PG8_SA(b, h) + (m) * 2048 + 1024>(abase); } while (0)
#define PG8_RB(b) do { B0[0][0] = rd128<(b) * 2 * HTB>(bbase); B0[0][1] = rd128<(b) * 2 * HTB + 1024>(bbase); B0[1][0] = rd128<(b) * 2 * HTB + 2048>(bbase); B0[1][1] = rd128<(b) * 2 * HTB + 3072>(bbase); \
        B1[0][0] = rd128<((b) * 2 + 1) * HTB>(bbase); B1[0][1] = rd128<((b) * 2 + 1) * HTB + 1024>(bbase); B1[1][0] = rd128<((b) * 2 + 1) * HTB + 2048>(bbase); B1[1][1] = rd128<((b) * 2 + 1) * HTB + 3072>(bbase); } while (0)
#define PG8_SPY(ai, STAGES, CK, nb, nh, RBX) do { STAGES; PG8_WAIT_V(8); PG8_WAIT_L(0); PG8_BAR; PG8_SCHED; __builtin_amdgcn_s_setprio(1); \
        PG8_MMAm(ai, 0); PG8_SCHED; PG8_RA(nb, nh, 0); PG8_SCHED; PG8_MMAm(ai, 1); PG8_SCHED; PG8_RA(nb, nh, 1); PG8_SCHED; \
        PG8_MMAm(ai, 2); PG8_SCHED; PG8_RA(nb, nh, 2); PG8_SCHED; PG8_MMAm(ai, 3); PG8_SCHED; RBX; PG8_RA(nb, nh, 3); __builtin_amdgcn_s_setprio(0); \
        PG8_WAIT_V(CK); PG8_BAR; PG8_SCHED; } while (0)
#define PG8_SPY_LAST(ai, STAGES, CK) do { STAGES; PG8_WAIT_V(8); PG8_WAIT_L(0); PG8_BAR; PG8_SCHED; __builtin_amdgcn_s_setprio(1); \
        PG8_MMAm(ai, 0); PG8_MMAm(ai, 1); PG8_MMAm(ai, 2); PG8_MMAm(ai, 3); __builtin_amdgcn_s_setprio(0); \
        PG8_WAIT_V(CK); PG8_BAR; PG8_SCHED; } while (0)
#define PG8_WAIT_V(n) asm volatile("s_waitcnt vmcnt(" #n ")" ::: "memory")
#define PG8_WAIT_L(n) asm volatile("s_waitcnt lgkmcnt(" #n ")" ::: "memory")
#define PG8_BAR __builtin_amdgcn_s_barrier()
#define PG8_SCHED __builtin_amdgcn_sched_barrier(0)
    Unit cur, nxt; int ui = 0;
    if (!S.next(0, cur)) return;
    if (G_STAG > 0) { const unsigned long long t0_ = __builtin_amdgcn_s_memrealtime(); const unsigned long long d_ = (unsigned long long)((tid_in & 0) * G_STAG);
        while (__builtin_amdgcn_s_memrealtime() - t0_ < d_) __builtin_amdgcn_s_sleep(4); }
    f32x4 acc[2][2][4][2];
#pragma unroll
    for (int a = 0; a < 2; ++a)
#pragma unroll
        for (int b = 0; b < 2; ++b)
#pragma unroll
            for (int m = 0; m < 4; ++m)
#pragma unroll
                for (int n = 0; n < 2; ++n) acc[a][b][m][n] = (f32x4){0.f, 0.f, 0.f, 0.f};
    bf16x8 At[4][2], B0[2][2], B1[2][2];
    unsigned cA = (unsigned)cur.pm * tstepA + (unsigned)(cur.pn >> 2) * g.agrp * 2, cB = (unsigned)cur.pn * tstepB;
    S.a_ready(cur);
    const int abase = (int)(unsigned)(uintptr_t)lds + aoff, bbase = (int)(unsigned)(uintptr_t)lds + 4 * HTB + boff;
    if constexpr (SP2) {
        PG8_STAGE(PG8_SB(0, 0), cB, voffB); PG8_STAGE(PG8_SB(0, 1), cB + hstepB, voffB); PG8_STAGE(PG8_SA(0, 0), cA, voffA); PG8_STAGE(PG8_SA(0, 1), cA + hstepA, voffA);
        if (wr == 1) PG8_BAR;
        PG8_WAIT_V(2); PG8_BAR;
        PG8_STAGE(PG8_SB(1, 0), cB + kstep, voffB); PG8_STAGE(PG8_SA(1, 0), cA + kstep, voffA); PG8_STAGE(PG8_SB(1, 1), cB + hstepB + kstep, voffB);
        PG8_WAIT_V(6); PG8_BAR;
    } else {
        PG8_STAGE(PG8_SB(0, 0), cB, voffB); PG8_STAGE(PG8_SA(0, 0), cA, voffA); PG8_STAGE(PG8_SB(0, 1), cB + hstepB, voffB); PG8_STAGE(PG8_SA(0, 1), cA + hstepA, voffA);
        if (wr == 1) PG8_BAR;
        PG8_WAIT_V(4); PG8_BAR;
        PG8_STAGE(PG8_SB(1, 0), cB + kstep, voffB); PG8_STAGE(PG8_SA(1, 0), cA + kstep, voffA); PG8_STAGE(PG8_SB(1, 1), cB + hstepB + kstep, voffB);
        PG8_WAIT_V(6); PG8_BAR;
    }
    for (;;) {
        const bool has_next = S.next(ui + 1, nxt);
        const unsigned nA = has_next ? (unsigned)nxt.pm * tstepA + (unsigned)(nxt.pn >> 2) * g.agrp * 2 : cA, nB = has_next ? (unsigned)nxt.pn * tstepB : cB;
        if constexpr (SP2 && G_ROLL) {
#define PG8_ROLLBODY(FRONT, SP4X) do { \
            PG8_SPY(0, FRONT; PG8_STAGE(PG8_SA(1, 1), a1 + hstepA, voffA), 2, 0, 1, (void)0); \
            PG8_SPY(1, PG8_STAGE(PG8_SB(0, 0), b2, voffB); PG8_STAGE(PG8_SB(0, 1), b2 + hstepB, voffB); PG8_STAGE(PG8_SA(0, 0), a2, voffA), 6, 1, 0, PG8_RB(1)); \
            PG8_SPY(0, PG8_STAGE(PG8_SA(0, 1), a2 + hstepA, voffA), 2, 1, 1, (void)0); \
            SP4X; } while (0)
#define PG8_ST4 PG8_STAGE(PG8_SB(1, 0), b3, voffB); PG8_STAGE(PG8_SB(1, 1), b3 + hstepB, voffB); PG8_STAGE(PG8_SA(1, 0), a3, voffA)
#define PG8_FRONT PG8_RB(0); PG8_RA(0, 0, 0); PG8_RA(0, 0, 1); PG8_RA(0, 0, 2); PG8_RA(0, 0, 3)
            PG8_FRONT;
            for (int t = 0; t < nt - 2; t += 2) {
                const unsigned a1 = cA + (unsigned)(t + 1) * kstep, a2 = cA + (unsigned)(t + 2) * kstep, b2 = cB + (unsigned)(t + 2) * kstep, a3 = a2 + kstep, b3 = b2 + kstep;
                PG8_ROLLBODY((void)0, PG8_SPY(1, PG8_ST4, 6, 0, 0, PG8_RB(0)));
            }
            { const unsigned a1 = cA + (unsigned)(nt - 1) * kstep, a2 = nA, b2 = nB, a3 = a2 + kstep, b3 = b2 + kstep;
              if (has_next) S.a_ready(nxt);
              PG8_ROLLBODY((void)0, PG8_SPY_LAST(1, PG8_ST4, 6)); }
#undef PG8_ST4
#undef PG8_FRONT
#undef PG8_ROLLBODY
        } else
        for (int t = 0; t < nt; t += 2) {
            const bool last = (t == nt - 2);
            const unsigned a1 = cA + (unsigned)(t + 1) * kstep;
            const unsigned a2 = last ? nA : cA + (unsigned)(t + 2) * kstep, b2 = last ? nB : cB + (unsigned)(t + 2) * kstep;
            const unsigned a3 = a2 + kstep, b3 = b2 + kstep;
            if (last && has_next) S.a_ready(nxt);
            if constexpr (SP2) {
            PG8_LDB(B0, 0, 0); PG8_LDB(B1, 0, 1); PG8_SCHED; PG8_LDA(At, 0, 0); PG8_STAGE(PG8_SA(1, 1), a1 + hstepA, voffA);
            PG8_WAIT_V(8); PG8_WAIT_L(0); PG8_BAR; PG8_MMA(0, 0, At, B0); PG8_MMA(0, 1, At, B1); PG8_BAR; PG8_SCHED;
            PG8_LDA(At, 0, 1); PG8_STAGE(PG8_SB(0, 0), b2, voffB); PG8_STAGE(PG8_SB(0, 1), b2 + hstepB, voffB); PG8_STAGE(PG8_SA(0, 0), a2, voffA);
            PG8_WAIT_V(8); PG8_WAIT_L(0); PG8_BAR; PG8_MMA(1, 0, At, B0); PG8_MMA(1, 1, At, B1); PG8_BAR; PG8_SCHED;
            PG8_LDB(B0, 1, 0); PG8_LDB(B1, 1, 1); PG8_SCHED; PG8_LDA(At, 1, 0); PG8_STAGE(PG8_SA(0, 1), a2 + hstepA, voffA);
            PG8_WAIT_V(8); PG8_WAIT_L(0); PG8_BAR; PG8_MMA(0, 0, At, B0); PG8_MMA(0, 1, At, B1); PG8_BAR; PG8_SCHED;
            PG8_LDA(At, 1, 1); PG8_STAGE(PG8_SB(1, 0), b3, voffB); PG8_STAGE(PG8_SB(1, 1), b3 + hstepB, voffB); PG8_STAGE(PG8_SA(1, 0), a3, voffA);
            PG8_WAIT_V(8); PG8_WAIT_L(0); PG8_BAR; PG8_MMA(1, 0, At, B0); PG8_MMA(1, 1, At, B1); PG8_BAR; PG8_SCHED;
            } else {
            PG8_LDB(B0, 0, 0); PG8_SCHED; PG8_LDA(At, 0, 0); PG8_STAGE(PG8_SA(1, 1), a1 + hstepA, voffA);
            PG8_WAIT_L(8); PG8_BAR; PG8_WAIT_L(0); PG8_MMA(0, 0, At, B0); PG8_BAR; PG8_SCHED;
            PG8_LDB(B1, 0, 1); PG8_STAGE(PG8_SB(0, 0), b2, voffB);
            PG8_BAR; PG8_WAIT_L(0); PG8_MMA(0, 1, At, B1); PG8_BAR;
            PG8_LDA(At, 0, 1); PG8_STAGE(PG8_SA(0, 0), a2, voffA);
            PG8_BAR; PG8_WAIT_L(0); PG8_MMA(1, 0, At, B0); PG8_BAR; PG8_SCHED;
            PG8_STAGE(PG8_SB(0, 1), b2 + hstepB, voffB);
            PG8_WAIT_V(6); PG8_BAR; PG8_MMA(1, 1, At, B1); PG8_BAR;
            PG8_LDB(B0, 1, 0); PG8_SCHED; PG8_LDA(At, 1, 0); PG8_STAGE(PG8_SA(0, 1), a2 + hstepA, voffA);
            PG8_WAIT_L(8); PG8_BAR; PG8_WAIT_L(0); PG8_MMA(0, 0, At, B0); PG8_BAR; PG8_SCHED;
            PG8_LDB(B1, 1, 1); PG8_STAGE(PG8_SB(1, 0), b3, voffB);
            PG8_BAR; PG8_WAIT_L(0); PG8_MMA(0, 1, At, B1); PG8_BAR;
            PG8_LDA(At, 1, 1); PG8_STAGE(PG8_SA(1, 0), a3, voffA);
            PG8_BAR; PG8_WAIT_L(0); PG8_MMA(1, 0, At, B0); PG8_BAR; PG8_SCHED;
            PG8_STAGE(PG8_SB(1, 1), b3 + hstepB, voffB);
            PG8_WAIT_V(6); PG8_BAR; PG8_MMA(1, 1, At, B1); PG8_BAR;
            }
        }
        if constexpr (ALIGN_EPI) { if (wr == 0) PG8_BAR; }
        { int le_; asm volatile("v_mbcnt_lo_u32_b32 %0, -1, 0\n\tv_mbcnt_hi_u32_b32 %0, -1, %0" : "=v"(le_));
          E(acc, cur, wr, wc, le_ & 15, le_ >> 4); } S.done(cur);
        if (!has_next) break;
#pragma unroll
        for (int a = 0; a < 2; ++a)
#pragma unroll
            for (int b = 0; b < 2; ++b)
#pragma unroll
                for (int m = 0; m < 4; ++m)
#pragma unroll
                    for (int n = 0; n < 2; ++n) acc[a][b][m][n] = (f32x4){0.f, 0.f, 0.f, 0.f};
        cur = nxt; cA = nA; cB = nB; ++ui;
        if constexpr (ALIGN_EPI) { if (wr == 1) PG8_BAR; }
    }
    PG8_WAIT_V(0);
    if constexpr (!ALIGN_EPI) { if (wr == 0) PG8_BAR; }
    PG8_BAR;
#undef PG8_SA
#undef PG8_SB
#undef PG8_STAGE
#undef PG8_RS_voffA
#undef PG8_RS_voffB
#undef PG8_LDA
#undef PG8_LDB
#undef PG8_MMA
#undef PG8_MMAm
#undef PG8_RA
#undef PG8_RB
#undef PG8_SPY
#undef PG8_SPY_LAST
#undef PG8_WAIT_V
#undef PG8_WAIT_L
#undef PG8_BAR
#undef PG8_SCHED
}
}

namespace att {
constexpr int D = 128, NW = 8, QBLK = 32, KVBLK = 64;
constexpr float SCALE = 0.088388347648318440f;
constexpr int LDQ = DM, LDK = KVW, LDO = DM;
constexpr int SHM_V = KVBLK * D * 2, SHM_K = KVBLK * D * 2, SHM_ATTN = 2 * SHM_V + 2 * SHM_K + NW * 64 * 4;
#define KSWZ(row, colB) ((row) * 256 + ((colB) ^ (((row) & 7) << 4)))
#define SBAR() __builtin_amdgcn_sched_barrier(0)
__device__ __forceinline__ int crow(int r, int hi) { return (r & 3) + 8 * (r >> 2) + 4 * hi; }
__device__ __forceinline__ unsigned cvtpk(float lo, float hi) { unsigned r; asm volatile("v_cvt_pk_bf16_f32 %0, %1, %2" : "=v"(r) : "v"(lo), "v"(hi)); return r; }

constexpr float THRL = 8.f;
#define MX3(a, b, c) __builtin_fmaxf(__builtin_fmaxf((a), (b)), (c))
template <bool FIRST>
__device__ __forceinline__ bool partialSM(f32x16& p0, f32x16& p1, float& mhat, f32x16& negm, float& l_reg, LAS float* al_l, int r32, int hi) {
  float a = MX3(p0[0], p0[1], p1[0]), b = MX3(p0[2], p0[3], p1[1]); a = MX3(a, p1[2], p1[3]);
#pragma unroll
  for (int r = 4; r < 16; r += 4) { a = MX3(a, p0[r], p0[r + 1]); b = MX3(b, p0[r + 2], p0[r + 3]); a = MX3(a, p1[r], p1[r + 1]); b = MX3(b, p1[r + 2], p1[r + 3]); }
  float rm = __builtin_fmaxf(a, b);
  { auto rr = __builtin_amdgcn_permlane32_swap(__float_as_uint(rm), __float_as_uint(rm), false, false);
    rm = __builtin_fmaxf(__uint_as_float(rr[0]), __uint_as_float(rr[1])); }
  bool resc = false;
  if (FIRST) { const float dl = rm; mhat = dl;
#pragma unroll
    for (int r = 0; r < 16; ++r) { p0[r] -= dl; p1[r] -= dl; }
#pragma unroll
    for (int r = 0; r < 16; ++r) negm[r] = -mhat;
    asm volatile("" : "+v"(negm));
  } else if (__builtin_expect(__any(rm > THRL), 0)) { const float dl = __builtin_fmaxf(rm, 0.f); mhat += dl;
#pragma unroll
    for (int r = 0; r < 16; ++r) { p0[r] -= dl; p1[r] -= dl; }
#pragma unroll
    for (int r = 0; r < 16; ++r) negm[r] = -mhat;
    asm volatile("" : "+v"(negm));
    const float f = __builtin_amdgcn_exp2f(-dl); l_reg *= f; if (hi == 0) al_l[r32] = f; resc = true; }
#pragma unroll
  for (int r = 0; r < 16; ++r) p0[r] = __builtin_amdgcn_exp2f(p0[r]);
  return resc;
}
#undef MX3
template <int R0 = 0>
__device__ __forceinline__ void finishSM(f32x16& p0, f32x16& p1, float& l_reg, bf16x8& pa0, bf16x8& pa1, bf16x8& pa2, bf16x8& pa3) {
#pragma unroll
  for (int r = R0; r < 16; ++r) p1[r] = __builtin_amdgcn_exp2f(p1[r]);
  float ps = 0;
#pragma unroll
  for (int r = 0; r < 16; ++r) ps += p0[r];
#pragma unroll
  for (int r = 0; r < 16; ++r) ps += p1[r];
  l_reg += ps;
#define PK4(P, BASE, OUT) do { unsigned a0 = cvtpk(P[BASE + 0], P[BASE + 1]), a1 = cvtpk(P[BASE + 2], P[BASE + 3]);   \
    unsigned b0 = cvtpk(P[BASE + 4], P[BASE + 5]), b1 = cvtpk(P[BASE + 6], P[BASE + 7]);                              \
    auto r0 = __builtin_amdgcn_permlane32_swap(a0, b0, false, false); auto r1 = __builtin_amdgcn_permlane32_swap(a1, b1, false, false); \
    u32x4 w = {r0[0], r1[0], r0[1], r1[1]}; OUT = *reinterpret_cast<bf16x8*>(&w); } while (0)
  PK4(p0, 0, pa0); PK4(p0, 8, pa1); PK4(p1, 0, pa2); PK4(p1, 8, pa3);
#undef PK4
}
__device__ __forceinline__ void qkt(f32x16& p0, f32x16& p1, const LAS char* Ks, const bf16x8* qr, const f32x16& negm, int r32, int hi) {
#pragma unroll
  for (int d0 = 0; d0 < 8; ++d0) { int cb = (d0 * 16 + hi * 8) * 2;
    bf16x8 b0 = *reinterpret_cast<const LAS bf16x8*>(Ks + KSWZ(r32, cb));
    bf16x8 b1 = *reinterpret_cast<const LAS bf16x8*>(Ks + KSWZ(32 + r32, cb));
    if (d0 == 0) { p0 = __builtin_amdgcn_mfma_f32_32x32x16_bf16(b0, qr[0], negm, 0, 0, 0); p1 = __builtin_amdgcn_mfma_f32_32x32x16_bf16(b1, qr[0], negm, 0, 0, 0); }
    else { p0 = __builtin_amdgcn_mfma_f32_32x32x16_bf16(b0, qr[d0], p0, 0, 0, 0); p1 = __builtin_amdgcn_mfma_f32_32x32x16_bf16(b1, qr[d0], p1, 0, 0, 0); } }
}
__device__ __forceinline__ int v_st(int k, int c) { const int kk = (k & ~0xC) | ((k & 4) << 1) | ((k & 8) >> 1); return ((kk >> 3) * 4 + (c >> 5)) * 512 + ((kk & 7) * 32 + (c & 31)) * 2; }
__device__ __forceinline__ int v_rd_base(int lane) { return ((lane & 3) << 3) | (((lane >> 2) & 3) << 6) | (((lane >> 4) & 1) << 5) | (((lane >> 5) & 1) << 8); }
constexpr int v_rd_off(int d0, int ks, int half) { return d0 * 512 + ks * 4096 + half * 2048; }
template <int OFF> __device__ __forceinline__ s16x4 tr_read(int vb) {
  s16x4 r; asm volatile("ds_read_b64_tr_b16 %0, %1 offset:%2" : "=&v"(r) : "v"(vb), "i"(OFF) : "memory"); return r;
}
template <int D0> __device__ __forceinline__ void pv_one(f32x16& od, int vb, bf16x8 pa0, bf16x8 pa1, bf16x8 pa2, bf16x8 pa3) {
  const s16x4 l0 = tr_read<v_rd_off(D0, 0, 0)>(vb), h0 = tr_read<v_rd_off(D0, 0, 1)>(vb), l1 = tr_read<v_rd_off(D0, 1, 0)>(vb), h1 = tr_read<v_rd_off(D0, 1, 1)>(vb);
  const s16x4 l2 = tr_read<v_rd_off(D0, 2, 0)>(vb), h2 = tr_read<v_rd_off(D0, 2, 1)>(vb), l3 = tr_read<v_rd_off(D0, 3, 0)>(vb), h3 = tr_read<v_rd_off(D0, 3, 1)>(vb);
  asm volatile("s_waitcnt lgkmcnt(0)" ::: "memory"); SBAR();
#define PK(L, H) (bf16x8){L[0], L[1], L[2], L[3], H[0], H[1], H[2], H[3]}
  od = __builtin_amdgcn_mfma_f32_32x32x16_bf16(pa0, PK(l0, h0), od, 0, 0, 0);
  od = __builtin_amdgcn_mfma_f32_32x32x16_bf16(pa1, PK(l1, h1), od, 0, 0, 0);
  od = __builtin_amdgcn_mfma_f32_32x32x16_bf16(pa2, PK(l2, h2), od, 0, 0, 0);
  od = __builtin_amdgcn_mfma_f32_32x32x16_bf16(pa3, PK(l3, h3), od, 0, 0, 0);
#undef PK
}
__device__ __forceinline__ void pv_d0(f32x16* o, int vb, bf16x8 pa0, bf16x8 pa1, bf16x8 pa2, bf16x8 pa3) {
  pv_one<0>(o[0], vb, pa0, pa1, pa2, pa3); pv_one<1>(o[1], vb, pa0, pa1, pa2, pa3); pv_one<2>(o[2], vb, pa0, pa1, pa2, pa3); pv_one<3>(o[3], vb, pa0, pa1, pa2, pa3);
}
__device__ __forceinline__ void attn_dense_body(const bf16_t* __restrict__ Qb, const bf16_t* __restrict__ Kh, const bf16_t* __restrict__ Vh, bf16_t* __restrict__ Ob, int seq, LAS char* lds, const int tid_in) {
  int tid_ = tid_in; asm volatile("" : "+v"(tid_));
  const int tid = tid_, wid = tid >> 6, lane = tid & 63, r32 = lane & 31, hi = lane >> 5;
  LAS char* V_lds = lds; LAS char* K_lds = lds + 2 * SHM_V;
  LAS float* ws = (LAS float*)(lds + 2 * SHM_V + 2 * SHM_K) + wid * 64; LAS float* li_l = ws; LAS float* al_l = ws + 32;
  float mhat = 0.f, l_reg = 0; f32x16 o[4] = {}; bf16x8 qr[8]; f32x16 negm = f32x16{}; asm volatile("" : "+v"(negm));
  const bf16_t* Qw = Qb + (long)(wid * QBLK + r32) * LDQ + hi * 8;
#pragma unroll
  for (int d0 = 0; d0 < 8; ++d0) qr[d0] = *reinterpret_cast<const bf16x8*>(Qw + d0 * 16);
  const int sr = tid >> 4, sc = (tid & 15) * 8, vst0 = v_st(sr, sc), vst1 = v_st(32 + sr, sc);
  const int vb0 = (int)(unsigned)(uintptr_t)V_lds + v_rd_base(lane);
  struct { bf16x8 vs0, vs1, ks0, ks1; } sr_[1];
#define SLOAD(i, k0) do { sr_[i].vs0 = *reinterpret_cast<const bf16x8*>(&Vh[(long)((k0) + sr) * LDK + sc]); sr_[i].vs1 = *reinterpret_cast<const bf16x8*>(&Vh[(long)((k0) + 32 + sr) * LDK + sc]); \
    sr_[i].ks0 = *reinterpret_cast<const bf16x8*>(&Kh[(long)((k0) + sr) * LDK + sc]); sr_[i].ks1 = *reinterpret_cast<const bf16x8*>(&Kh[(long)((k0) + 32 + sr) * LDK + sc]); } while (0)
#define SWRITE(b, i) do { *(LAS bf16x8*)(V_lds + (b) * SHM_V + vst0) = sr_[i].vs0;          \
    *(LAS bf16x8*)(V_lds + (b) * SHM_V + vst1) = sr_[i].vs1; int kc = sc * 2;               \
    *(LAS bf16x8*)(K_lds + (b) * SHM_K + KSWZ(sr, kc)) = sr_[i].ks0;                       \
    *(LAS bf16x8*)(K_lds + (b) * SHM_K + KSWZ(32 + sr, kc)) = sr_[i].ks1; } while (0)
#define SWAIT() asm volatile("s_waitcnt vmcnt(0)" ::: "memory")
#define RESC(fl) do { if (fl) { asm volatile("s_waitcnt lgkmcnt(0)" ::: "memory"); \
    _Pragma("unroll") for (int d = 0; d < 4; ++d) _Pragma("unroll") for (int r = 0; r < 16; ++r) o[d][r] *= al_l[crow(r, hi)]; } } while (0)
  f32x16 pA0, pA1, pB0, pB1; bool rsA, rsB; bf16x8 pa0, pa1, pa2, pa3; const int NT = seq / KVBLK;
  constexpr int SE = 0, SO = 0;
  SLOAD(SE, 0); asm volatile("s_waitcnt vmcnt(0)" ::: "memory"); SWRITE(0, SE); __syncthreads();
  qkt(pA0, pA1, K_lds, qr, negm, r32, hi); (void)partialSM<true>(pA0, pA1, mhat, negm, l_reg, al_l, r32, hi);
  SLOAD(SO, KVBLK);
  SWAIT(); SWRITE(1, SO); __syncthreads();
  for (int j = 1; j + 1 < NT; j += 2) {
    SBAR(); qkt(pB0, pB1, K_lds + SHM_K, qr, negm, r32, hi);
    finishSM(pA0, pA1, l_reg, pa0, pa1, pa2, pa3); SBAR();
    SLOAD(SO, (j + 1) * KVBLK); SBAR();
    pv_d0(o, vb0, pa0, pa1, pa2, pa3); rsB = partialSM<false>(pB0, pB1, mhat, negm, l_reg, al_l, r32, hi);
    __syncthreads(); SWAIT(); SWRITE(0, SE);
    RESC(rsB); __syncthreads();
    SBAR(); qkt(pA0, pA1, K_lds, qr, negm, r32, hi);
    finishSM(pB0, pB1, l_reg, pa0, pa1, pa2, pa3); SBAR();
    SLOAD(SE, (j + 2) * KVBLK); SBAR();
    pv_d0(o, vb0 + SHM_V, pa0, pa1, pa2, pa3); rsA = partialSM<false>(pA0, pA1, mhat, negm, l_reg, al_l, r32, hi);
    __syncthreads(); SWAIT(); SWRITE(1, SO);
    RESC(rsA); __syncthreads();
  }
  SBAR(); qkt(pB0, pB1, K_lds + SHM_K, qr, negm, r32, hi);
  finishSM(pA0, pA1, l_reg, pa0, pa1, pa2, pa3); SBAR();
  pv_d0(o, vb0, pa0, pa1, pa2, pa3); rsB = partialSM<false>(pB0, pB1, mhat, negm, l_reg, al_l, r32, hi);
  __syncthreads(); RESC(rsB);
  finishSM(pB0, pB1, l_reg, pa0, pa1, pa2, pa3); SBAR();
  pv_d0(o, vb0 + SHM_V, pa0, pa1, pa2, pa3);
  { auto rr = __builtin_amdgcn_permlane32_swap(__float_as_uint(l_reg), __float_as_uint(l_reg), false, false); l_reg = __uint_as_float(rr[0]) + __uint_as_float(rr[1]); }
  if (hi == 0) li_l[r32] = l_reg; asm volatile("s_waitcnt lgkmcnt(0)" ::: "memory");
  float rli[16];
#pragma unroll
  for (int r = 0; r < 16; ++r) rli[r] = __builtin_amdgcn_rcpf(li_l[crow(r, hi)]);
  bf16_t* Ow = Ob + (long)(wid * QBLK) * LDO;
#pragma unroll
  for (int r = 0; r < 16; ++r) { const int orow = crow(r, hi);
#pragma unroll
    for (int d0 = 0; d0 < 4; ++d0) { const unsigned w = cvtpk(o[d0][r] * rli[r], 0.f); Ow[(long)orow * LDO + d0 * 32 + r32] = (bf16_t)(w & 0xffffu); } }
#undef SLOAD
#undef SWRITE
#undef SWAIT
#undef RESC
}

template <int OFF> __device__ __forceinline__ bf16x8 lds_rd128(int a) { bf16x8 r; asm volatile("ds_read_b128 %0, %1 offset:%2" : "=&v"(r) : "v"(a), "i"(OFF) : "memory"); return r; }
#define MX3(a, b, c) __builtin_fmaxf(__builtin_fmaxf((a), (b)), (c))
__device__ __forceinline__ bool partialSM_head(f32x16& p0, f32x16& p1, float& mhat, f32x16& negm, float& l_reg, LAS float* al_l, int r32, int hi) {
  float a = MX3(p0[0], p0[1], p1[0]), b = MX3(p0[2], p0[3], p1[1]); a = MX3(a, p1[2], p1[3]);
#pragma unroll
  for (int r = 4; r < 16; r += 4) { a = MX3(a, p0[r], p0[r + 1]); b = MX3(b, p0[r + 2], p0[r + 3]); a = MX3(a, p1[r], p1[r + 1]); b = MX3(b, p1[r + 2], p1[r + 3]); }
  float rm = __builtin_fmaxf(a, b);
  { auto rr = __builtin_amdgcn_permlane32_swap(__float_as_uint(rm), __float_as_uint(rm), false, false);
    rm = __builtin_fmaxf(__uint_as_float(rr[0]), __uint_as_float(rr[1])); }
  bool resc = false;
  if (__builtin_expect(__any(rm > THRL), 0)) { const float dl = __builtin_fmaxf(rm, 0.f); mhat += dl;
#pragma unroll
    for (int r = 0; r < 16; ++r) { p0[r] -= dl; p1[r] -= dl; }
#pragma unroll
    for (int r = 0; r < 16; ++r) negm[r] = -mhat;
    asm volatile("" : "+v"(negm));
    const float f = __builtin_amdgcn_exp2f(-dl); l_reg *= f; if (hi == 0) al_l[r32] = f; resc = true; }
  return resc;
}
#undef MX3
constexpr int RSLOT = 16384, RING_ATTN = 6 * RSLOT + NW * 64 * 4;
__device__ __forceinline__ void attn_ring_body(const bf16_t* __restrict__ Qb, const bf16_t* __restrict__ Kh, const bf16_t* __restrict__ Vh, bf16_t* __restrict__ Ob, int seq, LAS char* lds, const int tid_in, const bool BND, const int row0, const float* __restrict__ qgain, const float* __restrict__ rope, const int nU) {
  int cur = 0, nxt = RSLOT, nn = 2 * RSLOT;
  for (int u = 0; u < nU; ++u, Qb += D, Ob += D) {
  int tid_ = tid_in; asm volatile("" : "+v"(tid_));
  const int tid = tid_, wid = __builtin_amdgcn_readfirstlane(tid >> 6), lane = tid & 63, r32 = lane & 31, hi = lane >> 5;
  LAS char* K_lds = lds; LAS char* V_lds = lds + 3 * RSLOT;
  LAS float* ws = (LAS float*)(lds + 6 * RSLOT) + wid * 64; LAS float* li_l = ws; LAS float* al_l = ws + 32;
  int koff[2], voff[2];
#pragma unroll
  for (int e = 0; e < 2; ++e) { const int i = 2 * wid + e;
    const int krow = 4 * i + (lane >> 4), cp = lane & 15, kc = cp ^ (krow & 7); koff[e] = (krow * LDK + 8 * kc) * 2;
    const int sub = 2 * i + (lane >> 5), q = lane & 31, kk = (sub >> 2) * 8 + (q >> 2), c = (sub & 3) * 32 + (q & 3) * 8, k = (kk & ~0xC) | ((kk & 4) << 1) | ((kk & 8) >> 1); voff[e] = (k * LDK + c) * 2; }
  const unsigned pdst = (unsigned)(2 * wid) * 1024u;
  const __amdgpu_buffer_rsrc_t krs = __builtin_amdgcn_make_buffer_rsrc((void*)Kh, 0, S * LDK * 2, 0x00020000), vrs = __builtin_amdgcn_make_buffer_rsrc((void*)Vh, 0, S * LDK * 2, 0x00020000);
#define DMA_K(t, slot) do { _Pragma("unroll") for (int e = 0; e < 2; ++e) __builtin_amdgcn_raw_ptr_buffer_load_lds(krs, (LAS unsigned*)(K_lds + (slot) + pdst + e * 1024), 16, koff[e], (t) * (KVBLK * LDK * 2), 0, 0); } while (0)
#define DMA_V(t, slot) do { _Pragma("unroll") for (int e = 0; e < 2; ++e) __builtin_amdgcn_raw_ptr_buffer_load_lds(vrs, (LAS unsigned*)(V_lds + (slot) + pdst + e * 1024), 16, voff[e], (t) * (KVBLK * LDK * 2), 0, 0); } while (0)
#define WAIT_BAR(N) asm volatile("s_waitcnt vmcnt(" #N ") lgkmcnt(0)\n\ts_barrier" ::: "memory")
  const int NT = seq / KVBLK;
#define ROT() do { const int t_ = cur; cur = nxt; nxt = nn; nn = t_; } while (0)
  const float* qgain_u = qgain; const float* rope_u = rope; int row0_u = row0; asm volatile("" : "+s"(qgain_u), "+s"(rope_u), "+s"(row0_u));
  if (u == 0) { DMA_K(0, 0); DMA_V(0, 0); DMA_K(1, RSLOT); }
  float mhat = 0.f, l_reg = 0; f32x16 o[4] = {}; bf16x8 qr[8]; f32x16 negm = f32x16{};
  asm volatile("" : "+v"(negm));
  { const bf16_t* Qw = Qb + (long)(wid * QBLK + r32) * LDQ + hi * 8;
    u32x4 raw[8];
#pragma unroll
    for (int d0 = 0; d0 < 8; ++d0) raw[d0] = *reinterpret_cast<const u32x4*>(Qw + d0 * 16);
    float x[8][8]; float ss = 0.f;
#pragma unroll
    for (int d0 = 0; d0 < 8; ++d0) { x[d0][0] = bf_lo(raw[d0].x); x[d0][1] = bf_hi(raw[d0].x); x[d0][2] = bf_lo(raw[d0].y); x[d0][3] = bf_hi(raw[d0].y); x[d0][4] = bf_lo(raw[d0].z); x[d0][5] = bf_hi(raw[d0].z); x[d0][6] = bf_lo(raw[d0].w); x[d0][7] = bf_hi(raw[d0].w);
#pragma unroll
      for (int j = 0; j < 8; ++j) ss += x[d0][j] * x[d0][j]; }
    { auto rr = __builtin_amdgcn_permlane32_swap(__float_as_uint(ss), __float_as_uint(ss), false, false); ss = __uint_as_float(rr[0]) + __uint_as_float(rr[1]); }
    const float rs = (SCALE * 1.4426950408889634f) / sqrtf(ss * (1.f / D) + EPS);
#pragma unroll
    for (int d0 = 0; d0 < 8; ++d0) { const f32x4 ga = *(const f32x4*)(qgain_u + 16 * d0 + 8 * hi), gb = *(const f32x4*)(qgain_u + 16 * d0 + 8 * hi + 4);
      x[d0][0] *= rs * ga.x; x[d0][1] *= rs * ga.y; x[d0][2] *= rs * ga.z; x[d0][3] *= rs * ga.w; x[d0][4] *= rs * gb.x; x[d0][5] *= rs * gb.y; x[d0][6] *= rs * gb.z; x[d0][7] *= rs * gb.w; }
    const int trow = row0_u + wid * QBLK + r32;
#pragma unroll
    for (int p = 0; p < 4; ++p) { const int da = (p & 1) + 4 * (p >> 1), db = da + 2;
      const int pos = (p >> 1) ? (trow & 63) : (trow >> 6); const f32x4* tp = (const f32x4*)(rope_u + ((size_t)pos * 32 + 16 * (p & 1) + 8 * hi) * 2);
#pragma unroll
      for (int jj = 0; jj < 4; ++jj) { const f32x4 cs = tp[jj];
        const float a0 = x[da][2 * jj], b0 = x[db][2 * jj], a1 = x[da][2 * jj + 1], b1 = x[db][2 * jj + 1];
        x[da][2 * jj] = a0 * cs.x - b0 * cs.y; x[db][2 * jj] = b0 * cs.x + a0 * cs.y; x[da][2 * jj + 1] = a1 * cs.z - b1 * cs.w; x[db][2 * jj + 1] = b1 * cs.z + a1 * cs.w; } }
#pragma unroll
    for (int d0 = 0; d0 < 8; ++d0) { u32x4 w = {cvtpk(x[d0][0], x[d0][1]), cvtpk(x[d0][2], x[d0][3]), cvtpk(x[d0][4], x[d0][5]), cvtpk(x[d0][6], x[d0][7])}; qr[d0] = *reinterpret_cast<bf16x8*>(&w); } }
  const int vb0 = (int)(unsigned)(uintptr_t)V_lds + v_rd_base(lane);
#define RESC(fl) do { if (fl) { asm volatile("s_waitcnt lgkmcnt(0)" ::: "memory"); \
    _Pragma("unroll") for (int d = 0; d < 4; ++d) _Pragma("unroll") for (int r = 0; r < 16; ++r) o[d][r] *= al_l[crow(r, hi)]; } } while (0)
  f32x16 pA0, pA1, pB0, pB1; bool rs; bf16x8 pa0, pa1, pa2, pa3;
  if (u == 0) WAIT_BAR(0);
  qkt(pA0, pA1, K_lds + cur, qr, negm, r32, hi);
  if (BND) {
#pragma unroll
    for (int r = 0; r < 16; ++r) pA0[r] = __builtin_amdgcn_exp2f(pA0[r]);
  } else (void)partialSM<true>(pA0, pA1, mhat, negm, l_reg, al_l, r32, hi);
  if (ATT_REBAL) {
#pragma unroll
    for (int r = 0; r < 8; ++r) pA1[r] = __builtin_amdgcn_exp2f(pA1[r]); }
  DMA_K(2, nn); DMA_V(1, nxt);
  WAIT_BAR(4); ROT();
  const int kbase = (int)(unsigned)(uintptr_t)K_lds + r32 * 256;
  const int kad0 = kbase + (((0 + hi) ^ (r32 & 7)) << 4), kad1 = kbase + (((2 + hi) ^ (r32 & 7)) << 4), kad2 = kbase + (((4 + hi) ^ (r32 & 7)) << 4), kad3 = kbase + (((6 + hi) ^ (r32 & 7)) << 4);
#define WAITL(N) asm volatile("s_waitcnt lgkmcnt(" #N ")" ::: "memory")
#define MFQ(acc, kf, d0, c) acc = __builtin_amdgcn_mfma_f32_32x32x16_bf16(kf, qr[d0], c, 0, 0, 0)
#define EXP8(P, B) do { _Pragma("unroll") for (int r_ = 0; r_ < 8; ++r_) P[(B) + r_] = __builtin_amdgcn_exp2f(P[(B) + r_]); } while (0)
#define EXP4(P, B) do { _Pragma("unroll") for (int r_ = 0; r_ < 4; ++r_) P[(B) + r_] = __builtin_amdgcn_exp2f(P[(B) + r_]); } while (0)
#define SUM8(P, B) do { _Pragma("unroll") for (int r_ = 0; r_ < 8; ++r_) ps_ += P[(B) + r_]; } while (0)
#define PK4(P, BASE, OUT) do { unsigned a0 = cvtpk(P[BASE + 0], P[BASE + 1]), a1 = cvtpk(P[BASE + 2], P[BASE + 3]);   \
    unsigned b0 = cvtpk(P[BASE + 4], P[BASE + 5]), b1 = cvtpk(P[BASE + 6], P[BASE + 7]);                              \
    auto r0 = __builtin_amdgcn_permlane32_swap(a0, b0, false, false); auto r1 = __builtin_amdgcn_permlane32_swap(a1, b1, false, false); \
    u32x4 w = {r0[0], r1[0], r0[1], r1[1]}; OUT = *reinterpret_cast<bf16x8*>(&w); } while (0)
#define PKV(L, H) (bf16x8){L[0], L[1], L[2], L[3], H[0], H[1], H[2], H[3]}
#define RDV(D0, l0, h0, l1, h1, l2, h2, l3, h3) const s16x4 l0 = tr_read<v_rd_off(D0, 0, 0)>(vb_), h0 = tr_read<v_rd_off(D0, 0, 1)>(vb_), l1 = tr_read<v_rd_off(D0, 1, 0)>(vb_), h1 = tr_read<v_rd_off(D0, 1, 1)>(vb_), \
    l2 = tr_read<v_rd_off(D0, 2, 0)>(vb_), h2 = tr_read<v_rd_off(D0, 2, 1)>(vb_), l3 = tr_read<v_rd_off(D0, 3, 0)>(vb_), h3 = tr_read<v_rd_off(D0, 3, 1)>(vb_)
#define MFV(od, l0, h0, l1, h1, l2, h2, l3, h3) do { od = __builtin_amdgcn_mfma_f32_32x32x16_bf16(pa0, PKV(l0, h0), od, 0, 0, 0); od = __builtin_amdgcn_mfma_f32_32x32x16_bf16(pa1, PKV(l1, h1), od, 0, 0, 0); \
    od = __builtin_amdgcn_mfma_f32_32x32x16_bf16(pa2, PKV(l2, h2), od, 0, 0, 0); od = __builtin_amdgcn_mfma_f32_32x32x16_bf16(pa3, PKV(l3, h3), od, 0, 0, 0); } while (0)
#define RS_HEAD(X0, X1) do { rs = false; if (!BND) rs = partialSM_head(X0, X1, mhat, negm, l_reg, al_l, r32, hi); } while (0)
#define ITER(X0, X1, Y0, Y1, t) do { \
    SBAR(); \
    { const int a0_ = kad0 + cur, a1_ = kad1 + cur, a2_ = kad2 + cur, a3_ = kad3 + cur; const int vb_ = vb0 + nn; float ps_ = 0.f; \
      const bf16x8 k00 = lds_rd128<0>(a0_), k01 = lds_rd128<8192>(a0_), k10 = lds_rd128<0>(a1_), k11 = lds_rd128<8192>(a1_); \
      const bf16x8 k20 = lds_rd128<0>(a2_), k21 = lds_rd128<8192>(a2_), k30 = lds_rd128<0>(a3_), k31 = lds_rd128<8192>(a3_); \
      WAITL(4); SBAR(); \
      MFQ(X0, k00, 0, negm); MFQ(X1, k01, 0, negm); MFQ(X0, k10, 1, X0); MFQ(X1, k11, 1, X1); \
      if (ATT_REBAL) EXP4(Y1, 8); else EXP8(Y1, 0); PK4(Y0, 0, pa0); SUM8(Y0, 0); \
      const bf16x8 k40 = lds_rd128<128>(a0_), k41 = lds_rd128<8192 + 128>(a0_), k50 = lds_rd128<128>(a1_), k51 = lds_rd128<8192 + 128>(a1_); \
      WAITL(4); SBAR(); \
      MFQ(X0, k20, 2, X0); MFQ(X1, k21, 2, X1); MFQ(X0, k30, 3, X0); MFQ(X1, k31, 3, X1); \
      if (ATT_REBAL) EXP4(Y1, 12); else EXP8(Y1, 8); PK4(Y0, 8, pa1); SUM8(Y0, 8); \
      DMA_K(((t) + 2 < NT ? (t) + 2 : (t) + 2 - NT), nn); \
      const bf16x8 k60 = lds_rd128<128>(a2_), k61 = lds_rd128<8192 + 128>(a2_), k70 = lds_rd128<128>(a3_), k71 = lds_rd128<8192 + 128>(a3_); \
      WAITL(4); SBAR(); \
      MFQ(X0, k40, 4, X0); MFQ(X1, k41, 4, X1); MFQ(X0, k50, 5, X0); MFQ(X1, k51, 5, X1); \
      PK4(Y1, 0, pa2); SUM8(Y1, 0); \
      DMA_V(((t) + 1 < NT ? (t) + 1 : 0), nxt); \
      RDV(0, vl00, vh00, vl01, vh01, vl02, vh02, vl03, vh03); \
      WAITL(8); SBAR(); \
      MFQ(X0, k60, 6, X0); MFQ(X1, k61, 6, X1); MFQ(X0, k70, 7, X0); MFQ(X1, k71, 7, X1); \
      PK4(Y1, 8, pa3); SUM8(Y1, 8); l_reg += ps_; \
      RDV(1, vl10, vh10, vl11, vh11, vl12, vh12, vl13, vh13); \
      WAITL(8); SBAR(); \
      MFV(o[0], vl00, vh00, vl01, vh01, vl02, vh02, vl03, vh03); \
      RS_HEAD(X0, X1); \
      if (ATT_REBAL) { EXP8(X0, 0); asm volatile("" : "+v"(X0)); } \
      RDV(2, vl20, vh20, vl21, vh21, vl22, vh22, vl23, vh23); \
      WAITL(8); SBAR(); \
      MFV(o[1], vl10, vh10, vl11, vh11, vl12, vh12, vl13, vh13); \
      if (ATT_REBAL) EXP8(X0, 8); else EXP8(X0, 0); asm volatile("" : "+v"(X0)); \
      RDV(3, vl30, vh30, vl31, vh31, vl32, vh32, vl33, vh33); \
      WAITL(8); SBAR(); \
      MFV(o[2], vl20, vh20, vl21, vh21, vl22, vh22, vl23, vh23); \
      if (ATT_REBAL) { EXP8(X1, 0); asm volatile("" : "+v"(X1)); } else { EXP8(X0, 8); asm volatile("" : "+v"(X0)); } \
      WAITL(0); SBAR(); \
      MFV(o[3], vl30, vh30, vl31, vh31, vl32, vh32, vl33, vh33); } \
    WAIT_BAR(4); \
    RESC(rs); ROT(); } while (0)
  int t = 1;
  for (; t + 1 < NT; t += 2) { ITER(pB0, pB1, pA0, pA1, t); ITER(pA0, pA1, pB0, pB1, t + 1); }
  ITER(pB0, pB1, pA0, pA1, t);
  finishSM<ATT_REBAL ? 8 : 0>(pB0, pB1, l_reg, pa0, pa1, pa2, pa3); SBAR();
  pv_d0(o, vb0 + nn, pa0, pa1, pa2, pa3);
  { auto rr = __builtin_amdgcn_permlane32_swap(__float_as_uint(l_reg), __float_as_uint(l_reg), false, false); l_reg = __uint_as_float(rr[0]) + __uint_as_float(rr[1]); }
  if (hi == 0) li_l[r32] = l_reg; asm volatile("s_waitcnt lgkmcnt(0)" ::: "memory");
  float rli[16];
#pragma unroll
  for (int r = 0; r < 16; ++r) rli[r] = __builtin_amdgcn_rcpf(li_l[crow(r, hi)]);
  bf16_t* Ow = Ob + (long)(wid * QBLK) * LDO;
#pragma unroll
  for (int r = 0; r < 16; ++r) { const int orow = crow(r, hi);
#pragma unroll
    for (int d0 = 0; d0 < 4; ++d0) { const unsigned w = cvtpk(o[d0][r] * rli[r], 0.f); Ow[(long)orow * LDO + d0 * 32 + r32] = (bf16_t)(w & 0xffffu); } }
  }
  asm volatile("s_waitcnt vmcnt(0) lgkmcnt(0)\n\ts_barrier" ::: "memory");
#undef DMA_K
#undef DMA_V
#undef WAIT_BAR
#undef ROT
#undef RESC
#undef ITER
#undef WAITL
#undef MFQ
#undef EXP8
#undef SUM8
#undef PK4
#undef PKV
#undef RDV
#undef MFV
}
#undef SBAR
}

constexpr int NWAVES = 8;
constexpr int N_PHASES = 1 + 11 * DEPTH;
constexpr int N_LAUNCHES = MK_N_LAUNCHES;
static_assert(N_LAUNCHES == 1 || N_LAUNCHES == N_PHASES, "MK_N_LAUNCHES is 1 or 23");

constexpr size_t MiB = 1u << 20;
constexpr size_t WS_CTL = 0, CTL_ZERO_BYTES = 1 * MiB;
constexpr size_t WS_ROPE = 1 * MiB;
constexpr size_t WS_PB = 2 * MiB;
constexpr size_t WS_W = 16 * MiB;
constexpr size_t LW_IN = 0, LW_POOL = 128 * MiB, LW_OUT = 132 * MiB, LW_GU = 164 * MiB, LW_DOWN = 336 * MiB, LW_PIN = 422 * MiB, LW_PG = 424 * MiB, LW_BYTES = 456 * MiB;
constexpr size_t WS_ACT = WS_W + 2 * LW_BYTES;
constexpr size_t WS_H = WS_ACT;
constexpr size_t WS_Q = WS_H + 64 * MiB;
constexpr size_t WS_K = WS_Q + 64 * MiB;
constexpr size_t WS_V = WS_K + 16 * MiB;
constexpr size_t WS_U = WS_V + 16 * MiB;
constexpr size_t WS_GA = WS_U + 32 * MiB;
constexpr size_t WS_GP = WS_GA + 64 * MiB;
constexpr size_t WS_Q2 = WS_GP + 64 * MiB;
constexpr size_t WS_X16 = WS_Q2;
constexpr size_t WS_K2 = WS_Q2 + 64 * MiB;
constexpr size_t WS_DL = WS_K2 + 16 * MiB;
constexpr size_t WS_O = WS_DL + 32 * MiB;
constexpr size_t WS_MG = WS_O + 64 * MiB;
constexpr size_t WS_Y = WS_MG + 64 * MiB;
constexpr size_t WS_F = WS_Y + 80 * MiB;
constexpr size_t WS_E = WS_F + 172 * MiB;
constexpr size_t WS_END = WS_E + 128 * MiB;
static_assert(WS_END <= 2048 * MiB, "workspace map");

constexpr int CW_TMO = 0, CW_CODE = 1;
constexpr int CW_BAR = 4096;
constexpr int CW_QUEUE = 8192;

constexpr int RING_OFF = 0, RING_BYTES = 131072;
constexpr int LDSCTL_OFF = RING_BYTES, MISC_OFF = LDSCTL_OFF + 320;
constexpr int LDS_BYTES = 147456;

typedef GAS unsigned gu32;
#define RLX_AGENT __ATOMIC_RELAXED, __HIP_MEMORY_SCOPE_AGENT
#define LDS_WAIT() asm volatile("s_waitcnt lgkmcnt(0)" ::: "memory")
#define VM_WAIT() asm volatile("s_waitcnt vmcnt(0)" ::: "memory")
__device__ __forceinline__ unsigned f2bf(float f) { unsigned u = __builtin_bit_cast(unsigned, f); return (u + 0x7fffu + ((u >> 16) & 1u)) >> 16; }
__device__ __forceinline__ unsigned pk2(float lo, float hi) { return f2bf(lo) | (f2bf(hi) << 16); }

#define XB_TMO      128
#define XB_XCNT(j)  (256  + 64 * (j))
#define XB_XSUB(j)  (1280 + 64 * (j))
#define XB_XGEN(j)  (2304 + 64 * (j))
#define XB_TOP      3328
#define XB_TOPGEN   3392
#define XCD_BAR_WORDS 3456
#define XB_SPIN_CAP (1u << 18)

__device__ __forceinline__ unsigned xb_ld(unsigned* p)              { return __hip_atomic_load(p, __ATOMIC_RELAXED, __HIP_MEMORY_SCOPE_AGENT); }
__device__ __forceinline__ unsigned xb_add(unsigned* p, unsigned v) { return __hip_atomic_fetch_add(p, v, __ATOMIC_RELAXED, __HIP_MEMORY_SCOPE_AGENT); }
__device__ __forceinline__ unsigned xb_xcc_id() { return (unsigned)__builtin_amdgcn_s_getreg((3 << 11) | 20) & 0xFu; }
#define XB_SPIN(cond, bar) do { unsigned _sp = 0; while (cond) { __builtin_amdgcn_s_sleep(1); \
    if ((++_sp & 255u) == 0u) { if (xb_ld(&(bar)[XB_TMO])) break; if (_sp > XB_SPIN_CAP) { atomicAdd(&(bar)[XB_TMO], 1u); break; } } } } while (0)

struct XcdBarrier {
    unsigned* bar; unsigned x;
    volatile LAS unsigned* st;
};
__device__ __forceinline__ XcdBarrier xcd_barrier_post(unsigned* bar, volatile LAS unsigned* st) {
    XcdBarrier b; b.bar = bar; b.x = xb_xcc_id(); b.st = st;
    if (threadIdx.x == 0) (void)xb_add(&bar[XB_XCNT(b.x)], 1u);
    return b;
}
__device__ __forceinline__ void xcd_barrier_complete(unsigned* bar, unsigned x, unsigned& nloc, unsigned& nx) {
    const unsigned G = gridDim.x * gridDim.y * gridDim.z;
    unsigned sum, cnt, mine, sp = 0u;
    for (;;) {
        sum = 0u; cnt = 0u; mine = 0u;
#pragma unroll
        for (unsigned j = 0; j < 16; ++j) { const unsigned c = xb_ld(&bar[XB_XCNT(j)]); sum += c; cnt += (c > 0u) ? 1u : 0u; mine = (j == x) ? c : mine; }
        if (sum == G) break;
        __builtin_amdgcn_s_sleep(1);
        if ((++sp & 255u) == 0u) { if (xb_ld(&bar[XB_TMO])) break; if (sp > XB_SPIN_CAP) { atomicAdd(&bar[XB_TMO], 1u); break; } }
    }
    nloc = mine > 0u ? mine : 1u; nx = cnt > 0u ? cnt : 1u;
}
__device__ __forceinline__ void xcd_barrier(const XcdBarrier& b, const int wave_s) {
    asm volatile("s_waitcnt vmcnt(0)" ::: "memory");
    __syncthreads();
    unsigned m_ = ~0u; asm volatile("" : "+s"(m_));
    if (wave_s == 0 && __builtin_amdgcn_mbcnt_hi(m_, __builtin_amdgcn_mbcnt_lo(m_, 0u)) == 0u) {
        unsigned* bar = b.bar; asm volatile("" : "+s"(bar));
        __builtin_amdgcn_s_waitcnt(0);
        unsigned nloc = b.st[0], nx = b.st[1];
        if (nloc == 0u) { xcd_barrier_complete(bar, b.x, nloc, nx); b.st[0] = nloc; b.st[1] = nx; }
        const unsigned old = xb_add(&bar[XB_XSUB(b.x)], 1u);
        const unsigned gen = old / nloc;
        if (old + 1u == (gen + 1u) * nloc) {
            __builtin_amdgcn_fence(__ATOMIC_RELEASE, "agent");
            asm volatile("s_waitcnt vmcnt(0)" ::: "memory");
            const unsigned og = xb_add(&bar[XB_TOP], 1u);
            const unsigned tg = og / nx;
            if (og + 1u == (tg + 1u) * nx) xb_add(&bar[XB_TOPGEN], 1u);
            else XB_SPIN(xb_ld(&bar[XB_TOPGEN]) == tg, bar);
            __builtin_amdgcn_fence(__ATOMIC_ACQUIRE, "agent");
            xb_add(&bar[XB_XGEN(b.x)], 1u);
            asm volatile("s_waitcnt vmcnt(0)" ::: "memory");
        } else {
            XB_SPIN(xb_ld(&bar[XB_XGEN(b.x)]) == gen, bar);
            __builtin_amdgcn_fence(__ATOMIC_ACQUIRE, "agent");
            asm volatile("s_waitcnt vmcnt(0)" ::: "memory");
        }
    }
    __syncthreads();
}

struct Frame {
    LAS unsigned char* lds;
    int tid, lane, wave;
    int vcu, G, bx;
};
__device__ __forceinline__ int thread_id(int wave_s) { unsigned m = ~0u; asm volatile("" : "+s"(m)); const int lane = (int)__builtin_amdgcn_mbcnt_hi(m, __builtin_amdgcn_mbcnt_lo(m, 0u)); int t = wave_s * 64 + lane; asm volatile("" : "+v"(t)); return t; }
__device__ __forceinline__ Frame make_frame(LAS unsigned char* lds, int wave_s) {
    Frame F; const int t = thread_id(wave_s); int bx = blockIdx.x; asm volatile("" : "+s"(bx)); int G = gridDim.x; asm volatile("" : "+s"(G));
    F.lds = lds; F.tid = t; F.lane = t & 63; F.wave = wave_s; F.G = G; F.bx = bx;
    F.vcu = (G % 8 == 0) ? (bx % 8) * (G / 8) + bx / 8 : bx;
    return F;
}

__device__ __forceinline__ float shx(float v, int m, int lane) { return __int_as_float(__builtin_amdgcn_ds_bpermute((lane ^ m) << 2, __float_as_int(v))); }
__device__ __forceinline__ float wave_sum(float v, int lane) {
#pragma unroll
    for (int o = 1; o < 64; o <<= 1) v += shx(v, o, lane);
    return v;
}

template <int MAP>
__device__ __forceinline__ void p0_transpose_item(const float* W, int K, int N, bf16_t* WT, int row_off, LAS float* scr, int item, int lane) {
    const int nblk = N / 32, kb = item / nblk, nb = item % nblk, k0 = 64 * kb, n0 = 32 * nb;
    const int r0 = (MAP == 0) ? (row_off + n0) : (256 * (n0 >> 7) + (n0 & 127) + row_off);
#pragma unroll 8
    for (int i = 0; i < 32; ++i) { const int kk = 2 * i + (lane >> 5);
#if NT_CONV
        scr[kk * 33 + (lane & 31)] = __builtin_nontemporal_load(&W[(size_t)(k0 + kk) * N + n0 + (lane & 31)]);
#else
        scr[kk * 33 + (lane & 31)] = W[(size_t)(k0 + kk) * N + n0 + (lane & 31)];
#endif
    }
    LDS_WAIT(); asm volatile("" ::: "memory");
    const int c = lane & 7;
#pragma unroll
    for (int j = 0; j < 4; ++j) { const int n = (lane >> 3) + 8 * j; const LAS float* s = scr + (8 * c) * 33 + n;
        u32x4 o; o.x = pk2(s[0 * 33], s[1 * 33]); o.y = pk2(s[2 * 33], s[3 * 33]); o.z = pk2(s[4 * 33], s[5 * 33]); o.w = pk2(s[6 * 33], s[7 * 33]);
        *(GAS u32x4*)(WT + (size_t)(r0 + n) * K + k0 + 8 * c) = o; }
    LDS_WAIT(); asm volatile("" ::: "memory");
}

struct Args { const float* in[18]; float* out; unsigned char* ws; int ph_lo, ph_hi; };

__device__ __forceinline__ void norm_row(int lane, const float* xf, const bf16_t* x16in, const bf16_t* y, const LAS float* gpost, bf16_t* x16out, float* xfout, const LAS float* gpre, bf16_t* h) {
    f32x4 v[16];
    if (xf) { const GAS f32x4* xr = (const GAS f32x4*)xf + lane;
#pragma unroll
        for (int j = 0; j < 16; ++j) v[j] = xr[64 * j];
    } else { const GAS u32x2* xr = (const GAS u32x2*)x16in + lane;
#pragma unroll
        for (int j = 0; j < 16; ++j) { const u32x2 w = xr[64 * j]; v[j] = (f32x4){bf_lo(w.x), bf_hi(w.x), bf_lo(w.y), bf_hi(w.y)}; } }
    if (y) {
        const GAS u32x2* yr = (const GAS u32x2*)y + lane; f32x4 yv[16]; float s = 0.f;
#pragma unroll
        for (int j = 0; j < 16; ++j) { const u32x2 w = yr[64 * j]; yv[j] = (f32x4){bf_lo(w.x), bf_hi(w.x), bf_lo(w.y), bf_hi(w.y)}; s += (yv[j].x * yv[j].x + yv[j].y * yv[j].y) + (yv[j].z * yv[j].z + yv[j].w * yv[j].w); }
        const float rstd = 1.0f / sqrtf(wave_sum(s, lane) * (1.f / DM) + EPS);
#pragma unroll
        for (int j = 0; j < 16; ++j) { const f32x4 g = *(const LAS f32x4*)(gpost + 4 * lane + 256 * j); v[j] = v[j] + yv[j] * rstd * g; }
    }
    if (xfout) { GAS f32x4* xo = (GAS f32x4*)xfout + lane;
#pragma unroll
        for (int j = 0; j < 16; ++j) xo[64 * j] = v[j]; }
    if (x16out) { GAS u32x2* xo = (GAS u32x2*)x16out + lane;
#pragma unroll
        for (int j = 0; j < 16; ++j) { u32x2 w; w.x = cvt_pk_bf16(v[j].x, v[j].y); w.y = cvt_pk_bf16(v[j].z, v[j].w); xo[64 * j] = w; } }
    if (h) {
        float s = 0.f;
#pragma unroll
        for (int j = 0; j < 16; ++j) s += (v[j].x * v[j].x + v[j].y * v[j].y) + (v[j].z * v[j].z + v[j].w * v[j].w);
        const float rstd = 1.0f / sqrtf(wave_sum(s, lane) * (1.f / DM) + EPS);
        GAS u32x2* ho = (GAS u32x2*)h + lane;
#pragma unroll
        for (int j = 0; j < 16; ++j) { const f32x4 g = *(const LAS f32x4*)(gpre + 4 * lane + 256 * j); const f32x4 t = v[j] * rstd * g;
            u32x2 w; w.x = cvt_pk_bf16(t.x, t.y); w.y = cvt_pk_bf16(t.z, t.w); ho[64 * j] = w; }
    }
}
__device__ __forceinline__ void norm_pass(Frame& F, const float* xf, const bf16_t* x16in, const bf16_t* y, const float* gpost, bf16_t* x16out, float* xfout, const float* gpre, bf16_t* h) {
    LAS float* gl = (LAS float*)(F.lds + RING_OFF);
    __syncthreads();
    for (int i = F.tid; i < DM; i += NWAVES * 64) { gl[i] = gpost ? gpost[i] : 0.f; gl[DM + i] = gpre ? gpre[i] : 0.f; }
    __syncthreads();
    const int gw = F.vcu * NWAVES + F.wave, NGW = F.G * NWAVES;
    for (int m = gw; m < S; m += NGW)
        norm_row(F.lane, xf ? xf + (size_t)m * DM : nullptr, x16in ? x16in + (size_t)m * DM : nullptr, y ? y + (size_t)m * YP : nullptr, gl,
                 x16out ? x16out + (size_t)m * DM : nullptr, xfout ? xfout + (size_t)m * DM : nullptr, gl + DM, h ? h + (size_t)m * DM : nullptr);
    __syncthreads();
}

__device__ __forceinline__ void qk_item_addr(int it, int dsub, const bf16_t* Qr, const bf16_t* Kr, bf16_t* Q2, bf16_t* K2, const bf16_t*& src, bf16_t*& dst, int& row, bool& isq) {
    row = it / NKV; const int hh = it % NKV; isq = false;
    src = Kr + (size_t)row * KVW + hh * HD + dsub;
    dst = K2 + (size_t)row * KVW + hh * HD + dsub;
}
__device__ __forceinline__ void qk_item_do(const u32x4 w, bf16_t* dst, int row, bool isq, int lane, int s, const float* qn, const float* kn, const float* rope) {
    const int dsub = 8 * s, axis = s >> 3, half = (s >> 2) & 1, i0 = 8 * (s & 3);
    const float* gn = isq ? qn : kn;
    float x[8] = {bf_lo(w.x), bf_hi(w.x), bf_lo(w.y), bf_hi(w.y), bf_lo(w.z), bf_hi(w.z), bf_lo(w.w), bf_hi(w.w)};
    float ss = 0.f;
#pragma unroll
    for (int j = 0; j < 8; ++j) ss += x[j] * x[j];
    ss += shx(ss, 1, lane); ss += shx(ss, 2, lane); ss += shx(ss, 4, lane); ss += shx(ss, 8, lane);
    const float rstd = 1.0f / sqrtf(ss * (1.f / HD) + EPS);
    const f32x4 ga = *(const f32x4*)(gn + dsub), gb = *(const f32x4*)(gn + dsub + 4);
    const float g[8] = {ga.x, ga.y, ga.z, ga.w, gb.x, gb.y, gb.z, gb.w};
    const float rs = isq ? rstd * (att::SCALE * 1.4426950408889634f) : rstd;
#pragma unroll
    for (int j = 0; j < 8; ++j) x[j] = x[j] * rs * g[j];
    float xp[8];
#pragma unroll
    for (int j = 0; j < 8; ++j) xp[j] = shx(x[j], 4, lane);
    const int pos = axis ? (row & 63) : (row >> 6);
    const f32x4* tp = (const f32x4*)(rope + ((size_t)pos * 32 + i0) * 2);
    float o[8];
#pragma unroll
    for (int jj = 0; jj < 4; ++jj) { const f32x4 cs = tp[jj];
        o[2 * jj]     = half ? (x[2 * jj] * cs.x + xp[2 * jj] * cs.y)         : (x[2 * jj] * cs.x - xp[2 * jj] * cs.y);
        o[2 * jj + 1] = half ? (x[2 * jj + 1] * cs.z + xp[2 * jj + 1] * cs.w) : (x[2 * jj + 1] * cs.z - xp[2 * jj + 1] * cs.w); }
    u32x4 ow; ow.x = cvt_pk_bf16(o[0], o[1]); ow.y = cvt_pk_bf16(o[2], o[3]); ow.z = cvt_pk_bf16(o[4], o[5]); ow.w = cvt_pk_bf16(o[6], o[7]);
    *(GAS u32x4*)dst = ow;
}
__device__ __forceinline__ void qk_norm_rope_pass(Frame& F, const bf16_t* Qr, const bf16_t* Kr, bf16_t* Q2, bf16_t* K2, const float* qn, const float* kn, const float* rope) {
    const int gw = F.vcu * NWAVES + F.wave, NGW = F.G * NWAVES;
    const int g16 = F.lane >> 4, s = F.lane & 15;
    constexpr int NITEM = S * NKV;
    const int step = 4 * NGW;
    for (int it = 4 * gw + g16; it < NITEM; it += 4 * step) {
        const bf16_t* src[4]; bf16_t* dst[4]; int row[4]; bool isq[4]; u32x4 w[4];
#pragma unroll
        for (int u = 0; u < 4; ++u) { const int iu = it + u * step; qk_item_addr(iu < NITEM ? iu : it, 8 * s, Qr, Kr, Q2, K2, src[u], dst[u], row[u], isq[u]); w[u] = *(const GAS u32x4*)src[u]; }
#pragma unroll
        for (int u = 0; u < 4; ++u) if (it + u * step < NITEM) qk_item_do(w[u], dst[u], row[u], isq[u], F.lane, s, qn, kn, rope);
    }
}
template <int HW> __device__ __forceinline__ void pool_item(const bf16_t* U, bf16_t* DL, int t, int c) {
    u32x4 w[2 * HW];
#pragma unroll
    for (int i = 0; i < 2 * HW; ++i) { int r = t - HW + i; r = r < 0 ? 0 : (r >= S ? S - 1 : r); w[i] = *(const GAS u32x4*)(U + (size_t)r * POOLW + 8 * c); }
    float acc[8] = {0.f, 0.f, 0.f, 0.f, 0.f, 0.f, 0.f, 0.f};
#pragma unroll
    for (int i = 0; i < 2 * HW; ++i) { const int r = t - HW + i; const float m = ((unsigned)r < (unsigned)S) ? 1.f : 0.f;
        acc[0] += m * bf_lo(w[i].x); acc[1] += m * bf_hi(w[i].x); acc[2] += m * bf_lo(w[i].y); acc[3] += m * bf_hi(w[i].y); acc[4] += m * bf_lo(w[i].z); acc[5] += m * bf_hi(w[i].z); acc[6] += m * bf_lo(w[i].w); acc[7] += m * bf_hi(w[i].w); }
    const int lo = (t - HW) < 0 ? 0 : (t - HW), hi = (t + HW) > S ? S : (t + HW);
    const float inv = 1.0f / (float)(hi - lo);
    const u32x4 wm = w[HW];
    const float me[8] = {bf_lo(wm.x), bf_hi(wm.x), bf_lo(wm.y), bf_hi(wm.y), bf_lo(wm.z), bf_hi(wm.z), bf_lo(wm.w), bf_hi(wm.w)};
    float d[8];
#pragma unroll
    for (int j = 0; j < 8; ++j) d[j] = acc[j] * inv - me[j];
    u32x4 ow; ow.x = cvt_pk_bf16(d[0], d[1]); ow.y = cvt_pk_bf16(d[2], d[3]); ow.z = cvt_pk_bf16(d[4], d[5]); ow.w = cvt_pk_bf16(d[6], d[7]);
    *(GAS u32x4*)(DL + (size_t)t * POOLW + 8 * c) = ow;
}
__device__ __forceinline__ void pool_delta_pass(Frame& F, const bf16_t* U, bf16_t* DL) {
    const int gt = F.vcu * (NWAVES * 64) + F.tid, NT = F.G * NWAVES * 64;
    for (int it = gt; it < S * (POOLW / 8); it += NT) {
        const int t = it >> 8, c = it & 255, g = __builtin_amdgcn_readfirstlane(c >> 6);
        if (g == 0) pool_item<1>(U, DL, t, c); else if (g == 1) pool_item<2>(U, DL, t, c); else if (g == 2) pool_item<4>(U, DL, t, c); else pool_item<8>(U, DL, t, c);
    }
}

__device__ __forceinline__ double inv_freq_of(int i) {
    const double step = 0.74989420933245582730;
    double r = 1.0; for (int k = 0; k < i; ++k) r *= step; return r;
}

typedef const __attribute__((address_space(4))) Args CArgs;
__device__ __forceinline__ CArgs* fresh_args() { CArgs* p = (CArgs*)__builtin_amdgcn_kernarg_segment_ptr(); asm volatile("" : "+s"(p)); return p; }
#define WSP(off) ((bf16_t*)(ws + (off)))
struct ConvDesc { const float* src; bf16_t* dst; int N, K; };
constexpr int CI_IN = (DM / 64) * (INW / 32), CI_POOL = (PGI / 64) * (PGO / 32), CI_OUT = (DM / 64) * (DM / 32), CI_GU = (DM / 64) * (FF / 32), CI_DOWN = (FF / 64) * (DM / 32), CI_PIN = (DPLE / 64) * (DM / 32);
constexpr int CI_LAYER = CI_IN + 4 * CI_POOL + CI_OUT + 2 * CI_GU + CI_DOWN + CI_PIN + CI_OUT;
__device__ __forceinline__ ConvDesc conv_decode(CArgs* ap, unsigned char* ws, int it) {
    const int l = it / CI_LAYER; int r = it % CI_LAYER;
    unsigned char* wl = ws + WS_W + (size_t)l * LW_BYTES;
    const float* W; int K, N, row_off = 0, map = 0; bf16_t* WT;
    if (r < CI_IN) { W = ap->in[2] + (size_t)l * DM * INW; K = DM; N = INW; WT = (bf16_t*)(wl + LW_IN); }
    else if ((r -= CI_IN) < 4 * CI_POOL) { const int g = r / CI_POOL; r -= g * CI_POOL; W = ap->in[5] + ((size_t)l * 4 + g) * PGI * PGO; K = PGI; N = PGO; WT = (bf16_t*)(wl + LW_POOL); row_off = g * PGO; }
    else if ((r -= 4 * CI_POOL) < CI_OUT) { W = ap->in[7] + (size_t)l * DM * DM; K = DM; N = DM; WT = (bf16_t*)(wl + LW_OUT); }
    else if ((r -= CI_OUT) < CI_GU) { W = ap->in[12] + (size_t)l * DM * FF; K = DM; N = FF; WT = (bf16_t*)(wl + LW_GU); map = 1; }
    else if ((r -= CI_GU) < CI_GU) { W = ap->in[13] + (size_t)l * DM * FF; K = DM; N = FF; WT = (bf16_t*)(wl + LW_GU); map = 1; row_off = 128; }
    else if ((r -= CI_GU) < CI_DOWN) { W = ap->in[14] + (size_t)l * FF * DM; K = FF; N = DM; WT = (bf16_t*)(wl + LW_DOWN); }
    else if ((r -= CI_DOWN) < CI_PIN) { W = ap->in[15] + (size_t)l * DPLE * DM; K = DPLE; N = DM; WT = (bf16_t*)(wl + LW_PIN); }
    else { r -= CI_PIN; W = ap->in[16] + (size_t)l * DM * DM; K = DM; N = DM; WT = (bf16_t*)(wl + LW_PG); }
    const int nblk = N / 32, kb = r / nblk, nb = r % nblk, k0 = 64 * kb, n0 = 32 * nb;
    const int r0 = map ? (256 * (n0 >> 7) + (n0 & 127) + row_off) : (row_off + n0);
    ConvDesc d; d.src = W + (size_t)k0 * N + n0; d.dst = WT + (size_t)r0 * K + k0; d.N = N; d.K = K; return d;
}
__device__ __forceinline__ void conv_load(const ConvDesc& d, int lane, float (&r)[32]) {
#pragma unroll
    for (int i = 0; i < 32; ++i) r[i] = NT_CONV ? __builtin_nontemporal_load(&d.src[(size_t)(2 * i + (lane >> 5)) * d.N + (lane & 31)]) : d.src[(size_t)(2 * i + (lane >> 5)) * d.N + (lane & 31)];
}
__device__ __forceinline__ void conv_finish(const ConvDesc& d, const float (&r)[32], LAS float* scr, int lane) {
#pragma unroll
    for (int i = 0; i < 32; ++i) scr[(2 * i + (lane >> 5)) * 33 + (lane & 31)] = r[i];
    LDS_WAIT(); asm volatile("" ::: "memory");
    const int c = lane & 7;
#pragma unroll
    for (int j = 0; j < 4; ++j) { const int n = (lane >> 3) + 8 * j; const LAS float* s = scr + (8 * c) * 33 + n;
        u32x4 o; o.x = pk2(s[0 * 33], s[1 * 33]); o.y = pk2(s[2 * 33], s[3 * 33]); o.z = pk2(s[4 * 33], s[5 * 33]); o.w = pk2(s[6 * 33], s[7 * 33]);
        *(GAS u32x4*)(d.dst + (size_t)n * d.K + 8 * c) = o; }
    LDS_WAIT(); asm volatile("" ::: "memory");
}
__device__ __forceinline__ void convert_range(CArgs* ap, unsigned char* ws, LAS unsigned char* Lb, int wave, int lane, int gw, int NGW, int lo, int hi) {
    LAS float* scr = (LAS float*)(Lb + RING_OFF + wave * 16384);
    int it = lo + gw;
    if (it < hi) {
        ConvDesc d = conv_decode(ap, ws, it); float r[32]; conv_load(d, lane, r);
        for (;;) {
            const int itn = it + NGW; const bool has = itn < hi;
            ConvDesc dn = d; float rn[32];
            if (has) { dn = conv_decode(ap, ws, itn); conv_load(dn, lane, rn); }
            conv_finish(d, r, scr, lane);
            if (!has) break;
            d = dn; it = itn;
#pragma unroll
            for (int i = 0; i < 32; ++i) r[i] = rn[i];
        }
    }
}
__device__ __forceinline__ void convert_range_dyn(CArgs* ap, unsigned char* ws, LAS unsigned char* Lb, int wave, int lane, int lo, int hi, unsigned* counter) {
    constexpr int CH = 8;
    LAS float* scr = (LAS float*)(Lb + RING_OFF + wave * 16384);
    for (;;) {
        unsigned b = 0u; if (lane == 0) b = __hip_atomic_fetch_add(counter, (unsigned)CH, __ATOMIC_RELAXED, __HIP_MEMORY_SCOPE_AGENT);
        const int base = lo + (int)__builtin_amdgcn_readfirstlane((int)b);
        if (base >= hi) break;
        const int end = base + CH < hi ? base + CH : hi;
        ConvDesc d = conv_decode(ap, ws, base); float r[32]; conv_load(d, lane, r);
        for (int it = base;;) {
            const int itn = it + 1; const bool has = itn < end;
            ConvDesc dn = d; float rn[32];
            if (has) { dn = conv_decode(ap, ws, itn); conv_load(dn, lane, rn); }
            conv_finish(d, r, scr, lane);
            if (!has) break;
            d = dn; it = itn;
#pragma unroll
            for (int i = 0; i < 32; ++i) r[i] = rn[i];
        }
    }
}
constexpr int CO_POOL = CI_IN, CO_OUT = CO_POOL + 4 * CI_POOL, CO_GATE = CO_OUT + CI_OUT, CO_DOWN = CO_GATE + 2 * CI_GU, CO_PIN = CO_DOWN + CI_DOWN, CO_PG = CO_PIN + CI_PIN;
#define CONVERT(l_, lo_, hi_) convert_range(ap, ws, L, F.wave, F.lane, F.vcu * NWAVES + F.wave, F.G * NWAVES, (l_) * CI_LAYER + (lo_), (l_) * CI_LAYER + (hi_))


__global__ void __launch_bounds__(NWAVES * 64, 2) fwd_kernel(Args args) {
    extern __shared__ __attribute__((aligned(16))) unsigned char lds[];
    LAS unsigned char* const L = (LAS unsigned char*)lds;
    const int wave_s = __builtin_amdgcn_readfirstlane((int)threadIdx.x >> 6);
    for (int u = threadIdx.x; u < (LDS_BYTES - LDSCTL_OFF) / 4; u += NWAVES * 64) ((LAS unsigned*)(L + LDSCTL_OFF))[u] = 0u;
    __syncthreads();
    unsigned* const barw = (unsigned*)(args.ws + WS_CTL) + CW_BAR;
    XcdBarrier bar; bar.bar = barw; bar.x = 0; bar.st = nullptr;
    if (N_LAUNCHES == 1) bar = xcd_barrier_post(barw, (volatile LAS unsigned*)(L + MISC_OFF) + 8);
#if SKEW_PROBE
    unsigned long long wait_ticks = 0;
#define GRID_BAR() do { const unsigned long long ta_ = __builtin_amdgcn_s_memrealtime(); xcd_barrier(bar, wave_s); wait_ticks += __builtin_amdgcn_s_memrealtime() - ta_; } while (0)
#else
#define GRID_BAR() do { if (N_LAUNCHES == 1) { for (int rb_ = 0; rb_ < REP_BAR; ++rb_) xcd_barrier(bar, wave_s); } } while (0)
#endif
    const int lo = args.ph_lo, hi = args.ph_hi;
#define IN(k) (lo <= (k) && (k) < hi)
#define SEAM(k) do { if (IN(k) && IN((k) + 1)) GRID_BAR(); } while (0)

    if (IN(0)) {
        CArgs* ap = fresh_args(); unsigned char* ws = ap->ws; Frame F = make_frame(L, wave_s);
        LAS float* scr = (LAS float*)(F.lds + RING_OFF + F.wave * 16384);
        const int gw = F.vcu * NWAVES + F.wave, NGW = F.G * NWAVES;
        if (JIT_CONV) { CONVERT(0, 0, CI_IN); } else {
        for (int rep = 0; rep < REP_CONV; ++rep) {
            constexpr int TOT = DEPTH * CI_LAYER;
            int it = gw;
            if (it < TOT) {
                ConvDesc d = conv_decode(ap, ws, TOT - 1 - it); float r[32]; conv_load(d, F.lane, r);
                for (;;) {
                    const int itn = it + NGW; const bool has = itn < TOT;
                    ConvDesc dn = d; float rn[32];
                    if (has) { dn = conv_decode(ap, ws, TOT - 1 - itn); conv_load(dn, F.lane, rn); }
                    conv_finish(d, r, scr, F.lane);
                    if (!has) break;
                    d = dn; it = itn;
#pragma unroll
                    for (int i = 0; i < 32; ++i) r[i] = rn[i];
                }
            }
        }
        }
        { const int gt = F.vcu * (NWAVES * 64) + F.tid, NT = F.G * NWAVES * 64;
          const float* p_in = ap->in[1]; bf16_t* PB = WSP(WS_PB); float* rope = (float*)(ws + WS_ROPE);
          for (int i = gt; i < DEPTH * S * DPLE / 8; i += NT) { const f32x4 a = *(const GAS f32x4*)(p_in + (size_t)i * 8), b = *(const GAS f32x4*)(p_in + (size_t)i * 8 + 4);
              u32x4 o; o.x = cvt_pk_bf16(a.x, a.y); o.y = cvt_pk_bf16(a.z, a.w); o.z = cvt_pk_bf16(b.x, b.y); o.w = cvt_pk_bf16(b.z, b.w); *(GAS u32x4*)(PB + (size_t)i * 8) = o; }
          for (int i = gt; i < 128 * 32; i += NT) { const int pos = i >> 5, fi = i & 31;
              const double ang = (double)pos * inv_freq_of(fi); const double k = __builtin_rint(ang * 0.15915494309189533577); const double r = ang - k * 6.283185307179586476925;
              const float rf = (float)r; rope[2 * i] = cosf(rf); rope[2 * i + 1] = sinf(rf); }
        }
        norm_pass(F, ap->in[0], nullptr, nullptr, nullptr, nullptr, nullptr, ap->in[8], WSP(WS_H));
    }
    SEAM(0);

    for (int l = 0; l < DEPTH; ++l) {
        const int pb = 1 + 11 * l;
        if (IN(pb + 0)) {
            CArgs* ap = fresh_args(); unsigned char* ws = ap->ws; Frame F = make_frame(L, wave_s); unsigned char* wl = ws + WS_W + (size_t)l * LW_BYTES;
            for (int rep = 0; rep < REP_G1; ++rep) { pg8::Gemm g{WSP(WS_H), (const bf16_t*)(wl + LW_IN), S, INW, DM, DM, DM, 0}; pg8::StaticOrder So; So.init(S, INW, F.G, F.bx);
              pg8::EpiZ E{WSP(WS_Q), WSP(WS_K), WSP(WS_V), WSP(WS_U), WSP(WS_GA), WSP(WS_GP)};
              pg8::gemm_phase<pg8::EpiZ, pg8::StaticOrder, G_ALIGN, G_SP2>(F.lds + RING_OFF, g, So, E, F.tid); }
            if (!JIT_CONV && l == 0) {
                for (int l2 = 0; l2 < DEPTH * REP_E; ++l2) {
                    const int l2_ = l2 % DEPTH; pg8::Gemm g2{WSP(WS_PB) + (size_t)l2_ * S * DPLE, (const bf16_t*)(ws + WS_W + (size_t)l2_ * LW_BYTES + LW_PIN), S, DM, DPLE, DPLE, DPLE, 0}; pg8::StaticOrder S2; S2.init(S, DM, F.G, F.bx);
                    pg8::EpiPlain E2{WSP(WS_E) + (size_t)l2_ * S * DM, DM};
                    pg8::gemm_phase<pg8::EpiPlain, pg8::StaticOrder, G_ALIGN, G_SP2>(F.lds + RING_OFF, g2, S2, E2, F.tid);
                }
            }
        }
        SEAM(pb + 0);
        if (IN(pb + 1)) {
            CArgs* ap = fresh_args(); unsigned char* ws = ap->ws; Frame F = make_frame(L, wave_s);
            for (int rep = 0; rep < REP_T2; ++rep) {
            qk_norm_rope_pass(F, WSP(WS_Q), WSP(WS_K), WSP(WS_Q2), WSP(WS_K2), ap->in[3] + l * HD, ap->in[4] + l * HD, (const float*)(ws + WS_ROPE));
            pool_delta_pass(F, WSP(WS_U), WSP(WS_DL)); }
            if (JIT_CONV) CONVERT(l, CO_POOL, CO_OUT);
        }
        SEAM(pb + 1);
        if (IN(pb + 2)) {
            CArgs* ap = fresh_args(); unsigned char* ws = ap->ws; Frame F = make_frame(L, wave_s);
            bool bounded;
            { const float* qn = ap->in[3] + l * HD; const float* kn = ap->in[4] + l * HD; float gq = fmaxf(fabsf(qn[F.lane]), fabsf(qn[F.lane + 64])), gk = fmaxf(fabsf(kn[F.lane]), fabsf(kn[F.lane + 64]));
#pragma unroll
              for (int o_ = 1; o_ < 64; o_ <<= 1) { gq = fmaxf(gq, shx(gq, o_, F.lane)); gk = fmaxf(gk, shx(gk, o_, F.lane)); }
              bounded = __builtin_amdgcn_readfirstlane((1.4426950408889634f * 11.313708498984761f * 1.02f * gq * gk <= 60.f) ? 1 : 0) != 0; }
            const bool bnd = ATT_BOUND && bounded;
            for (int rep = 0; rep < REP_ATT; ++rep)
            { const int nU = (F.G == 256) ? 4 : 1;
            for (int U0 = F.vcu; U0 < NH * (S / 256); U0 += F.G * nU) {
                const int a = U0 >> 8, b = (U0 >> 5) & 7, c = U0 & 31, h = 4 * b + a, qb = c, kvh = h >> 2;
                att::attn_ring_body(WSP(WS_Q) + (size_t)qb * 256 * DM + h * HD, WSP(WS_K2) + kvh * HD, WSP(WS_V) + kvh * HD, WSP(WS_O) + (size_t)qb * 256 * DM + h * HD, S, (LAS char*)(F.lds + RING_OFF), F.tid, bnd, qb * 256, ap->in[3] + l * HD, (const float*)(ws + WS_ROPE), nU);
            } }
        }
        const bool pool_local = (N_LAUNCHES == 1) && (gridDim.x == 256);
        if (!pool_local) SEAM(pb + 2);
        if (IN(pb + 3)) {
            CArgs* ap = fresh_args(); unsigned char* ws = ap->ws; Frame F = make_frame(L, wave_s); unsigned char* wl = ws + WS_W + (size_t)l * LW_BYTES;
            pg8::Gemm g{WSP(WS_DL), (const bf16_t*)(wl + LW_POOL), S, DM, PGI, POOLW, PGI, PGI};
            pg8::EpiPool E{WSP(WS_MG), WSP(WS_O), WSP(WS_GA), WSP(WS_GP), ap->in[6] + (size_t)l * DM, DM};
            if (pool_local) {
                asm volatile("s_waitcnt vmcnt(0)" ::: "memory"); __syncthreads();
                if (F.tid == 0) { __builtin_amdgcn_fence(__ATOMIC_ACQUIRE, "agent"); asm volatile("s_waitcnt vmcnt(0)" ::: "memory"); }
                __syncthreads();
                pg8::PoolOrder Po{F.vcu & 31, 2 * ((F.vcu >> 5) & 7)};
                pg8::gemm_phase<pg8::EpiPool, pg8::PoolOrder, G_ALIGN, G_SP2>(F.lds + RING_OFF, g, Po, E, F.tid);
            } else {
                pg8::StaticOrder So; So.init(S, DM, F.G, F.bx);
                pg8::gemm_phase<pg8::EpiPool, pg8::StaticOrder, G_ALIGN, G_SP2>(F.lds + RING_OFF, g, So, E, F.tid);
            }
            if (JIT_CONV) CONVERT(l, CO_OUT, CO_GATE);
        }
        SEAM(pb + 3);
        if (IN(pb + 4)) {
            CArgs* ap = fresh_args(); unsigned char* ws = ap->ws; Frame F = make_frame(L, wave_s); unsigned char* wl = ws + WS_W + (size_t)l * LW_BYTES;
            pg8::Gemm g{WSP(WS_MG), (const bf16_t*)(wl + LW_OUT), S, DM, DM, DM, DM, 0}; pg8::StaticOrder So; So.init(S, DM, F.G, F.bx);
            pg8::EpiPlain E{WSP(WS_Y), YP};
            for (int rep = 0; rep < REP_SMALLG; ++rep)
            pg8::gemm_phase<pg8::EpiPlain, pg8::StaticOrder, G_ALIGN, G_SP2>(F.lds + RING_OFF, g, So, E, F.tid);
        }
        SEAM(pb + 4);
        if (IN(pb + 5)) {
            CArgs* ap = fresh_args(); unsigned char* ws = ap->ws; Frame F = make_frame(L, wave_s);
            norm_pass(F, l == 0 ? ap->in[0] : nullptr, WSP(WS_X16), WSP(WS_Y), ap->in[9] + (size_t)l * DM, WSP(WS_X16), nullptr, ap->in[10] + (size_t)l * DM, WSP(WS_H));
            if (JIT_CONV) CONVERT(l, CO_GATE, CO_DOWN);
        }
        SEAM(pb + 5);
        if (IN(pb + 6)) {
            CArgs* ap = fresh_args(); unsigned char* ws = ap->ws; Frame F = make_frame(L, wave_s); unsigned char* wl = ws + WS_W + (size_t)l * LW_BYTES;
            pg8::Gemm g{WSP(WS_H), (const bf16_t*)(wl + LW_GU), S, 2 * FF, DM, DM, DM, 0}; pg8::StaticOrder So; So.init(S, 2 * FF, F.G, F.bx);
            pg8::EpiSwiglu E{WSP(WS_F), FF};
            for (int rep = 0; rep < REP_G3; ++rep)
            pg8::gemm_phase<pg8::EpiSwiglu, pg8::StaticOrder, G_ALIGN, G_SP2>(F.lds + RING_OFF, g, So, E, F.tid);
            if (JIT_CONV) convert_range_dyn(ap, ws, L, F.wave, F.lane, l * CI_LAYER + CO_DOWN, l * CI_LAYER + CO_PIN, (unsigned*)(ws + WS_CTL) + CW_QUEUE + 64 * l);
        }
        SEAM(pb + 6);
        if (IN(pb + 7)) {
            CArgs* ap = fresh_args(); unsigned char* ws = ap->ws; Frame F = make_frame(L, wave_s); unsigned char* wl = ws + WS_W + (size_t)l * LW_BYTES;
            pg8::Gemm g{WSP(WS_F), (const bf16_t*)(wl + LW_DOWN), S, DM, FF, FF, FF, 0}; pg8::StaticOrder So; So.init(S, DM, F.G, F.bx);
            pg8::EpiPlain E{WSP(WS_Y), YP};
            pg8::gemm_phase<pg8::EpiPlain, pg8::StaticOrder, G_ALIGN, G_SP2>(F.lds + RING_OFF, g, So, E, F.tid);
#if REP_G4 > 1
            pg8::gemm_phase<pg8::EpiPlain, pg8::StaticOrder, G_ALIGN, G_SP2>(F.lds + RING_OFF, g, So, E, F.tid);
#endif
        }
        SEAM(pb + 7);
        if (IN(pb + 8)) {
            CArgs* ap = fresh_args(); unsigned char* ws = ap->ws; Frame F = make_frame(L, wave_s);
            norm_pass(F, nullptr, WSP(WS_X16), WSP(WS_Y), ap->in[11] + (size_t)l * DM, WSP(WS_X16), nullptr, nullptr, nullptr);
            if (JIT_CONV) CONVERT(l, CO_PIN, CI_LAYER);
        }
        SEAM(pb + 8);
        if (IN(pb + 9)) {
            CArgs* ap = fresh_args(); unsigned char* ws = ap->ws; Frame F = make_frame(L, wave_s); unsigned char* wl = ws + WS_W + (size_t)l * LW_BYTES;
            pg8::Gemm g{WSP(WS_X16), (const bf16_t*)(wl + LW_PG), S, DM, DM, DM, DM, 0}; pg8::StaticOrder So; So.init(S, DM, F.G, F.bx);
            pg8::EpiPle E{WSP(WS_Y), WSP(WS_E) + (size_t)l * S * DM, DM, YP};
            if (JIT_CONV) {
                pg8::Gemm g2{WSP(WS_PB) + (size_t)l * S * DPLE, (const bf16_t*)(wl + LW_PIN), S, DM, DPLE, DPLE, DPLE, 0};
                pg8::EpiPlain E2{WSP(WS_E) + (size_t)l * S * DM, DM};
                pg8::gemm_phase<pg8::EpiPlain, pg8::StaticOrder, G_ALIGN, G_SP2>(F.lds + RING_OFF, g2, So, E2, F.tid);
            }
            for (int rep = 0; rep < REP_SMALLG; ++rep)
            pg8::gemm_phase<pg8::EpiPle, pg8::StaticOrder, G_ALIGN, G_SP2>(F.lds + RING_OFF, g, So, E, F.tid);
        }
        SEAM(pb + 9);
        if (IN(pb + 10)) {
            CArgs* ap = fresh_args(); unsigned char* ws = ap->ws; Frame F = make_frame(L, wave_s);
            if (l + 1 < DEPTH) norm_pass(F, nullptr, WSP(WS_X16), WSP(WS_Y), ap->in[17] + (size_t)l * DM, WSP(WS_X16), nullptr, ap->in[8] + (size_t)(l + 1) * DM, WSP(WS_H));
            else norm_pass(F, nullptr, WSP(WS_X16), WSP(WS_Y), ap->in[17] + (size_t)l * DM, nullptr, ap->out, nullptr, nullptr);
            if (JIT_CONV && l + 1 < DEPTH) CONVERT(l + 1, 0, CI_IN);
        }
        SEAM(pb + 10);
    }
#if SKEW_PROBE
    { unsigned* acc = (unsigned*)(args.ws + WS_CTL) + 64;
      unsigned m_ = ~0u; const bool t0 = (wave_s == 0 && __builtin_amdgcn_mbcnt_hi(m_, __builtin_amdgcn_mbcnt_lo(m_, 0u)) == 0u);
      if (t0) atomicAdd(acc, (unsigned)(wait_ticks / 16));
      xcd_barrier(bar, wave_s);
      if (t0 && blockIdx.x == 0) { const unsigned tot = __hip_atomic_load(acc, __ATOMIC_RELAXED, __HIP_MEMORY_SCOPE_AGENT); args.out[0] += (float)tot * 16.f / 100.f / (float)gridDim.x; } }
#endif
#undef IN
#undef SEAM
#undef GRID_BAR
}

extern "C" void kernel_launch(void* const* d_in, const int* in_sizes, int n_in, void* d_out, int out_size, void* d_ws, size_t ws_size, hipStream_t stream) {
    static int grid = 0;
    if (grid == 0) {
        if (n_in != 18 || in_sizes[0] != S * DM || out_size != S * DM || ws_size < WS_END) { fprintf(stderr, "kernel_launch: shape/workspace mismatch: n_in %d in0 %d out %d ws %zu (need %zu)\n", n_in, n_in > 0 ? in_sizes[0] : -1, out_size, ws_size, (size_t)WS_END); grid = -1; return; }
        int dev = 0, cus = 0, per_cu = 0;
        if (hipGetDevice(&dev) != hipSuccess || hipDeviceGetAttribute(&cus, hipDeviceAttributeMultiprocessorCount, dev) != hipSuccess) { grid = -1; return; }
        if (hipFuncSetAttribute((const void*)fwd_kernel, hipFuncAttributeMaxDynamicSharedMemorySize, LDS_BYTES) != hipSuccess) { fprintf(stderr, "kernel_launch: hipFuncSetAttribute failed\n"); grid = -1; return; }
        if (hipOccupancyMaxActiveBlocksPerMultiprocessor(&per_cu, (const void*)fwd_kernel, NWAVES * 64, LDS_BYTES) != hipSuccess || per_cu < 1) { fprintf(stderr, "kernel_launch: occupancy query says %d blocks per CU\n", per_cu); }
        (void)hipGetLastError();
        grid = cus;
    }
    if (grid < 0) return;
    if (hipMemsetAsync((char*)d_ws + WS_CTL, 0, CTL_ZERO_BYTES, stream) != hipSuccess) return;
    Args a{};
    for (int i = 0; i < 18; ++i) a.in[i] = (const float*)d_in[i];
    a.out = (float*)d_out; a.ws = (unsigned char*)d_ws;
    for (int li = 0; li < N_LAUNCHES; ++li) {
        a.ph_lo = (N_LAUNCHES == 1) ? 0 : li; a.ph_hi = (N_LAUNCHES == 1) ? N_PHASES : li + 1;
        hipLaunchKernelGGL(fwd_kernel, dim3(grid), dim3(NWAVES * 64), LDS_BYTES, stream, a);
        const hipError_t le = hipPeekAtLastError();
        if (le != hipSuccess) { fprintf(stderr, "kernel_launch: launch %d failed: %s\n", li, hipGetErrorName(le)); break; }
    }
}
```

```cpp
#include <hip/hip_runtime.h>
#include <cstdio>
#include <cstdint>

#ifndef MK_N_LAUNCHES
#define MK_N_LAUNCHES 1
#endif

#ifndef G_SP2
#define G_SP2 true
#endif
#ifndef G_ALIGN
#define G_ALIGN true
#endif
#ifndef SKEW_PROBE
#define SKEW_PROBE 0
#endif
#ifndef YP
#define YP 4096
#endif
#ifndef NT_CONV
#define NT_CONV 1
#endif
#ifndef REP_E
#define REP_E 1
#endif
#ifndef JIT_CONV
#define JIT_CONV 1
#endif
#ifndef G_STAG
#define G_STAG 0
#endif
#ifndef ATT_BOUND
#define ATT_BOUND 1
#endif
#ifndef NT_STORE
#define NT_STORE 0
#endif
#ifndef REP_BAR
#define REP_BAR 1
#endif
#ifndef REP_CONV
#define REP_CONV 1
#endif
#ifndef REP_G1
#define REP_G1 1
#endif
#ifndef REP_ATT
#define REP_ATT 1
#endif
#ifndef REP_G3
#define REP_G3 1
#endif
#ifndef ATT_REBAL
#define ATT_REBAL 1
#endif
#ifndef REP_G4
#define REP_G4 1
#endif
#ifndef REP_T2
#define REP_T2 1
#endif
#ifndef REP_THIN
#define REP_THIN 1
#endif
#ifndef REP_SMALLG
#define REP_SMALLG 1
#endif

#define LAS __attribute__((address_space(3)))
#define GAS __attribute__((address_space(1)))
typedef unsigned short bf16_t;
typedef short bf16x8 __attribute__((ext_vector_type(8)));
typedef short s16x4 __attribute__((ext_vector_type(4)));
typedef float f32x4 __attribute__((ext_vector_type(4)));
typedef float f32x2 __attribute__((ext_vector_type(2)));
typedef float f32x16 __attribute__((ext_vector_type(16)));
typedef unsigned u32x4 __attribute__((ext_vector_type(4)));
typedef unsigned u32x2 __attribute__((ext_vector_type(2)));

constexpr int S = 8192, DM = 4096, DEPTH = 2;
constexpr int NH = 32, NKV = 8, HD = 128;
constexpr int KVW = NKV * HD;
constexpr int POOLW = 2048, PGI = 512, PGO = 1024;
constexpr int INW = 16384;
constexpr int FF = 11008;
constexpr int DPLE = 256;
constexpr float EPS = 1e-6f;

__device__ __forceinline__ unsigned cvt_pk_bf16(float lo, float hi) { unsigned r; asm volatile("v_cvt_pk_bf16_f32 %0, %1, %2" : "=v"(r) : "v"(lo), "v"(hi)); return r; }
__device__ __forceinline__ float bf_lo(unsigned w) { return __uint_as_float(w << 16); }
__device__ __forceinline__ float bf_hi(unsigned w) { return __uint_as_float(w & 0xffff0000u); }
__device__ __forceinline__ float sigmoid_f(float v) { return __builtin_amdgcn_rcpf(1.0f + __builtin_amdgcn_exp2f(v * -1.4426950408889634f)); }

namespace pg8 {
constexpr int BM = 256, BK = 64, HALF = 128, HTB = HALF * BK * 2  , STAGE_BYTES = 8 * HTB, NXCD = 8, WGM = 8;

__host__ __device__ __forceinline__ int lds_byte(int r, int c) { const int st = (r >> 4) * 2 + (c >> 5), rr = r & 15, cc = c & 31, ob = rr * 64 + cc * 2; return st * 1024 + (ob ^ (((ob >> 9) & 1) << 5)); }
__host__ __device__ __forceinline__ void stage_rc(int b, int& R, int& C) { const int st = b / 1024, sb = b % 1024, swz = sb ^ (((sb >> 9) & 1) << 5); R = (st >> 1) * 16 + swz / 64; C = (st & 1) * 32 + (swz % 64) / 2; }
__host__ __device__ __forceinline__ int perm32(int rho) { const int n = rho >> 4, i = rho & 15; return 8 * (i >> 2) + 4 * n + (i & 3); }

struct Unit { int pm, pn; };
struct Gemm { const bf16_t* A; const bf16_t* Bt; int M, N, K, lda, ldb, agrp; };

struct StaticOrder {
    int nM, nN, nwg, G, c;
    __host__ __device__ void init(int M, int N, int G_, int c_) { nM = M / BM; nN = N / BM; nwg = nM * nN; G = G_; c = c_; }
    __host__ __device__ bool next(int i, Unit& u) const {
        const long L = (long)i * G + c; if (L >= nwg) return false;
        int wgid = (int)L; { const int q = nwg / NXCD, r = nwg % NXCD, xcd = wgid % NXCD, off = wgid / NXCD; wgid = (xcd < r ? xcd * (q + 1) : r * (q + 1) + (xcd - r) * q) + off; }
        const int nig = WGM * nN, gid = wgid / nig, fm = gid * WGM, gsz = (nM - fm) < WGM ? (nM - fm) : WGM;
        u.pm = fm + ((wgid % nig) % gsz); u.pn = (wgid % nig) / gsz; return true;
    }
    __device__ __forceinline__ void a_ready(const Unit&) const {}
    __device__ __forceinline__ void done(const Unit&) const {}
};

struct PoolOrder {
    int pm, pn0;
    __device__ __forceinline__ bool next(int i, Unit& u) const { if (i >= 2) return false; u.pm = pm; u.pn = pn0 + i; return true; }
    __device__ __forceinline__ void a_ready(const Unit&) const {}
    __device__ __forceinline__ void done(const Unit&) const {}
};
__device__ __forceinline__ u32x4 pack8(const f32x4 v0, const f32x4 v1) { u32x4 w; w.x = cvt_pk_bf16(v0[0], v0[1]); w.y = cvt_pk_bf16(v0[2], v0[3]); w.z = cvt_pk_bf16(v1[0], v1[1]); w.w = cvt_pk_bf16(v1[2], v1[3]); return w; }

__device__ __forceinline__ void st16(bf16_t* p, const u32x4 v) {
#if NT_STORE
    __builtin_nontemporal_store(v, (u32x4*)p);
#else
    *(u32x4*)p = v;
#endif
}
struct EpiPlain {
    static constexpr bool PERM = true, AFTER_DRAIN = false;
    bf16_t* O; int ldc;
    __device__ __forceinline__ void operator()(const f32x4 (&acc)[2][2][4][2], const Unit& u, int wr, int wc, int fr, int fq) const {
        const int row0 = u.pm * BM + wr * 64 + fr, col0 = u.pn * BM + wc * 32 + 8 * fq;
#pragma unroll
        for (int ai = 0; ai < 2; ++ai)
#pragma unroll
            for (int m = 0; m < 4; ++m) { bf16_t* rowp = O + (size_t)(row0 + ai * HALF + m * 16) * ldc + col0;
#pragma unroll
                for (int bj = 0; bj < 2; ++bj) *(u32x4*)(rowp + bj * HALF) = pack8(acc[ai][bj][m][0], acc[ai][bj][m][1]); }
    }
};
struct EpiZ {
    static constexpr bool PERM = true, AFTER_DRAIN = false;
    bf16_t *Q, *Kb, *Vb, *U, *GA, *GP;
    __device__ __forceinline__ void operator()(const f32x4 (&acc)[2][2][4][2], const Unit& u, int wr, int wc, int fr, int fq) const {
        const int pn = u.pn; bf16_t* base; int ldc, ct; bool sg = false;
        if (pn < 16)      { base = Q;  ldc = DM;    ct = pn; }
        else if (pn < 20) { base = Kb; ldc = KVW;   ct = pn - 16; }
        else if (pn < 24) { base = Vb; ldc = KVW;   ct = pn - 20; }
        else if (pn < 32) { base = U;  ldc = POOLW; ct = pn - 24; }
        else if (pn < 48) { base = GA; ldc = DM;    ct = pn - 32; sg = true; }
        else              { base = GP; ldc = DM;    ct = pn - 48; sg = true; }
        const int row0 = u.pm * BM + wr * 64 + fr, col0 = ct * BM + wc * 32 + 8 * fq;
#pragma unroll
        for (int ai = 0; ai < 2; ++ai)
#pragma unroll
            for (int m = 0; m < 4; ++m) { bf16_t* rowp = base + (size_t)(row0 + ai * HALF + m * 16) * ldc + col0;
#pragma unroll
                for (int bj = 0; bj < 2; ++bj) { f32x4 v0 = acc[ai][bj][m][0], v1 = acc[ai][bj][m][1];
                    if (sg) {
                        unsigned w0 = 0u, w1 = 0u;
#pragma unroll
                        for (int j = 0; j < 4; ++j) { w0 = __builtin_amdgcn_cvt_pk_u8_f32(sigmoid_f(v0[j]) * 255.f, j, w0); w1 = __builtin_amdgcn_cvt_pk_u8_f32(sigmoid_f(v1[j]) * 255.f, j, w1); }
                        u32x2 w; w.x = w0; w.y = w1;
                        *(u32x2*)((unsigned char*)base + (size_t)(row0 + ai * HALF + m * 16) * ldc + col0 + bj * HALF) = w;
                    } else st16(rowp + bj * HALF, pack8(v0, v1)); } }
    }
};
struct EpiSwiglu {
    static constexpr bool PERM = true, AFTER_DRAIN = false;
    bf16_t* F; int ldc;
    __device__ __forceinline__ void operator()(const f32x4 (&acc)[2][2][4][2], const Unit& u, int wr, int wc, int fr, int fq) const {
        const int row0 = u.pm * BM + wr * 64 + fr, col0 = u.pn * HALF + wc * 32 + 8 * fq;
#pragma unroll
        for (int ai = 0; ai < 2; ++ai)
#pragma unroll
            for (int m = 0; m < 4; ++m) { bf16_t* rowp = F + (size_t)(row0 + ai * HALF + m * 16) * ldc + col0;
                f32x4 v0, v1;
#pragma unroll
                for (int j = 0; j < 4; ++j) { const float g0 = acc[ai][0][m][0][j], g1 = acc[ai][0][m][1][j];
                    v0[j] = g0 * sigmoid_f(g0) * acc[ai][1][m][0][j]; v1[j] = g1 * sigmoid_f(g1) * acc[ai][1][m][1][j]; }
                *(u32x4*)rowp = pack8(v0, v1); }
    }
};
__device__ __forceinline__ void unpack8(const u32x4 w, f32x4& a, f32x4& b) { a[0] = bf_lo(w.x); a[1] = bf_hi(w.x); a[2] = bf_lo(w.y); a[3] = bf_hi(w.y); b[0] = bf_lo(w.z); b[1] = bf_hi(w.z); b[2] = bf_lo(w.w); b[3] = bf_hi(w.w); }
struct EpiPle {
    static constexpr bool PERM = true, AFTER_DRAIN = false;
    bf16_t* Y; const bf16_t* E; int ldc; int ldy;
    __device__ __forceinline__ void operator()(const f32x4 (&acc)[2][2][4][2], const Unit& u, int wr, int wc, int fr, int fq) const {
        const int row0 = u.pm * BM + wr * 64 + fr, col0 = u.pn * BM + wc * 32 + 8 * fq;
#pragma unroll
        for (int ai = 0; ai < 2; ++ai)
#pragma unroll
            for (int m = 0; m < 4; ++m) { const size_t off = (size_t)(row0 + ai * HALF + m * 16) * ldc + col0, offy = (size_t)(row0 + ai * HALF + m * 16) * ldy + col0;
#pragma unroll
                for (int bj = 0; bj < 2; ++bj) { const u32x4 ew = *(const u32x4*)(E + off + bj * HALF); f32x4 e0, e1; unpack8(ew, e0, e1);
                    f32x4 v0 = acc[ai][bj][m][0], v1 = acc[ai][bj][m][1];
#pragma unroll
                    for (int j = 0; j < 4; ++j) { v0[j] = sigmoid_f(v0[j]) * e0[j]; v1[j] = sigmoid_f(v1[j]) * e1[j]; }
                    *(u32x4*)(Y + offy + bj * HALF) = pack8(v0, v1); }
                asm volatile("" ::: "memory"); }
    }
};
__device__ __forceinline__ void unq8(const u32x2 w, f32x4& a, f32x4& b) { constexpr float q = 1.0f / 255.0f;
    a[0] = (float)(w.x & 0xffu) * q; a[1] = (float)((w.x >> 8) & 0xffu) * q; a[2] = (float)((w.x >> 16) & 0xffu) * q; a[3] = (float)(w.x >> 24) * q;
    b[0] = (float)(w.y & 0xffu) * q; b[1] = (float)((w.y >> 8) & 0xffu) * q; b[2] = (float)((w.y >> 16) & 0xffu) * q; b[3] = (float)(w.y >> 24) * q; }
struct EpiPool {
    static constexpr bool PERM = true, AFTER_DRAIN = false;
    bf16_t* MG; const bf16_t *O, *GA, *GP; const float* ps; int ldc;
    __device__ __forceinline__ void operator()(const f32x4 (&acc)[2][2][4][2], const Unit& u, int wr, int wc, int fr, int fq) const {
        const int row0 = u.pm * BM + wr * 64 + fr, col0 = u.pn * BM + wc * 32 + 8 * fq;
        f32x4 pv[2][2];
#pragma unroll
        for (int bj = 0; bj < 2; ++bj)
#pragma unroll
            for (int n = 0; n < 2; ++n) pv[bj][n] = *(const f32x4*)(ps + col0 + bj * HALF + 4 * n);
#pragma unroll
        for (int ai = 0; ai < 2; ++ai)
#pragma unroll
            for (int m = 0; m < 4; ++m) { const size_t off = (size_t)(row0 + ai * HALF + m * 16) * ldc + col0;
#pragma unroll
                for (int bj = 0; bj < 2; ++bj) {
                    const u32x4 ow = *(const u32x4*)(O + off + bj * HALF); const u32x2 aw = *(const u32x2*)((const unsigned char*)GA + off + bj * HALF), pw = *(const u32x2*)((const unsigned char*)GP + off + bj * HALF);
                    f32x4 o0, o1, a0, a1, p0, p1; unpack8(ow, o0, o1); unq8(aw, a0, a1); unq8(pw, p0, p1);
                    const f32x4 v0 = a0 * o0 + p0 * (acc[ai][bj][m][0] * pv[bj][0]), v1 = a1 * o1 + p1 * (acc[ai][bj][m][1] * pv[bj][1]);
                    *(u32x4*)(MG + off + bj * HALF) = pack8(v0, v1); }
                asm volatile("" ::: "memory"); }
    }
};

template <class Epi, class Sched, bool ALIGN_EPI = false, bool SP2 = false>
__device__ __forceinline__ void gemm_phase(LAS unsigned char* lds, const Gemm g, const Sched& S, const Epi& E, const int tid_in) {
    int tid_ = tid_in; asm volatile("" : "+v"(tid_));
    const int tid = tid_, wid = __builtin_amdgcn_readfirstlane(tid >> 6), lane = tid & 63, wr = wid >> 2, wc = wid & 3, fr = lane & 15, fq = lane >> 4;
    const int K = g.K, nt = K / BK;
    unsigned voffA[2], voffB[2];
#pragma unroll
    for (int i = 0; i < 2; ++i) { int R, C; stage_rc(tid * 16 + i * 8192, R, C); const int Rb = Epi::PERM ? ((R & ~31) + perm32(R & 31)) : R;
        voffA[i] = (unsigned)(R * g.lda + C) * 2u; voffB[i] = (unsigned)(Rb * g.ldb + C) * 2u; }
    const size_t kstep = (size_t)(BK * 2);
    const size_t hstepA = (size_t)HALF * g.lda * 2, hstepB = (size_t)HALF * g.ldb * 2;
    const size_t tstepA = 2 * hstepA, tstepB = 2 * hstepB;
    const unsigned ldsw = (unsigned)wid * 1024u;
    const int aoff = lds_byte(wr * 64 + fr, fq * 8), boff = lds_byte(wc * 32 + fr, fq * 8);
#define PG8_SA(b, h) (((b) * 2 + (h)) * HTB)
#define PG8_SB(b, h) ((4 + (b) * 2 + (h)) * HTB)
#define PG8_STAGE(bufoff, gbase, voff) do { _Pragma("unroll") for (int _i = 0; _i < 2; ++_i) \
        __builtin_amdgcn_global_load_lds((const unsigned*)((const char*)(gbase) + (voff)[_i]), (LAS unsigned*)(lds + (bufoff) + ldsw + _i * 8192), 16, 0, 0); } while (0)
#define PG8_LDA(dst, b, h) do { _Pragma("unroll") for (int m = 0; m < 4; ++m) _Pragma("unroll") for (int k = 0; k < 2; ++k) dst[m][k] = *(const LAS bf16x8*)(lds + PG8_SA(b, h) + aoff + m * 2048 + k * 1024); } while (0)
#define PG8_LDB(dst, b, h) do { _Pragma("unroll") for (int n = 0; n < 2; ++n) _Pragma("unroll") for (int k = 0; k < 2; ++k) dst[n][k] = *(const LAS bf16x8*)(lds + PG8_SB(b, h) + boff + n * 2048 + k * 1024); } while (0)
#define PG8_MMA(ai, bj, At, Bt) do { __builtin_amdgcn_s_setprio(1); _Pragma("unroll") for (int k = 0; k < 2; ++k) _Pragma("unroll") for (int m = 0; m < 4; ++m) _Pragma("unroll") for (int n = 0; n < 2; ++n) \
        acc[ai][bj][m][n] = __builtin_amdgcn_mfma_f32_16x16x32_bf16(Bt[n][k], At[m][k], acc[ai][bj][m][n], 0, 0, 0); __builtin_amdgcn_s_setprio(0); } while (0)
#define PG8_WAIT_V(n) asm volatile("s_waitcnt vmcnt(" #n ")" ::: "memory")
#define PG8_WAIT_L(n) asm volatile("s_waitcnt lgkmcnt(" #n ")" ::: "memory")
#define PG8_BAR __builtin_amdgcn_s_barrier()
#define PG8_SCHED __builtin_amdgcn_sched_barrier(0)
    Unit cur, nxt; int ui = 0;
    if (!S.next(0, cur)) return;
    if (G_STAG > 0) { const unsigned long long t0_ = __builtin_amdgcn_s_memrealtime(); const unsigned long long d_ = (unsigned long long)((tid_in & 0) * G_STAG);
        while (__builtin_amdgcn_s_memrealtime() - t0_ < d_) __builtin_amdgcn_s_sleep(4); }
    f32x4 acc[2][2][4][2];
#pragma unroll
    for (int a = 0; a < 2; ++a)
#pragma unroll
        for (int b = 0; b < 2; ++b)
#pragma unroll
            for (int m = 0; m < 4; ++m)
#pragma unroll
                for (int n = 0; n < 2; ++n) acc[a][b][m][n] = (f32x4){0.f, 0.f, 0.f, 0.f};
    bf16x8 At[4][2], B0[2][2], B1[2][2];
    const char* cA = (const char*)g.A + (size_t)cur.pm * tstepA + (size_t)(cur.pn >> 2) * g.agrp * 2; const char* cB = (const char*)g.Bt + (size_t)cur.pn * tstepB;
    S.a_ready(cur);
    if constexpr (SP2) {
        PG8_STAGE(PG8_SB(0, 0), cB, voffB); PG8_STAGE(PG8_SB(0, 1), cB + hstepB, voffB); PG8_STAGE(PG8_SA(0, 0), cA, voffA); PG8_STAGE(PG8_SA(0, 1), cA + hstepA, voffA);
        if (wr == 1) PG8_BAR;
        PG8_WAIT_V(2); PG8_BAR;
        PG8_STAGE(PG8_SB(1, 0), cB + kstep, voffB); PG8_STAGE(PG8_SA(1, 0), cA + kstep, voffA); PG8_STAGE(PG8_SB(1, 1), cB + hstepB + kstep, voffB);
        PG8_WAIT_V(6); PG8_BAR;
    } else {
        PG8_STAGE(PG8_SB(0, 0), cB, voffB); PG8_STAGE(PG8_SA(0, 0), cA, voffA); PG8_STAGE(PG8_SB(0, 1), cB + hstepB, voffB); PG8_STAGE(PG8_SA(0, 1), cA + hstepA, voffA);
        if (wr == 1) PG8_BAR;
        PG8_WAIT_V(4); PG8_BAR;
        PG8_STAGE(PG8_SB(1, 0), cB + kstep, voffB); PG8_STAGE(PG8_SA(1, 0), cA + kstep, voffA); PG8_STAGE(PG8_SB(1, 1), cB + hstepB + kstep, voffB);
        PG8_WAIT_V(6); PG8_BAR;
    }
    for (;;) {
        const bool has_next = S.next(ui + 1, nxt);
        const char* nA = has_next ? (const char*)g.A + (size_t)nxt.pm * tstepA + (size_t)(nxt.pn >> 2) * g.agrp * 2 : cA; const char* nB = has_next ? (const char*)g.Bt + (size_t)nxt.pn * tstepB : cB;
        for (int t = 0; t < nt; t += 2) {
            const bool last = (t == nt - 2);
            const char* a1 = cA + (size_t)(t + 1) * kstep;
            const char* a2 = last ? nA : cA + (size_t)(t + 2) * kstep; const char* b2 = last ? nB : cB + (size_t)(t + 2) * kstep;
            const char* a3 = a2 + kstep; const char* b3 = b2 + kstep;
            if (last && has_next) S.a_ready(nxt);
            if constexpr (SP2) {
            PG8_LDB(B0, 0, 0); PG8_LDB(B1, 0, 1); PG8_SCHED; PG8_LDA(At, 0, 0); PG8_STAGE(PG8_SA(1, 1), a1 + hstepA, voffA);
            PG8_WAIT_V(8); PG8_WAIT_L(0); PG8_BAR; PG8_MMA(0, 0, At, B0); PG8_MMA(0, 1, At, B1); PG8_BAR; PG8_SCHED;
            PG8_LDA(At, 0, 1); PG8_STAGE(PG8_SB(0, 0), b2, voffB); PG8_STAGE(PG8_SB(0, 1), b2 + hstepB, voffB); PG8_STAGE(PG8_SA(0, 0), a2, voffA);
            PG8_WAIT_V(8); PG8_WAIT_L(0); PG8_BAR; PG8_MMA(1, 0, At, B0); PG8_MMA(1, 1, At, B1); PG8_BAR; PG8_SCHED;
            PG8_LDB(B0, 1, 0); PG8_LDB(B1, 1, 1); PG8_SCHED; PG8_LDA(At, 1, 0); PG8_STAGE(PG8_SA(0, 1), a2 + hstepA, voffA);
            PG8_WAIT_V(8); PG8_WAIT_L(0); PG8_BAR; PG8_MMA(0, 0, At, B0); PG8_MMA(0, 1, At, B1); PG8_BAR; PG8_SCHED;
            PG8_LDA(At, 1, 1); PG8_STAGE(PG8_SB(1, 0), b3, voffB); PG8_STAGE(PG8_SB(1, 1), b3 + hstepB, voffB); PG8_STAGE(PG8_SA(1, 0), a3, voffA);
            PG8_WAIT_V(8); PG8_WAIT_L(0); PG8_BAR; PG8_MMA(1, 0, At, B0); PG8_MMA(1, 1, At, B1); PG8_BAR; PG8_SCHED;
            } else {
            PG8_LDB(B0, 0, 0); PG8_SCHED; PG8_LDA(At, 0, 0); PG8_STAGE(PG8_SA(1, 1), a1 + hstepA, voffA);
            PG8_WAIT_L(8); PG8_BAR; PG8_WAIT_L(0); PG8_MMA(0, 0, At, B0); PG8_BAR; PG8_SCHED;
            PG8_LDB(B1, 0, 1); PG8_STAGE(PG8_SB(0, 0), b2, voffB);
            PG8_BAR; PG8_WAIT_L(0); PG8_MMA(0, 1, At, B1); PG8_BAR;
            PG8_LDA(At, 0, 1); PG8_STAGE(PG8_SA(0, 0), a2, voffA);
            PG8_BAR; PG8_WAIT_L(0); PG8_MMA(1, 0, At, B0); PG8_BAR; PG8_SCHED;
            PG8_STAGE(PG8_SB(0, 1), b2 + hstepB, voffB);
            PG8_WAIT_V(6); PG8_BAR; PG8_MMA(1, 1, At, B1); PG8_BAR;
            PG8_LDB(B0, 1, 0); PG8_SCHED; PG8_LDA(At, 1, 0); PG8_STAGE(PG8_SA(0, 1), a2 + hstepA, voffA);
            PG8_WAIT_L(8); PG8_BAR; PG8_WAIT_L(0); PG8_MMA(0, 0, At, B0); PG8_BAR; PG8_SCHED;
            PG8_LDB(B1, 1, 1); PG8_STAGE(PG8_SB(1, 0), b3, voffB);
            PG8_BAR; PG8_WAIT_L(0); PG8_MMA(0, 1, At, B1); PG8_BAR;
            PG8_LDA(At, 1, 1); PG8_STAGE(PG8_SA(1, 0), a3, voffA);
            PG8_BAR; PG8_WAIT_L(0); PG8_MMA(1, 0, At, B0); PG8_BAR; PG8_SCHED;
            PG8_STAGE(PG8_SB(1, 1), b3 + hstepB, voffB);
            PG8_WAIT_V(6); PG8_BAR; PG8_MMA(1, 1, At, B1); PG8_BAR;
            }
        }
        if constexpr (ALIGN_EPI) { if (wr == 0) PG8_BAR; }
        E(acc, cur, wr, wc, fr, fq); S.done(cur);
        if (!has_next) break;
#pragma unroll
        for (int a = 0; a < 2; ++a)
#pragma unroll
            for (int b = 0; b < 2; ++b)
#pragma unroll
                for (int m = 0; m < 4; ++m)
#pragma unroll
                    for (int n = 0; n < 2; ++n) acc[a][b][m][n] = (f32x4){0.f, 0.f, 0.f, 0.f};
        cur = nxt; cA = nA; cB = nB; ++ui;
        if constexpr (ALIGN_EPI) { if (wr == 1) PG8_BAR; }
    }
    PG8_WAIT_V(0);
    if constexpr (!ALIGN_EPI) { if (wr == 0) PG8_BAR; }
    PG8_BAR;
#undef PG8_SA
#undef PG8_SB
#undef PG8_STAGE
#undef PG8_LDA
#undef PG8_LDB
#undef PG8_MMA
#undef PG8_WAIT_V
#undef PG8_WAIT_L
#undef PG8_BAR
#undef PG8_SCHED
}
}

namespace att {
constexpr int D = 128, NW = 8, QBLK = 32, KVBLK = 64;
constexpr float SCALE = 0.088388347648318440f;
constexpr int LDQ = DM, LDK = KVW, LDO = DM;
constexpr int SHM_V = KVBLK * D * 2, SHM_K = KVBLK * D * 2, SHM_ATTN = 2 * SHM_V + 2 * SHM_K + NW * 64 * 4;
#define KSWZ(row, colB) ((row) * 256 + ((colB) ^ (((row) & 7) << 4)))
#define SBAR() __builtin_amdgcn_sched_barrier(0)
__device__ __forceinline__ int crow(int r, int hi) { return (r & 3) + 8 * (r >> 2) + 4 * hi; }
__device__ __forceinline__ unsigned cvtpk(float lo, float hi) { unsigned r; asm volatile("v_cvt_pk_bf16_f32 %0, %1, %2" : "=v"(r) : "v"(lo), "v"(hi)); return r; }

constexpr float THRL = 8.f;
#define MX3(a, b, c) __builtin_fmaxf(__builtin_fmaxf((a), (b)), (c))
template <bool FIRST>
__device__ __forceinline__ bool partialSM(f32x16& p0, f32x16& p1, float& mhat, f32x16& negm, float& l_reg, LAS float* al_l, int r32, int hi) {
  float a = MX3(p0[0], p0[1], p1[0]), b = MX3(p0[2], p0[3], p1[1]); a = MX3(a, p1[2], p1[3]);
#pragma unroll
  for (int r = 4; r < 16; r += 4) { a = MX3(a, p0[r], p0[r + 1]); b = MX3(b, p0[r + 2], p0[r + 3]); a = MX3(a, p1[r], p1[r + 1]); b = MX3(b, p1[r + 2], p1[r + 3]); }
  float rm = __builtin_fmaxf(a, b);
  { auto rr = __builtin_amdgcn_permlane32_swap(__float_as_uint(rm), __float_as_uint(rm), false, false);
    rm = __builtin_fmaxf(__uint_as_float(rr[0]), __uint_as_float(rr[1])); }
  bool resc = false;
  if (FIRST) { const float dl = rm; mhat = dl;
#pragma unroll
    for (int r = 0; r < 16; ++r) { p0[r] -= dl; p1[r] -= dl; }
#pragma unroll
    for (int r = 0; r < 16; ++r) negm[r] = -mhat;
    asm volatile("" : "+v"(negm));
  } else if (__builtin_expect(__any(rm > THRL), 0)) { const float dl = __builtin_fmaxf(rm, 0.f); mhat += dl;
#pragma unroll
    for (int r = 0; r < 16; ++r) { p0[r] -= dl; p1[r] -= dl; }
#pragma unroll
    for (int r = 0; r < 16; ++r) negm[r] = -mhat;
    asm volatile("" : "+v"(negm));
    const float f = __builtin_amdgcn_exp2f(-dl); l_reg *= f; if (hi == 0) al_l[r32] = f; resc = true; }
#pragma unroll
  for (int r = 0; r < 16; ++r) p0[r] = __builtin_amdgcn_exp2f(p0[r]);
  return resc;
}
#undef MX3
template <int R0 = 0>
__device__ __forceinline__ void finishSM(f32x16& p0, f32x16& p1, float& l_reg, bf16x8& pa0, bf16x8& pa1, bf16x8& pa2, bf16x8& pa3) {
#pragma unroll
  for (int r = R0; r < 16; ++r) p1[r] = __builtin_amdgcn_exp2f(p1[r]);
  float ps = 0;
#pragma unroll
  for (int r = 0; r < 16; ++r) ps += p0[r];
#pragma unroll
  for (int r = 0; r < 16; ++r) ps += p1[r];
  l_reg += ps;
#define PK4(P, BASE, OUT) do { unsigned a0 = cvtpk(P[BASE + 0], P[BASE + 1]), a1 = cvtpk(P[BASE + 2], P[BASE + 3]);   \
    unsigned b0 = cvtpk(P[BASE + 4], P[BASE + 5]), b1 = cvtpk(P[BASE + 6], P[BASE + 7]);                              \
    auto r0 = __builtin_amdgcn_permlane32_swap(a0, b0, false, false); auto r1 = __builtin_amdgcn_permlane32_swap(a1, b1, false, false); \
    u32x4 w = {r0[0], r1[0], r0[1], r1[1]}; OUT = *reinterpret_cast<bf16x8*>(&w); } while (0)
  PK4(p0, 0, pa0); PK4(p0, 8, pa1); PK4(p1, 0, pa2); PK4(p1, 8, pa3);
#undef PK4
}
__device__ __forceinline__ void qkt(f32x16& p0, f32x16& p1, const LAS char* Ks, const bf16x8* qr, const f32x16& negm, int r32, int hi) {
#pragma unroll
  for (int d0 = 0; d0 < 8; ++d0) { int cb = (d0 * 16 + hi * 8) * 2;
    bf16x8 b0 = *reinterpret_cast<const LAS bf16x8*>(Ks + KSWZ(r32, cb));
    bf16x8 b1 = *reinterpret_cast<const LAS bf16x8*>(Ks + KSWZ(32 + r32, cb));
    if (d0 == 0) { p0 = __builtin_amdgcn_mfma_f32_32x32x16_bf16(b0, qr[0], negm, 0, 0, 0); p1 = __builtin_amdgcn_mfma_f32_32x32x16_bf16(b1, qr[0], negm, 0, 0, 0); }
    else { p0 = __builtin_amdgcn_mfma_f32_32x32x16_bf16(b0, qr[d0], p0, 0, 0, 0); p1 = __builtin_amdgcn_mfma_f32_32x32x16_bf16(b1, qr[d0], p1, 0, 0, 0); } }
}
__device__ __forceinline__ int v_st(int k, int c) { const int kk = (k & ~0xC) | ((k & 4) << 1) | ((k & 8) >> 1); return ((kk >> 3) * 4 + (c >> 5)) * 512 + ((kk & 7) * 32 + (c & 31)) * 2; }
__device__ __forceinline__ int v_rd_base(int lane) { return ((lane & 3) << 3) | (((lane >> 2) & 3) << 6) | (((lane >> 4) & 1) << 5) | (((lane >> 5) & 1) << 8); }
constexpr int v_rd_off(int d0, int ks, int half) { return d0 * 512 + ks * 4096 + half * 2048; }
template <int OFF> __device__ __forceinline__ s16x4 tr_read(int vb) {
  s16x4 r; asm volatile("ds_read_b64_tr_b16 %0, %1 offset:%2" : "=&v"(r) : "v"(vb), "i"(OFF) : "memory"); return r;
}
template <int D0> __device__ __forceinline__ void pv_one(f32x16& od, int vb, bf16x8 pa0, bf16x8 pa1, bf16x8 pa2, bf16x8 pa3) {
  const s16x4 l0 = tr_read<v_rd_off(D0, 0, 0)>(vb), h0 = tr_read<v_rd_off(D0, 0, 1)>(vb), l1 = tr_read<v_rd_off(D0, 1, 0)>(vb), h1 = tr_read<v_rd_off(D0, 1, 1)>(vb);
  const s16x4 l2 = tr_read<v_rd_off(D0, 2, 0)>(vb), h2 = tr_read<v_rd_off(D0, 2, 1)>(vb), l3 = tr_read<v_rd_off(D0, 3, 0)>(vb), h3 = tr_read<v_rd_off(D0, 3, 1)>(vb);
  asm volatile("s_waitcnt lgkmcnt(0)" ::: "memory"); SBAR();
#define PK(L, H) (bf16x8){L[0], L[1], L[2], L[3], H[0], H[1], H[2], H[3]}
  od = __builtin_amdgcn_mfma_f32_32x32x16_bf16(pa0, PK(l0, h0), od, 0, 0, 0);
  od = __builtin_amdgcn_mfma_f32_32x32x16_bf16(pa1, PK(l1, h1), od, 0, 0, 0);
  od = __builtin_amdgcn_mfma_f32_32x32x16_bf16(pa2, PK(l2, h2), od, 0, 0, 0);
  od = __builtin_amdgcn_mfma_f32_32x32x16_bf16(pa3, PK(l3, h3), od, 0, 0, 0);
#undef PK
}
__device__ __forceinline__ void pv_d0(f32x16* o, int vb, bf16x8 pa0, bf16x8 pa1, bf16x8 pa2, bf16x8 pa3) {
  pv_one<0>(o[0], vb, pa0, pa1, pa2, pa3); pv_one<1>(o[1], vb, pa0, pa1, pa2, pa3); pv_one<2>(o[2], vb, pa0, pa1, pa2, pa3); pv_one<3>(o[3], vb, pa0, pa1, pa2, pa3);
}
__device__ __forceinline__ void attn_dense_body(const bf16_t* __restrict__ Qb, const bf16_t* __restrict__ Kh, const bf16_t* __restrict__ Vh, bf16_t* __restrict__ Ob, int seq, LAS char* lds, const int tid_in) {
  int tid_ = tid_in; asm volatile("" : "+v"(tid_));
  const int tid = tid_, wid = tid >> 6, lane = tid & 63, r32 = lane & 31, hi = lane >> 5;
  LAS char* V_lds = lds; LAS char* K_lds = lds + 2 * SHM_V;
  LAS float* ws = (LAS float*)(lds + 2 * SHM_V + 2 * SHM_K) + wid * 64; LAS float* li_l = ws; LAS float* al_l = ws + 32;
  float mhat = 0.f, l_reg = 0; f32x16 o[4] = {}; bf16x8 qr[8]; f32x16 negm = f32x16{}; asm volatile("" : "+v"(negm));
  const bf16_t* Qw = Qb + (long)(wid * QBLK + r32) * LDQ + hi * 8;
#pragma unroll
  for (int d0 = 0; d0 < 8; ++d0) qr[d0] = *reinterpret_cast<const bf16x8*>(Qw + d0 * 16);
  const int sr = tid >> 4, sc = (tid & 15) * 8, vst0 = v_st(sr, sc), vst1 = v_st(32 + sr, sc);
  const int vb0 = (int)(unsigned)(uintptr_t)V_lds + v_rd_base(lane);
  struct { bf16x8 vs0, vs1, ks0, ks1; } sr_[1];
#define SLOAD(i, k0) do { sr_[i].vs0 = *reinterpret_cast<const bf16x8*>(&Vh[(long)((k0) + sr) * LDK + sc]); sr_[i].vs1 = *reinterpret_cast<const bf16x8*>(&Vh[(long)((k0) + 32 + sr) * LDK + sc]); \
    sr_[i].ks0 = *reinterpret_cast<const bf16x8*>(&Kh[(long)((k0) + sr) * LDK + sc]); sr_[i].ks1 = *reinterpret_cast<const bf16x8*>(&Kh[(long)((k0) + 32 + sr) * LDK + sc]); } while (0)
#define SWRITE(b, i) do { *(LAS bf16x8*)(V_lds + (b) * SHM_V + vst0) = sr_[i].vs0;          \
    *(LAS bf16x8*)(V_lds + (b) * SHM_V + vst1) = sr_[i].vs1; int kc = sc * 2;               \
    *(LAS bf16x8*)(K_lds + (b) * SHM_K + KSWZ(sr, kc)) = sr_[i].ks0;                       \
    *(LAS bf16x8*)(K_lds + (b) * SHM_K + KSWZ(32 + sr, kc)) = sr_[i].ks1; } while (0)
#define SWAIT() asm volatile("s_waitcnt vmcnt(0)" ::: "memory")
#define RESC(fl) do { if (fl) { asm volatile("s_waitcnt lgkmcnt(0)" ::: "memory"); \
    _Pragma("unroll") for (int d = 0; d < 4; ++d) _Pragma("unroll") for (int r = 0; r < 16; ++r) o[d][r] *= al_l[crow(r, hi)]; } } while (0)
  f32x16 pA0, pA1, pB0, pB1; bool rsA, rsB; bf16x8 pa0, pa1, pa2, pa3; const int NT = seq / KVBLK;
  constexpr int SE = 0, SO = 0;
  SLOAD(SE, 0); asm volatile("s_waitcnt vmcnt(0)" ::: "memory"); SWRITE(0, SE); __syncthreads();
  qkt(pA0, pA1, K_lds, qr, negm, r32, hi); (void)partialSM<true>(pA0, pA1, mhat, negm, l_reg, al_l, r32, hi);
  SLOAD(SO, KVBLK);
  SWAIT(); SWRITE(1, SO); __syncthreads();
  for (int j = 1; j + 1 < NT; j += 2) {
    SBAR(); qkt(pB0, pB1, K_lds + SHM_K, qr, negm, r32, hi);
    finishSM(pA0, pA1, l_reg, pa0, pa1, pa2, pa3); SBAR();
    SLOAD(SO, (j + 1) * KVBLK); SBAR();
    pv_d0(o, vb0, pa0, pa1, pa2, pa3); rsB = partialSM<false>(pB0, pB1, mhat, negm, l_reg, al_l, r32, hi);
    __syncthreads(); SWAIT(); SWRITE(0, SE);
    RESC(rsB); __syncthreads();
    SBAR(); qkt(pA0, pA1, K_lds, qr, negm, r32, hi);
    finishSM(pB0, pB1, l_reg, pa0, pa1, pa2, pa3); SBAR();
    SLOAD(SE, (j + 2) * KVBLK); SBAR();
    pv_d0(o, vb0 + SHM_V, pa0, pa1, pa2, pa3); rsA = partialSM<false>(pA0, pA1, mhat, negm, l_reg, al_l, r32, hi);
    __syncthreads(); SWAIT(); SWRITE(1, SO);
    RESC(rsA); __syncthreads();
  }
  SBAR(); qkt(pB0, pB1, K_lds + SHM_K, qr, negm, r32, hi);
  finishSM(pA0, pA1, l_reg, pa0, pa1, pa2, pa3); SBAR();
  pv_d0(o, vb0, pa0, pa1, pa2, pa3); rsB = partialSM<false>(pB0, pB1, mhat, negm, l_reg, al_l, r32, hi);
  __syncthreads(); RESC(rsB);
  finishSM(pB0, pB1, l_reg, pa0, pa1, pa2, pa3); SBAR();
  pv_d0(o, vb0 + SHM_V, pa0, pa1, pa2, pa3);
  { auto rr = __builtin_amdgcn_permlane32_swap(__float_as_uint(l_reg), __float_as_uint(l_reg), false, false); l_reg = __uint_as_float(rr[0]) + __uint_as_float(rr[1]); }
  if (hi == 0) li_l[r32] = l_reg; asm volatile("s_waitcnt lgkmcnt(0)" ::: "memory");
  float rli[16];
#pragma unroll
  for (int r = 0; r < 16; ++r) rli[r] = __builtin_amdgcn_rcpf(li_l[crow(r, hi)]);
  bf16_t* Ow = Ob + (long)(wid * QBLK) * LDO;
#pragma unroll
  for (int r = 0; r < 16; ++r) { const int orow = crow(r, hi);
#pragma unroll
    for (int d0 = 0; d0 < 4; ++d0) { const unsigned w = cvtpk(o[d0][r] * rli[r], 0.f); Ow[(long)orow * LDO + d0 * 32 + r32] = (bf16_t)(w & 0xffffu); } }
#undef SLOAD
#undef SWRITE
#undef SWAIT
#undef RESC
}

template <int OFF> __device__ __forceinline__ bf16x8 lds_rd128(int a) { bf16x8 r; asm volatile("ds_read_b128 %0, %1 offset:%2" : "=&v"(r) : "v"(a), "i"(OFF) : "memory"); return r; }
#define MX3(a, b, c) __builtin_fmaxf(__builtin_fmaxf((a), (b)), (c))
__device__ __forceinline__ bool partialSM_head(f32x16& p0, f32x16& p1, float& mhat, f32x16& negm, float& l_reg, LAS float* al_l, int r32, int hi) {
  float a = MX3(p0[0], p0[1], p1[0]), b = MX3(p0[2], p0[3], p1[1]); a = MX3(a, p1[2], p1[3]);
#pragma unroll
  for (int r = 4; r < 16; r += 4) { a = MX3(a, p0[r], p0[r + 1]); b = MX3(b, p0[r + 2], p0[r + 3]); a = MX3(a, p1[r], p1[r + 1]); b = MX3(b, p1[r + 2], p1[r + 3]); }
  float rm = __builtin_fmaxf(a, b);
  { auto rr = __builtin_amdgcn_permlane32_swap(__float_as_uint(rm), __float_as_uint(rm), false, false);
    rm = __builtin_fmaxf(__uint_as_float(rr[0]), __uint_as_float(rr[1])); }
  bool resc = false;
  if (__builtin_expect(__any(rm > THRL), 0)) { const float dl = __builtin_fmaxf(rm, 0.f); mhat += dl;
#pragma unroll
    for (int r = 0; r < 16; ++r) { p0[r] -= dl; p1[r] -= dl; }
#pragma unroll
    for (int r = 0; r < 16; ++r) negm[r] = -mhat;
    asm volatile("" : "+v"(negm));
    const float f = __builtin_amdgcn_exp2f(-dl); l_reg *= f; if (hi == 0) al_l[r32] = f; resc = true; }
  return resc;
}
#undef MX3
constexpr int RSLOT = 16384, RING_ATTN = 6 * RSLOT + NW * 64 * 4;
__device__ __forceinline__ void attn_ring_body(const bf16_t* __restrict__ Qb, const bf16_t* __restrict__ Kh, const bf16_t* __restrict__ Vh, bf16_t* __restrict__ Ob, int seq, LAS char* lds, const int tid_in, const bool BND, const int row0, const float* __restrict__ qgain, const float* __restrict__ rope, const int nU) {
  int cur = 0, nxt = RSLOT, nn = 2 * RSLOT;
  for (int u = 0; u < nU; ++u, Qb += D, Ob += D) {
  int tid_ = tid_in; asm volatile("" : "+v"(tid_));
  const int tid = tid_, wid = __builtin_amdgcn_readfirstlane(tid >> 6), lane = tid & 63, r32 = lane & 31, hi = lane >> 5;
  LAS char* K_lds = lds; LAS char* V_lds = lds + 3 * RSLOT;
  LAS float* ws = (LAS float*)(lds + 6 * RSLOT) + wid * 64; LAS float* li_l = ws; LAS float* al_l = ws + 32;
  int koff[2], voff[2];
#pragma unroll
  for (int e = 0; e < 2; ++e) { const int i = 2 * wid + e;
    const int krow = 4 * i + (lane >> 4), cp = lane & 15, kc = cp ^ (krow & 7); koff[e] = (krow * LDK + 8 * kc) * 2;
    const int sub = 2 * i + (lane >> 5), q = lane & 31, kk = (sub >> 2) * 8 + (q >> 2), c = (sub & 3) * 32 + (q & 3) * 8, k = (kk & ~0xC) | ((kk & 4) << 1) | ((kk & 8) >> 1); voff[e] = (k * LDK + c) * 2; }
  const unsigned pdst = (unsigned)(2 * wid) * 1024u;
  const __amdgpu_buffer_rsrc_t krs = __builtin_amdgcn_make_buffer_rsrc((void*)Kh, 0, S * LDK * 2, 0x00020000), vrs = __builtin_amdgcn_make_buffer_rsrc((void*)Vh, 0, S * LDK * 2, 0x00020000);
#define DMA_K(t, slot) do { _Pragma("unroll") for (int e = 0; e < 2; ++e) __builtin_amdgcn_raw_ptr_buffer_load_lds(krs, (LAS unsigned*)(K_lds + (slot) + pdst + e * 1024), 16, koff[e], (t) * (KVBLK * LDK * 2), 0, 0); } while (0)
#define DMA_V(t, slot) do { _Pragma("unroll") for (int e = 0; e < 2; ++e) __builtin_amdgcn_raw_ptr_buffer_load_lds(vrs, (LAS unsigned*)(V_lds + (slot) + pdst + e * 1024), 16, voff[e], (t) * (KVBLK * LDK * 2), 0, 0); } while (0)
#define WAIT_BAR(N) asm volatile("s_waitcnt vmcnt(" #N ") lgkmcnt(0)\n\ts_barrier" ::: "memory")
  const int NT = seq / KVBLK;
#define ROT() do { const int t_ = cur; cur = nxt; nxt = nn; nn = t_; } while (0)
  const float* qgain_u = qgain; const float* rope_u = rope; int row0_u = row0; asm volatile("" : "+s"(qgain_u), "+s"(rope_u), "+s"(row0_u));
  if (u == 0) { DMA_K(0, 0); DMA_V(0, 0); DMA_K(1, RSLOT); }
  float mhat = 0.f, l_reg = 0; f32x16 o[4] = {}; bf16x8 qr[8]; f32x16 negm = f32x16{};
  asm volatile("" : "+v"(negm));
  { const bf16_t* Qw = Qb + (long)(wid * QBLK + r32) * LDQ + hi * 8;
    u32x4 raw[8];
#pragma unroll
    for (int d0 = 0; d0 < 8; ++d0) raw[d0] = *reinterpret_cast<const u32x4*>(Qw + d0 * 16);
    float x[8][8]; float ss = 0.f;
#pragma unroll
    for (int d0 = 0; d0 < 8; ++d0) { x[d0][0] = bf_lo(raw[d0].x); x[d0][1] = bf_hi(raw[d0].x); x[d0][2] = bf_lo(raw[d0].y); x[d0][3] = bf_hi(raw[d0].y); x[d0][4] = bf_lo(raw[d0].z); x[d0][5] = bf_hi(raw[d0].z); x[d0][6] = bf_lo(raw[d0].w); x[d0][7] = bf_hi(raw[d0].w);
#pragma unroll
      for (int j = 0; j < 8; ++j) ss += x[d0][j] * x[d0][j]; }
    { auto rr = __builtin_amdgcn_permlane32_swap(__float_as_uint(ss), __float_as_uint(ss), false, false); ss = __uint_as_float(rr[0]) + __uint_as_float(rr[1]); }
    const float rs = (SCALE * 1.4426950408889634f) / sqrtf(ss * (1.f / D) + EPS);
#pragma unroll
    for (int d0 = 0; d0 < 8; ++d0) { const f32x4 ga = *(const f32x4*)(qgain_u + 16 * d0 + 8 * hi), gb = *(const f32x4*)(qgain_u + 16 * d0 + 8 * hi + 4);
      x[d0][0] *= rs * ga.x; x[d0][1] *= rs * ga.y; x[d0][2] *= rs * ga.z; x[d0][3] *= rs * ga.w; x[d0][4] *= rs * gb.x; x[d0][5] *= rs * gb.y; x[d0][6] *= rs * gb.z; x[d0][7] *= rs * gb.w; }
    const int trow = row0_u + wid * QBLK + r32;
#pragma unroll
    for (int p = 0; p < 4; ++p) { const int da = (p & 1) + 4 * (p >> 1), db = da + 2;
      const int pos = (p >> 1) ? (trow & 63) : (trow >> 6); const f32x4* tp = (const f32x4*)(rope_u + ((size_t)pos * 32 + 16 * (p & 1) + 8 * hi) * 2);
#pragma unroll
      for (int jj = 0; jj < 4; ++jj) { const f32x4 cs = tp[jj];
        const float a0 = x[da][2 * jj], b0 = x[db][2 * jj], a1 = x[da][2 * jj + 1], b1 = x[db][2 * jj + 1];
        x[da][2 * jj] = a0 * cs.x - b0 * cs.y; x[db][2 * jj] = b0 * cs.x + a0 * cs.y; x[da][2 * jj + 1] = a1 * cs.z - b1 * cs.w; x[db][2 * jj + 1] = b1 * cs.z + a1 * cs.w; } }
#pragma unroll
    for (int d0 = 0; d0 < 8; ++d0) { u32x4 w = {cvtpk(x[d0][0], x[d0][1]), cvtpk(x[d0][2], x[d0][3]), cvtpk(x[d0][4], x[d0][5]), cvtpk(x[d0][6], x[d0][7])}; qr[d0] = *reinterpret_cast<bf16x8*>(&w); } }
  const int vb0 = (int)(unsigned)(uintptr_t)V_lds + v_rd_base(lane);
#define RESC(fl) do { if (fl) { asm volatile("s_waitcnt lgkmcnt(0)" ::: "memory"); \
    _Pragma("unroll") for (int d = 0; d < 4; ++d) _Pragma("unroll") for (int r = 0; r < 16; ++r) o[d][r] *= al_l[crow(r, hi)]; } } while (0)
  f32x16 pA0, pA1, pB0, pB1; bool rs; bf16x8 pa0, pa1, pa2, pa3;
  if (u == 0) WAIT_BAR(0);
  qkt(pA0, pA1, K_lds + cur, qr, negm, r32, hi);
  if (BND) {
#pragma unroll
    for (int r = 0; r < 16; ++r) pA0[r] = __builtin_amdgcn_exp2f(pA0[r]);
  } else (void)partialSM<true>(pA0, pA1, mhat, negm, l_reg, al_l, r32, hi);
  if (ATT_REBAL) {
#pragma unroll
    for (int r = 0; r < 8; ++r) pA1[r] = __builtin_amdgcn_exp2f(pA1[r]); }
  DMA_K(2, nn); DMA_V(1, nxt);
  WAIT_BAR(4); ROT();
  const int kbase = (int)(unsigned)(uintptr_t)K_lds + r32 * 256;
  const int kad0 = kbase + (((0 + hi) ^ (r32 & 7)) << 4), kad1 = kbase + (((2 + hi) ^ (r32 & 7)) << 4), kad2 = kbase + (((4 + hi) ^ (r32 & 7)) << 4), kad3 = kbase + (((6 + hi) ^ (r32 & 7)) << 4);
#define WAITL(N) asm volatile("s_waitcnt lgkmcnt(" #N ")" ::: "memory")
#define MFQ(acc, kf, d0, c) acc = __builtin_amdgcn_mfma_f32_32x32x16_bf16(kf, qr[d0], c, 0, 0, 0)
#define EXP8(P, B) do { _Pragma("unroll") for (int r_ = 0; r_ < 8; ++r_) P[(B) + r_] = __builtin_amdgcn_exp2f(P[(B) + r_]); } while (0)
#define EXP4(P, B) do { _Pragma("unroll") for (int r_ = 0; r_ < 4; ++r_) P[(B) + r_] = __builtin_amdgcn_exp2f(P[(B) + r_]); } while (0)
#define SUM8(P, B) do { _Pragma("unroll") for (int r_ = 0; r_ < 8; ++r_) ps_ += P[(B) + r_]; } while (0)
#define PK4(P, BASE, OUT) do { unsigned a0 = cvtpk(P[BASE + 0], P[BASE + 1]), a1 = cvtpk(P[BASE + 2], P[BASE + 3]);   \
    unsigned b0 = cvtpk(P[BASE + 4], P[BASE + 5]), b1 = cvtpk(P[BASE + 6], P[BASE + 7]);                              \
    auto r0 = __builtin_amdgcn_permlane32_swap(a0, b0, false, false); auto r1 = __builtin_amdgcn_permlane32_swap(a1, b1, false, false); \
    u32x4 w = {r0[0], r1[0], r0[1], r1[1]}; OUT = *reinterpret_cast<bf16x8*>(&w); } while (0)
#define PKV(L, H) (bf16x8){L[0], L[1], L[2], L[3], H[0], H[1], H[2], H[3]}
#define RDV(D0, l0, h0, l1, h1, l2, h2, l3, h3) const s16x4 l0 = tr_read<v_rd_off(D0, 0, 0)>(vb_), h0 = tr_read<v_rd_off(D0, 0, 1)>(vb_), l1 = tr_read<v_rd_off(D0, 1, 0)>(vb_), h1 = tr_read<v_rd_off(D0, 1, 1)>(vb_), \
    l2 = tr_read<v_rd_off(D0, 2, 0)>(vb_), h2 = tr_read<v_rd_off(D0, 2, 1)>(vb_), l3 = tr_read<v_rd_off(D0, 3, 0)>(vb_), h3 = tr_read<v_rd_off(D0, 3, 1)>(vb_)
#define MFV(od, l0, h0, l1, h1, l2, h2, l3, h3) do { od = __builtin_amdgcn_mfma_f32_32x32x16_bf16(pa0, PKV(l0, h0), od, 0, 0, 0); od = __builtin_amdgcn_mfma_f32_32x32x16_bf16(pa1, PKV(l1, h1), od, 0, 0, 0); \
    od = __builtin_amdgcn_mfma_f32_32x32x16_bf16(pa2, PKV(l2, h2), od, 0, 0, 0); od = __builtin_amdgcn_mfma_f32_32x32x16_bf16(pa3, PKV(l3, h3), od, 0, 0, 0); } while (0)
#define RS_HEAD(X0, X1) do { rs = false; if (!BND) rs = partialSM_head(X0, X1, mhat, negm, l_reg, al_l, r32, hi); } while (0)
#define ITER(X0, X1, Y0, Y1, t) do { \
    SBAR(); \
    { const int a0_ = kad0 + cur, a1_ = kad1 + cur, a2_ = kad2 + cur, a3_ = kad3 + cur; const int vb_ = vb0 + nn; float ps_ = 0.f; \
      const bf16x8 k00 = lds_rd128<0>(a0_), k01 = lds_rd128<8192>(a0_), k10 = lds_rd128<0>(a1_), k11 = lds_rd128<8192>(a1_); \
      const bf16x8 k20 = lds_rd128<0>(a2_), k21 = lds_rd128<8192>(a2_), k30 = lds_rd128<0>(a3_), k31 = lds_rd128<8192>(a3_); \
      WAITL(4); SBAR(); \
      MFQ(X0, k00, 0, negm); MFQ(X1, k01, 0, negm); MFQ(X0, k10, 1, X0); MFQ(X1, k11, 1, X1); \
      if (ATT_REBAL) EXP4(Y1, 8); else EXP8(Y1, 0); PK4(Y0, 0, pa0); SUM8(Y0, 0); \
      const bf16x8 k40 = lds_rd128<128>(a0_), k41 = lds_rd128<8192 + 128>(a0_), k50 = lds_rd128<128>(a1_), k51 = lds_rd128<8192 + 128>(a1_); \
      WAITL(4); SBAR(); \
      MFQ(X0, k20, 2, X0); MFQ(X1, k21, 2, X1); MFQ(X0, k30, 3, X0); MFQ(X1, k31, 3, X1); \
      if (ATT_REBAL) EXP4(Y1, 12); else EXP8(Y1, 8); PK4(Y0, 8, pa1); SUM8(Y0, 8); \
      DMA_K(((t) + 2 < NT ? (t) + 2 : (t) + 2 - NT), nn); \
      const bf16x8 k60 = lds_rd128<128>(a2_), k61 = lds_rd128<8192 + 128>(a2_), k70 = lds_rd128<128>(a3_), k71 = lds_rd128<8192 + 128>(a3_); \
      WAITL(4); SBAR(); \
      MFQ(X0, k40, 4, X0); MFQ(X1, k41, 4, X1); MFQ(X0, k50, 5, X0); MFQ(X1, k51, 5, X1); \
      PK4(Y1, 0, pa2); SUM8(Y1, 0); \
      DMA_V(((t) + 1 < NT ? (t) + 1 : 0), nxt); \
      RDV(0, vl00, vh00, vl01, vh01, vl02, vh02, vl03, vh03); \
      WAITL(8); SBAR(); \
      MFQ(X0, k60, 6, X0); MFQ(X1, k61, 6, X1); MFQ(X0, k70, 7, X0); MFQ(X1, k71, 7, X1); \
      PK4(Y1, 8, pa3); SUM8(Y1, 8); l_reg += ps_; \
      RDV(1, vl10, vh10, vl11, vh11, vl12, vh12, vl13, vh13); \
      WAITL(8); SBAR(); \
      MFV(o[0], vl00, vh00, vl01, vh01, vl02, vh02, vl03, vh03); \
      RS_HEAD(X0, X1); \
      if (ATT_REBAL) { EXP8(X0, 0); asm volatile("" : "+v"(X0)); } \
      RDV(2, vl20, vh20, vl21, vh21, vl22, vh22, vl23, vh23); \
      WAITL(8); SBAR(); \
      MFV(o[1], vl10, vh10, vl11, vh11, vl12, vh12, vl13, vh13); \
      if (ATT_REBAL) EXP8(X0, 8); else EXP8(X0, 0); asm volatile("" : "+v"(X0)); \
      RDV(3, vl30, vh30, vl31, vh31, vl32, vh32, vl33, vh33); \
      WAITL(8); SBAR(); \
      MFV(o[2], vl20, vh20, vl21, vh21, vl22, vh22, vl23, vh23); \
      if (ATT_REBAL) { EXP8(X1, 0); asm volatile("" : "+v"(X1)); } else { EXP8(X0, 8); asm volatile("" : "+v"(X0)); } \
      WAITL(0); SBAR(); \
      MFV(o[3], vl30, vh30, vl31, vh31, vl32, vh32, vl33, vh33); } \
    WAIT_BAR(4); \
    RESC(rs); ROT(); } while (0)
  int t = 1;
  for (; t + 1 < NT; t += 2) { ITER(pB0, pB1, pA0, pA1, t); ITER(pA0, pA1, pB0, pB1, t + 1); }
  ITER(pB0, pB1, pA0, pA1, t);
  finishSM<ATT_REBAL ? 8 : 0>(pB0, pB1, l_reg, pa0, pa1, pa2, pa3); SBAR();
  pv_d0(o, vb0 + nn, pa0, pa1, pa2, pa3);
  { auto rr = __builtin_amdgcn_permlane32_swap(__float_as_uint(l_reg), __float_as_uint(l_reg), false, false); l_reg = __uint_as_float(rr[0]) + __uint_as_float(rr[1]); }
  if (hi == 0) li_l[r32] = l_reg; asm volatile("s_waitcnt lgkmcnt(0)" ::: "memory");
  float rli[16];
#pragma unroll
  for (int r = 0; r < 16; ++r) rli[r] = __builtin_amdgcn_rcpf(li_l[crow(r, hi)]);
  bf16_t* Ow = Ob + (long)(wid * QBLK) * LDO;
#pragma unroll
  for (int r = 0; r < 16; ++r) { const int orow = crow(r, hi);
#pragma unroll
    for (int d0 = 0; d0 < 4; ++d0) { const unsigned w = cvtpk(o[d0][r] * rli[r], 0.f); Ow[(long)orow * LDO + d0 * 32 + r32] = (bf16_t)(w & 0xffffu); } }
  }
  asm volatile("s_waitcnt vmcnt(0) lgkmcnt(0)\n\ts_barrier" ::: "memory");
#undef DMA_K
#undef DMA_V
#undef WAIT_BAR
#undef ROT
#undef RESC
#undef ITER
#undef WAITL
#undef MFQ
#undef EXP8
#undef SUM8
#undef PK4
#undef PKV
#undef RDV
#undef MFV
}
#undef SBAR
}

constexpr int NWAVES = 8;
constexpr int N_PHASES = 1 + 11 * DEPTH;
constexpr int N_LAUNCHES = MK_N_LAUNCHES;
static_assert(N_LAUNCHES == 1 || N_LAUNCHES == N_PHASES, "MK_N_LAUNCHES is 1 or 23");

constexpr size_t MiB = 1u << 20;
constexpr size_t WS_CTL = 0, CTL_ZERO_BYTES = 1 * MiB;
constexpr size_t WS_ROPE = 1 * MiB;
constexpr size_t WS_PB = 2 * MiB;
constexpr size_t WS_W = 16 * MiB;
constexpr size_t LW_IN = 0, LW_POOL = 128 * MiB, LW_OUT = 132 * MiB, LW_GU = 164 * MiB, LW_DOWN = 336 * MiB, LW_PIN = 422 * MiB, LW_PG = 424 * MiB, LW_BYTES = 456 * MiB;
constexpr size_t WS_ACT = WS_W + 2 * LW_BYTES;
constexpr size_t WS_H = WS_ACT;
constexpr size_t WS_Q = WS_H + 64 * MiB;
constexpr size_t WS_K = WS_Q + 64 * MiB;
constexpr size_t WS_V = WS_K + 16 * MiB;
constexpr size_t WS_U = WS_V + 16 * MiB;
constexpr size_t WS_GA = WS_U + 32 * MiB;
constexpr size_t WS_GP = WS_GA + 64 * MiB;
constexpr size_t WS_Q2 = WS_GP + 64 * MiB;
constexpr size_t WS_X16 = WS_Q2;
constexpr size_t WS_K2 = WS_Q2 + 64 * MiB;
constexpr size_t WS_DL = WS_K2 + 16 * MiB;
constexpr size_t WS_O = WS_DL + 32 * MiB;
constexpr size_t WS_MG = WS_O + 64 * MiB;
constexpr size_t WS_Y = WS_MG + 64 * MiB;
constexpr size_t WS_F = WS_Y + 80 * MiB;
constexpr size_t WS_E = WS_F + 172 * MiB;
constexpr size_t WS_END = WS_E + 128 * MiB;
static_assert(WS_END <= 2048 * MiB, "workspace map");

constexpr int CW_TMO = 0, CW_CODE = 1;
constexpr int CW_BAR = 4096;
constexpr int CW_QUEUE = 8192;

constexpr int RING_OFF = 0, RING_BYTES = 131072;
constexpr int LDSCTL_OFF = RING_BYTES, MISC_OFF = LDSCTL_OFF + 320;
constexpr int LDS_BYTES = 147456;

typedef GAS unsigned gu32;
#define RLX_AGENT __ATOMIC_RELAXED, __HIP_MEMORY_SCOPE_AGENT
#define LDS_WAIT() asm volatile("s_waitcnt lgkmcnt(0)" ::: "memory")
#define VM_WAIT() asm volatile("s_waitcnt vmcnt(0)" ::: "memory")
__device__ __forceinline__ unsigned f2bf(float f) { unsigned u = __builtin_bit_cast(unsigned, f); return (u + 0x7fffu + ((u >> 16) & 1u)) >> 16; }
__device__ __forceinline__ unsigned pk2(float lo, float hi) { return f2bf(lo) | (f2bf(hi) << 16); }

#define XB_TMO      128
#define XB_XCNT(j)  (256  + 64 * (j))
#define XB_XSUB(j)  (1280 + 64 * (j))
#define XB_XGEN(j)  (2304 + 64 * (j))
#define XB_TOP      3328
#define XB_TOPGEN   3392
#define XCD_BAR_WORDS 3456
#define XB_SPIN_CAP (1u << 18)

__device__ __forceinline__ unsigned xb_ld(unsigned* p)              { return __hip_atomic_load(p, __ATOMIC_RELAXED, __HIP_MEMORY_SCOPE_AGENT); }
__device__ __forceinline__ unsigned xb_add(unsigned* p, unsigned v) { return __hip_atomic_fetch_add(p, v, __ATOMIC_RELAXED, __HIP_MEMORY_SCOPE_AGENT); }
__device__ __forceinline__ unsigned xb_xcc_id() { return (unsigned)__builtin_amdgcn_s_getreg((3 << 11) | 20) & 0xFu; }
#define XB_SPIN(cond, bar) do { unsigned _sp = 0; while (cond) { __builtin_amdgcn_s_sleep(1); \
    if ((++_sp & 255u) == 0u) { if (xb_ld(&(bar)[XB_TMO])) break; if (_sp > XB_SPIN_CAP) { atomicAdd(&(bar)[XB_TMO], 1u); break; } } } } while (0)

struct XcdBarrier {
    unsigned* bar; unsigned x;
    volatile LAS unsigned* st;
};
__device__ __forceinline__ XcdBarrier xcd_barrier_post(unsigned* bar, volatile LAS unsigned* st) {
    XcdBarrier b; b.bar = bar; b.x = xb_xcc_id(); b.st = st;
    if (threadIdx.x == 0) (void)xb_add(&bar[XB_XCNT(b.x)], 1u);
    return b;
}
__device__ __forceinline__ void xcd_barrier_complete(unsigned* bar, unsigned x, unsigned& nloc, unsigned& nx) {
    const unsigned G = gridDim.x * gridDim.y * gridDim.z;
    unsigned sum, cnt, mine, sp = 0u;
    for (;;) {
        sum = 0u; cnt = 0u; mine = 0u;
#pragma unroll
        for (unsigned j = 0; j < 16; ++j) { const unsigned c = xb_ld(&bar[XB_XCNT(j)]); sum += c; cnt += (c > 0u) ? 1u : 0u; mine = (j == x) ? c : mine; }
        if (sum == G) break;
        __builtin_amdgcn_s_sleep(1);
        if ((++sp & 255u) == 0u) { if (xb_ld(&bar[XB_TMO])) break; if (sp > XB_SPIN_CAP) { atomicAdd(&bar[XB_TMO], 1u); break; } }
    }
    nloc = mine > 0u ? mine : 1u; nx = cnt > 0u ? cnt : 1u;
}
__device__ __forceinline__ void xcd_barrier(const XcdBarrier& b, const int wave_s) {
    asm volatile("s_waitcnt vmcnt(0)" ::: "memory");
    __syncthreads();
    unsigned m_ = ~0u; asm volatile("" : "+s"(m_));
    if (wave_s == 0 && __builtin_amdgcn_mbcnt_hi(m_, __builtin_amdgcn_mbcnt_lo(m_, 0u)) == 0u) {
        unsigned* bar = b.bar; asm volatile("" : "+s"(bar));
        __builtin_amdgcn_s_waitcnt(0);
        unsigned nloc = b.st[0], nx = b.st[1];
        if (nloc == 0u) { xcd_barrier_complete(bar, b.x, nloc, nx); b.st[0] = nloc; b.st[1] = nx; }
        const unsigned old = xb_add(&bar[XB_XSUB(b.x)], 1u);
        const unsigned gen = old / nloc;
        if (old + 1u == (gen + 1u) * nloc) {
            __builtin_amdgcn_fence(__ATOMIC_RELEASE, "agent");
            asm volatile("s_waitcnt vmcnt(0)" ::: "memory");
            const unsigned og = xb_add(&bar[XB_TOP], 1u);
            const unsigned tg = og / nx;
            if (og + 1u == (tg + 1u) * nx) xb_add(&bar[XB_TOPGEN], 1u);
            else XB_SPIN(xb_ld(&bar[XB_TOPGEN]) == tg, bar);
            __builtin_amdgcn_fence(__ATOMIC_ACQUIRE, "agent");
            xb_add(&bar[XB_XGEN(b.x)], 1u);
            asm volatile("s_waitcnt vmcnt(0)" ::: "memory");
        } else {
            XB_SPIN(xb_ld(&bar[XB_XGEN(b.x)]) == gen, bar);
            __builtin_amdgcn_fence(__ATOMIC_ACQUIRE, "agent");
            asm volatile("s_waitcnt vmcnt(0)" ::: "memory");
        }
    }
    __syncthreads();
}

struct Frame {
    LAS unsigned char* lds;
    int tid, lane, wave;
    int vcu, G, bx;
};
__device__ __forceinline__ int thread_id(int wave_s) { unsigned m = ~0u; asm volatile("" : "+s"(m)); const int lane = (int)__builtin_amdgcn_mbcnt_hi(m, __builtin_amdgcn_mbcnt_lo(m, 0u)); int t = wave_s * 64 + lane; asm volatile("" : "+v"(t)); return t; }
__device__ __forceinline__ Frame make_frame(LAS unsigned char* lds, int wave_s) {
    Frame F; const int t = thread_id(wave_s); int bx = blockIdx.x; asm volatile("" : "+s"(bx)); int G = gridDim.x; asm volatile("" : "+s"(G));
    F.lds = lds; F.tid = t; F.lane = t & 63; F.wave = wave_s; F.G = G; F.bx = bx;
    F.vcu = (G % 8 == 0) ? (bx % 8) * (G / 8) + bx / 8 : bx;
    return F;
}

__device__ __forceinline__ float shx(float v, int m, int lane) { return __int_as_float(__builtin_amdgcn_ds_bpermute((lane ^ m) << 2, __float_as_int(v))); }
__device__ __forceinline__ float wave_sum(float v, int lane) {
#pragma unroll
    for (int o = 1; o < 64; o <<= 1) v += shx(v, o, lane);
    return v;
}

template <int MAP>
__device__ __forceinline__ void p0_transpose_item(const float* W, int K, int N, bf16_t* WT, int row_off, LAS float* scr, int item, int lane) {
    const int nblk = N / 32, kb = item / nblk, nb = item % nblk, k0 = 64 * kb, n0 = 32 * nb;
    const int r0 = (MAP == 0) ? (row_off + n0) : (256 * (n0 >> 7) + (n0 & 127) + row_off);
#pragma unroll 8
    for (int i = 0; i < 32; ++i) { const int kk = 2 * i + (lane >> 5);
#if NT_CONV
        scr[kk * 33 + (lane & 31)] = __builtin_nontemporal_load(&W[(size_t)(k0 + kk) * N + n0 + (lane & 31)]);
#else
        scr[kk * 33 + (lane & 31)] = W[(size_t)(k0 + kk) * N + n0 + (lane & 31)];
#endif
    }
    LDS_WAIT(); asm volatile("" ::: "memory");
    const int c = lane & 7;
#pragma unroll
    for (int j = 0; j < 4; ++j) { const int n = (lane >> 3) + 8 * j; const LAS float* s = scr + (8 * c) * 33 + n;
        u32x4 o; o.x = pk2(s[0 * 33], s[1 * 33]); o.y = pk2(s[2 * 33], s[3 * 33]); o.z = pk2(s[4 * 33], s[5 * 33]); o.w = pk2(s[6 * 33], s[7 * 33]);
        *(GAS u32x4*)(WT + (size_t)(r0 + n) * K + k0 + 8 * c) = o; }
    LDS_WAIT(); asm volatile("" ::: "memory");
}

struct Args { const float* in[18]; float* out; unsigned char* ws; int ph_lo, ph_hi; };

__device__ __forceinline__ void norm_row(int lane, const float* xf, const bf16_t* x16in, const bf16_t* y, const LAS float* gpost, bf16_t* x16out, float* xfout, const LAS float* gpre, bf16_t* h) {
    f32x4 v[16];
    if (xf) { const GAS f32x4* xr = (const GAS f32x4*)xf + lane;
#pragma unroll
        for (int j = 0; j < 16; ++j) v[j] = xr[64 * j];
    } else { const GAS u32x2* xr = (const GAS u32x2*)x16in + lane;
#pragma unroll
        for (int j = 0; j < 16; ++j) { const u32x2 w = xr[64 * j]; v[j] = (f32x4){bf_lo(w.x), bf_hi(w.x), bf_lo(w.y), bf_hi(w.y)}; } }
    if (y) {
        const GAS u32x2* yr = (const GAS u32x2*)y + lane; f32x4 yv[16]; float s = 0.f;
#pragma unroll
        for (int j = 0; j < 16; ++j) { const u32x2 w = yr[64 * j]; yv[j] = (f32x4){bf_lo(w.x), bf_hi(w.x), bf_lo(w.y), bf_hi(w.y)}; s += (yv[j].x * yv[j].x + yv[j].y * yv[j].y) + (yv[j].z * yv[j].z + yv[j].w * yv[j].w); }
        const float rstd = 1.0f / sqrtf(wave_sum(s, lane) * (1.f / DM) + EPS);
#pragma unroll
        for (int j = 0; j < 16; ++j) { const f32x4 g = *(const LAS f32x4*)(gpost + 4 * lane + 256 * j); v[j] = v[j] + yv[j] * rstd * g; }
    }
    if (xfout) { GAS f32x4* xo = (GAS f32x4*)xfout + lane;
#pragma unroll
        for (int j = 0; j < 16; ++j) xo[64 * j] = v[j]; }
    if (x16out) { GAS u32x2* xo = (GAS u32x2*)x16out + lane;
#pragma unroll
        for (int j = 0; j < 16; ++j) { u32x2 w; w.x = cvt_pk_bf16(v[j].x, v[j].y); w.y = cvt_pk_bf16(v[j].z, v[j].w); xo[64 * j] = w; } }
    if (h) {
        float s = 0.f;
#pragma unroll
        for (int j = 0; j < 16; ++j) s += (v[j].x * v[j].x + v[j].y * v[j].y) + (v[j].z * v[j].z + v[j].w * v[j].w);
        const float rstd = 1.0f / sqrtf(wave_sum(s, lane) * (1.f / DM) + EPS);
        GAS u32x2* ho = (GAS u32x2*)h + lane;
#pragma unroll
        for (int j = 0; j < 16; ++j) { const f32x4 g = *(const LAS f32x4*)(gpre + 4 * lane + 256 * j); const f32x4 t = v[j] * rstd * g;
            u32x2 w; w.x = cvt_pk_bf16(t.x, t.y); w.y = cvt_pk_bf16(t.z, t.w); ho[64 * j] = w; }
    }
}
__device__ __forceinline__ void norm_pass(Frame& F, const float* xf, const bf16_t* x16in, const bf16_t* y, const float* gpost, bf16_t* x16out, float* xfout, const float* gpre, bf16_t* h) {
    LAS float* gl = (LAS float*)(F.lds + RING_OFF);
    __syncthreads();
    for (int i = F.tid; i < DM; i += NWAVES * 64) { gl[i] = gpost ? gpost[i] : 0.f; gl[DM + i] = gpre ? gpre[i] : 0.f; }
    __syncthreads();
    const int gw = F.vcu * NWAVES + F.wave, NGW = F.G * NWAVES;
    for (int m = gw; m < S; m += NGW)
        norm_row(F.lane, xf ? xf + (size_t)m * DM : nullptr, x16in ? x16in + (size_t)m * DM : nullptr, y ? y + (size_t)m * YP : nullptr, gl,
                 x16out ? x16out + (size_t)m * DM : nullptr, xfout ? xfout + (size_t)m * DM : nullptr, gl + DM, h ? h + (size_t)m * DM : nullptr);
    __syncthreads();
}

__device__ __forceinline__ void qk_item_addr(int it, int dsub, const bf16_t* Qr, const bf16_t* Kr, bf16_t* Q2, bf16_t* K2, const bf16_t*& src, bf16_t*& dst, int& row, bool& isq) {
    row = it / NKV; const int hh = it % NKV; isq = false;
    src = Kr + (size_t)row * KVW + hh * HD + dsub;
    dst = K2 + (size_t)row * KVW + hh * HD + dsub;
}
__device__ __forceinline__ void qk_item_do(const u32x4 w, bf16_t* dst, int row, bool isq, int lane, int s, const float* qn, const float* kn, const float* rope) {
    const int dsub = 8 * s, axis = s >> 3, half = (s >> 2) & 1, i0 = 8 * (s & 3);
    const float* gn = isq ? qn : kn;
    float x[8] = {bf_lo(w.x), bf_hi(w.x), bf_lo(w.y), bf_hi(w.y), bf_lo(w.z), bf_hi(w.z), bf_lo(w.w), bf_hi(w.w)};
    float ss = 0.f;
#pragma unroll
    for (int j = 0; j < 8; ++j) ss += x[j] * x[j];
    ss += shx(ss, 1, lane); ss += shx(ss, 2, lane); ss += shx(ss, 4, lane); ss += shx(ss, 8, lane);
    const float rstd = 1.0f / sqrtf(ss * (1.f / HD) + EPS);
    const f32x4 ga = *(const f32x4*)(gn + dsub), gb = *(const f32x4*)(gn + dsub + 4);
    const float g[8] = {ga.x, ga.y, ga.z, ga.w, gb.x, gb.y, gb.z, gb.w};
    const float rs = isq ? rstd * (att::SCALE * 1.4426950408889634f) : rstd;
#pragma unroll
    for (int j = 0; j < 8; ++j) x[j] = x[j] * rs * g[j];
    float xp[8];
#pragma unroll
    for (int j = 0; j < 8; ++j) xp[j] = shx(x[j], 4, lane);
    const int pos = axis ? (row & 63) : (row >> 6);
    const f32x4* tp = (const f32x4*)(rope + ((size_t)pos * 32 + i0) * 2);
    float o[8];
#pragma unroll
    for (int jj = 0; jj < 4; ++jj) { const f32x4 cs = tp[jj];
        o[2 * jj]     = half ? (x[2 * jj] * cs.x + xp[2 * jj] * cs.y)         : (x[2 * jj] * cs.x - xp[2 * jj] * cs.y);
        o[2 * jj + 1] = half ? (x[2 * jj + 1] * cs.z + xp[2 * jj + 1] * cs.w) : (x[2 * jj + 1] * cs.z - xp[2 * jj + 1] * cs.w); }
    u32x4 ow; ow.x = cvt_pk_bf16(o[0], o[1]); ow.y = cvt_pk_bf16(o[2], o[3]); ow.z = cvt_pk_bf16(o[4], o[5]); ow.w = cvt_pk_bf16(o[6], o[7]);
    *(GAS u32x4*)dst = ow;
}
__device__ __forceinline__ void qk_norm_rope_pass(Frame& F, const bf16_t* Qr, const bf16_t* Kr, bf16_t* Q2, bf16_t* K2, const float* qn, const float* kn, const float* rope) {
    const int gw = F.vcu * NWAVES + F.wave, NGW = F.G * NWAVES;
    const int g16 = F.lane >> 4, s = F.lane & 15;
    constexpr int NITEM = S * NKV;
    const int step = 4 * NGW;
    for (int it = 4 * gw + g16; it < NITEM; it += 4 * step) {
        const bf16_t* src[4]; bf16_t* dst[4]; int row[4]; bool isq[4]; u32x4 w[4];
#pragma unroll
        for (int u = 0; u < 4; ++u) { const int iu = it + u * step; qk_item_addr(iu < NITEM ? iu : it, 8 * s, Qr, Kr, Q2, K2, src[u], dst[u], row[u], isq[u]); w[u] = *(const GAS u32x4*)src[u]; }
#pragma unroll
        for (int u = 0; u < 4; ++u) if (it + u * step < NITEM) qk_item_do(w[u], dst[u], row[u], isq[u], F.lane, s, qn, kn, rope);
    }
}
template <int HW> __device__ __forceinline__ void pool_item(const bf16_t* U, bf16_t* DL, int t, int c) {
    u32x4 w[2 * HW];
#pragma unroll
    for (int i = 0; i < 2 * HW; ++i) { int r = t - HW + i; r = r < 0 ? 0 : (r >= S ? S - 1 : r); w[i] = *(const GAS u32x4*)(U + (size_t)r * POOLW + 8 * c); }
    float acc[8] = {0.f, 0.f, 0.f, 0.f, 0.f, 0.f, 0.f, 0.f};
#pragma unroll
    for (int i = 0; i < 2 * HW; ++i) { const int r = t - HW + i; const float m = ((unsigned)r < (unsigned)S) ? 1.f : 0.f;
        acc[0] += m * bf_lo(w[i].x); acc[1] += m * bf_hi(w[i].x); acc[2] += m * bf_lo(w[i].y); acc[3] += m * bf_hi(w[i].y); acc[4] += m * bf_lo(w[i].z); acc[5] += m * bf_hi(w[i].z); acc[6] += m * bf_lo(w[i].w); acc[7] += m * bf_hi(w[i].w); }
    const int lo = (t - HW) < 0 ? 0 : (t - HW), hi = (t + HW) > S ? S : (t + HW);
    const float inv = 1.0f / (float)(hi - lo);
    const u32x4 wm = w[HW];
    const float me[8] = {bf_lo(wm.x), bf_hi(wm.x), bf_lo(wm.y), bf_hi(wm.y), bf_lo(wm.z), bf_hi(wm.z), bf_lo(wm.w), bf_hi(wm.w)};
    float d[8];
#pragma unroll
    for (int j = 0; j < 8; ++j) d[j] = acc[j] * inv - me[j];
    u32x4 ow; ow.x = cvt_pk_bf16(d[0], d[1]); ow.y = cvt_pk_bf16(d[2], d[3]); ow.z = cvt_pk_bf16(d[4], d[5]); ow.w = cvt_pk_bf16(d[6], d[7]);
    *(GAS u32x4*)(DL + (size_t)t * POOLW + 8 * c) = ow;
}
__device__ __forceinline__ void pool_delta_pass(Frame& F, const bf16_t* U, bf16_t* DL) {
    const int gt = F.vcu * (NWAVES * 64) + F.tid, NT = F.G * NWAVES * 64;
    for (int it = gt; it < S * (POOLW / 8); it += NT) {
        const int t = it >> 8, c = it & 255, g = __builtin_amdgcn_readfirstlane(c >> 6);
        if (g == 0) pool_item<1>(U, DL, t, c); else if (g == 1) pool_item<2>(U, DL, t, c); else if (g == 2) pool_item<4>(U, DL, t, c); else pool_item<8>(U, DL, t, c);
    }
}

__device__ __forceinline__ double inv_freq_of(int i) {
    const double step = 0.74989420933245582730;
    double r = 1.0; for (int k = 0; k < i; ++k) r *= step; return r;
}

typedef const __attribute__((address_space(4))) Args CArgs;
__device__ __forceinline__ CArgs* fresh_args() { CArgs* p = (CArgs*)__builtin_amdgcn_kernarg_segment_ptr(); asm volatile("" : "+s"(p)); return p; }
#define WSP(off) ((bf16_t*)(ws + (off)))
struct ConvDesc { const float* src; bf16_t* dst; int N, K; };
constexpr int CI_IN = (DM / 64) * (INW / 32), CI_POOL = (PGI / 64) * (PGO / 32), CI_OUT = (DM / 64) * (DM / 32), CI_GU = (DM / 64) * (FF / 32), CI_DOWN = (FF / 64) * (DM / 32), CI_PIN = (DPLE / 64) * (DM / 32);
constexpr int CI_LAYER = CI_IN + 4 * CI_POOL + CI_OUT + 2 * CI_GU + CI_DOWN + CI_PIN + CI_OUT;
__device__ __forceinline__ ConvDesc conv_decode(CArgs* ap, unsigned char* ws, int it) {
    const int l = it / CI_LAYER; int r = it % CI_LAYER;
    unsigned char* wl = ws + WS_W + (size_t)l * LW_BYTES;
    const float* W; int K, N, row_off = 0, map = 0; bf16_t* WT;
    if (r < CI_IN) { W = ap->in[2] + (size_t)l * DM * INW; K = DM; N = INW; WT = (bf16_t*)(wl + LW_IN); }
    else if ((r -= CI_IN) < 4 * CI_POOL) { const int g = r / CI_POOL; r -= g * CI_POOL; W = ap->in[5] + ((size_t)l * 4 + g) * PGI * PGO; K = PGI; N = PGO; WT = (bf16_t*)(wl + LW_POOL); row_off = g * PGO; }
    else if ((r -= 4 * CI_POOL) < CI_OUT) { W = ap->in[7] + (size_t)l * DM * DM; K = DM; N = DM; WT = (bf16_t*)(wl + LW_OUT); }
    else if ((r -= CI_OUT) < CI_GU) { W = ap->in[12] + (size_t)l * DM * FF; K = DM; N = FF; WT = (bf16_t*)(wl + LW_GU); map = 1; }
    else if ((r -= CI_GU) < CI_GU) { W = ap->in[13] + (size_t)l * DM * FF; K = DM; N = FF; WT = (bf16_t*)(wl + LW_GU); map = 1; row_off = 128; }
    else if ((r -= CI_GU) < CI_DOWN) { W = ap->in[14] + (size_t)l * FF * DM; K = FF; N = DM; WT = (bf16_t*)(wl + LW_DOWN); }
    else if ((r -= CI_DOWN) < CI_PIN) { W = ap->in[15] + (size_t)l * DPLE * DM; K = DPLE; N = DM; WT = (bf16_t*)(wl + LW_PIN); }
    else { r -= CI_PIN; W = ap->in[16] + (size_t)l * DM * DM; K = DM; N = DM; WT = (bf16_t*)(wl + LW_PG); }
    const int nblk = N / 32, kb = r / nblk, nb = r % nblk, k0 = 64 * kb, n0 = 32 * nb;
    const int r0 = map ? (256 * (n0 >> 7) + (n0 & 127) + row_off) : (row_off + n0);
    ConvDesc d; d.src = W + (size_t)k0 * N + n0; d.dst = WT + (size_t)r0 * K + k0; d.N = N; d.K = K; return d;
}
__device__ __forceinline__ void conv_load(const ConvDesc& d, int lane, float (&r)[32]) {
#pragma unroll
    for (int i = 0; i < 32; ++i) r[i] = NT_CONV ? __builtin_nontemporal_load(&d.src[(size_t)(2 * i + (lane >> 5)) * d.N + (lane & 31)]) : d.src[(size_t)(2 * i + (lane >> 5)) * d.N + (lane & 31)];
}
__device__ __forceinline__ void conv_finish(const ConvDesc& d, const float (&r)[32], LAS float* scr, int lane) {
#pragma unroll
    for (int i = 0; i < 32; ++i) scr[(2 * i + (lane >> 5)) * 33 + (lane & 31)] = r[i];
    LDS_WAIT(); asm volatile("" ::: "memory");
    const int c = lane & 7;
#pragma unroll
    for (int j = 0; j < 4; ++j) { const int n = (lane >> 3) + 8 * j; const LAS float* s = scr + (8 * c) * 33 + n;
        u32x4 o; o.x = pk2(s[0 * 33], s[1 * 33]); o.y = pk2(s[2 * 33], s[3 * 33]); o.z = pk2(s[4 * 33], s[5 * 33]); o.w = pk2(s[6 * 33], s[7 * 33]);
        *(GAS u32x4*)(d.dst + (size_t)n * d.K + 8 * c) = o; }
    LDS_WAIT(); asm volatile("" ::: "memory");
}
__device__ __forceinline__ void convert_range(CArgs* ap, unsigned char* ws, LAS unsigned char* Lb, int wave, int lane, int gw, int NGW, int lo, int hi) {
    LAS float* scr = (LAS float*)(Lb + RING_OFF + wave * 16384);
    int it = lo + gw;
    if (it < hi) {
        ConvDesc d = conv_decode(ap, ws, it); float r[32]; conv_load(d, lane, r);
        for (;;) {
            const int itn = it + NGW; const bool has = itn < hi;
            ConvDesc dn = d; float rn[32];
            if (has) { dn = conv_decode(ap, ws, itn); conv_load(dn, lane, rn); }
            conv_finish(d, r, scr, lane);
            if (!has) break;
            d = dn; it = itn;
#pragma unroll
            for (int i = 0; i < 32; ++i) r[i] = rn[i];
        }
    }
}
__device__ __forceinline__ void convert_range_dyn(CArgs* ap, unsigned char* ws, LAS unsigned char* Lb, int wave, int lane, int lo, int hi, unsigned* counter) {
    constexpr int CH = 8;
    LAS float* scr = (LAS float*)(Lb + RING_OFF + wave * 16384);
    for (;;) {
        unsigned b = 0u; if (lane == 0) b = __hip_atomic_fetch_add(counter, (unsigned)CH, __ATOMIC_RELAXED, __HIP_MEMORY_SCOPE_AGENT);
        const int base = lo + (int)__builtin_amdgcn_readfirstlane((int)b);
        if (base >= hi) break;
        const int end = base + CH < hi ? base + CH : hi;
        ConvDesc d = conv_decode(ap, ws, base); float r[32]; conv_load(d, lane, r);
        for (int it = base;;) {
            const int itn = it + 1; const bool has = itn < end;
            ConvDesc dn = d; float rn[32];
            if (has) { dn = conv_decode(ap, ws, itn); conv_load(dn, lane, rn); }
            conv_finish(d, r, scr, lane);
            if (!has) break;
            d = dn; it = itn;
#pragma unroll
            for (int i = 0; i < 32; ++i) r[i] = rn[i];
        }
    }
}
constexpr int CO_POOL = CI_IN, CO_OUT = CO_POOL + 4 * CI_POOL, CO_GATE = CO_OUT + CI_OUT, CO_DOWN = CO_GATE + 2 * CI_GU, CO_PIN = CO_DOWN + CI_DOWN, CO_PG = CO_PIN + CI_PIN;
#define CONVERT(l_, lo_, hi_) convert_range(ap, ws, L, F.wave, F.lane, F.vcu * NWAVES + F.wave, F.G * NWAVES, (l_) * CI_LAYER + (lo_), (l_) * CI_LAYER + (hi_))


__global__ void __launch_bounds__(NWAVES * 64, 2) fwd_kernel(Args args) {
    extern __shared__ __attribute__((aligned(16))) unsigned char lds[];
    LAS unsigned char* const L = (LAS unsigned char*)lds;
    const int wave_s = __builtin_amdgcn_readfirstlane((int)threadIdx.x >> 6);
    for (int u = threadIdx.x; u < (LDS_BYTES - LDSCTL_OFF) / 4; u += NWAVES * 64) ((LAS unsigned*)(L + LDSCTL_OFF))[u] = 0u;
    __syncthreads();
    unsigned* const barw = (unsigned*)(args.ws + WS_CTL) + CW_BAR;
    XcdBarrier bar; bar.bar = barw; bar.x = 0; bar.st = nullptr;
    if (N_LAUNCHES == 1) bar = xcd_barrier_post(barw, (volatile LAS unsigned*)(L + MISC_OFF) + 8);
#if SKEW_PROBE
    unsigned long long wait_ticks = 0;
#define GRID_BAR() do { const unsigned long long ta_ = __builtin_amdgcn_s_memrealtime(); xcd_barrier(bar, wave_s); wait_ticks += __builtin_amdgcn_s_memrealtime() - ta_; } while (0)
#else
#define GRID_BAR() do { if (N_LAUNCHES == 1) { for (int rb_ = 0; rb_ < REP_BAR; ++rb_) xcd_barrier(bar, wave_s); } } while (0)
#endif
    const int lo = args.ph_lo, hi = args.ph_hi;
#define IN(k) (lo <= (k) && (k) < hi)
#define SEAM(k) do { if (IN(k) && IN((k) + 1)) GRID_BAR(); } while (0)

    if (IN(0)) {
        CArgs* ap = fresh_args(); unsigned char* ws = ap->ws; Frame F = make_frame(L, wave_s);
        LAS float* scr = (LAS float*)(F.lds + RING_OFF + F.wave * 16384);
        const int gw = F.vcu * NWAVES + F.wave, NGW = F.G * NWAVES;
        if (JIT_CONV) { CONVERT(0, 0, CI_IN); } else {
        for (int rep = 0; rep < REP_CONV; ++rep) {
            constexpr int TOT = DEPTH * CI_LAYER;
            int it = gw;
            if (it < TOT) {
                ConvDesc d = conv_decode(ap, ws, TOT - 1 - it); float r[32]; conv_load(d, F.lane, r);
                for (;;) {
                    const int itn = it + NGW; const bool has = itn < TOT;
                    ConvDesc dn = d; float rn[32];
                    if (has) { dn = conv_decode(ap, ws, TOT - 1 - itn); conv_load(dn, F.lane, rn); }
                    conv_finish(d, r, scr, F.lane);
                    if (!has) break;
                    d = dn; it = itn;
#pragma unroll
                    for (int i = 0; i < 32; ++i) r[i] = rn[i];
                }
            }
        }
        }
        { const int gt = F.vcu * (NWAVES * 64) + F.tid, NT = F.G * NWAVES * 64;
          const float* p_in = ap->in[1]; bf16_t* PB = WSP(WS_PB); float* rope = (float*)(ws + WS_ROPE);
          for (int i = gt; i < DEPTH * S * DPLE / 8; i += NT) { const f32x4 a = *(const GAS f32x4*)(p_in + (size_t)i * 8), b = *(const GAS f32x4*)(p_in + (size_t)i * 8 + 4);
              u32x4 o; o.x = cvt_pk_bf16(a.x, a.y); o.y = cvt_pk_bf16(a.z, a.w); o.z = cvt_pk_bf16(b.x, b.y); o.w = cvt_pk_bf16(b.z, b.w); *(GAS u32x4*)(PB + (size_t)i * 8) = o; }
          for (int i = gt; i < 128 * 32; i += NT) { const int pos = i >> 5, fi = i & 31;
              const double ang = (double)pos * inv_freq_of(fi); const double k = __builtin_rint(ang * 0.15915494309189533577); const double r = ang - k * 6.283185307179586476925;
              const float rf = (float)r; rope[2 * i] = cosf(rf); rope[2 * i + 1] = sinf(rf); }
        }
        norm_pass(F, ap->in[0], nullptr, nullptr, nullptr, nullptr, nullptr, ap->in[8], WSP(WS_H));
    }
    SEAM(0);

    for (int l = 0; l < DEPTH; ++l) {
        const int pb = 1 + 11 * l;
        if (IN(pb + 0)) {
            CArgs* ap = fresh_args(); unsigned char* ws = ap->ws; Frame F = make_frame(L, wave_s); unsigned char* wl = ws + WS_W + (size_t)l * LW_BYTES;
            for (int rep = 0; rep < REP_G1; ++rep) { pg8::Gemm g{WSP(WS_H), (const bf16_t*)(wl + LW_IN), S, INW, DM, DM, DM, 0}; pg8::StaticOrder So; So.init(S, INW, F.G, F.bx);
              pg8::EpiZ E{WSP(WS_Q), WSP(WS_K), WSP(WS_V), WSP(WS_U), WSP(WS_GA), WSP(WS_GP)};
              pg8::gemm_phase<pg8::EpiZ, pg8::StaticOrder, G_ALIGN, G_SP2>(F.lds + RING_OFF, g, So, E, F.tid); }
            if (!JIT_CONV && l == 0) {
                for (int l2 = 0; l2 < DEPTH * REP_E; ++l2) {
                    const int l2_ = l2 % DEPTH; pg8::Gemm g2{WSP(WS_PB) + (size_t)l2_ * S * DPLE, (const bf16_t*)(ws + WS_W + (size_t)l2_ * LW_BYTES + LW_PIN), S, DM, DPLE, DPLE, DPLE, 0}; pg8::StaticOrder S2; S2.init(S, DM, F.G, F.bx);
                    pg8::EpiPlain E2{WSP(WS_E) + (size_t)l2_ * S * DM, DM};
                    pg8::gemm_phase<pg8::EpiPlain, pg8::StaticOrder, G_ALIGN, G_SP2>(F.lds + RING_OFF, g2, S2, E2, F.tid);
                }
            }
        }
        SEAM(pb + 0);
        if (IN(pb + 1)) {
            CArgs* ap = fresh_args(); unsigned char* ws = ap->ws; Frame F = make_frame(L, wave_s);
            for (int rep = 0; rep < REP_T2; ++rep) {
            qk_norm_rope_pass(F, WSP(WS_Q), WSP(WS_K), WSP(WS_Q2), WSP(WS_K2), ap->in[3] + l * HD, ap->in[4] + l * HD, (const float*)(ws + WS_ROPE));
            pool_delta_pass(F, WSP(WS_U), WSP(WS_DL)); }
            if (JIT_CONV) CONVERT(l, CO_POOL, CO_OUT);
        }
        SEAM(pb + 1);
        if (IN(pb + 2)) {
            CArgs* ap = fresh_args(); unsigned char* ws = ap->ws; Frame F = make_frame(L, wave_s);
            bool bounded;
            { const float* qn = ap->in[3] + l * HD; const float* kn = ap->in[4] + l * HD; float gq = fmaxf(fabsf(qn[F.lane]), fabsf(qn[F.lane + 64])), gk = fmaxf(fabsf(kn[F.lane]), fabsf(kn[F.lane + 64]));
#pragma unroll
              for (int o_ = 1; o_ < 64; o_ <<= 1) { gq = fmaxf(gq, shx(gq, o_, F.lane)); gk = fmaxf(gk, shx(gk, o_, F.lane)); }
              bounded = __builtin_amdgcn_readfirstlane((1.4426950408889634f * 11.313708498984761f * 1.02f * gq * gk <= 60.f) ? 1 : 0) != 0; }
            const bool bnd = ATT_BOUND && bounded;
            for (int rep = 0; rep < REP_ATT; ++rep)
            { const int nU = (F.G == 256) ? 4 : 1;
            for (int U0 = F.vcu; U0 < NH * (S / 256); U0 += F.G * nU) {
                const int a = U0 >> 8, b = (U0 >> 5) & 7, c = U0 & 31, h = 4 * b + a, qb = c, kvh = h >> 2;
                att::attn_ring_body(WSP(WS_Q) + (size_t)qb * 256 * DM + h * HD, WSP(WS_K2) + kvh * HD, WSP(WS_V) + kvh * HD, WSP(WS_O) + (size_t)qb * 256 * DM + h * HD, S, (LAS char*)(F.lds + RING_OFF), F.tid, bnd, qb * 256, ap->in[3] + l * HD, (const float*)(ws + WS_ROPE), nU);
            } }
        }
        const bool pool_local = (N_LAUNCHES == 1) && (gridDim.x == 256);
        if (!pool_local) SEAM(pb + 2);
        if (IN(pb + 3)) {
            CArgs* ap = fresh_args(); unsigned char* ws = ap->ws; Frame F = make_frame(L, wave_s); unsigned char* wl = ws + WS_W + (size_t)l * LW_BYTES;
            pg8::Gemm g{WSP(WS_DL), (const bf16_t*)(wl + LW_POOL), S, DM, PGI, POOLW, PGI, PGI};
            pg8::EpiPool E{WSP(WS_MG), WSP(WS_O), WSP(WS_GA), WSP(WS_GP), ap->in[6] + (size_t)l * DM, DM};
            if (pool_local) {
                asm volatile("s_waitcnt vmcnt(0)" ::: "memory"); __syncthreads();
                if (F.tid == 0) { __builtin_amdgcn_fence(__ATOMIC_ACQUIRE, "agent"); asm volatile("s_waitcnt vmcnt(0)" ::: "memory"); }
                __syncthreads();
                pg8::PoolOrder Po{F.vcu & 31, 2 * ((F.vcu >> 5) & 7)};
                pg8::gemm_phase<pg8::EpiPool, pg8::PoolOrder, G_ALIGN, G_SP2>(F.lds + RING_OFF, g, Po, E, F.tid);
            } else {
                pg8::StaticOrder So; So.init(S, DM, F.G, F.bx);
                pg8::gemm_phase<pg8::EpiPool, pg8::StaticOrder, G_ALIGN, G_SP2>(F.lds + RING_OFF, g, So, E, F.tid);
            }
            if (JIT_CONV) CONVERT(l, CO_OUT, CO_GATE);
        }
        SEAM(pb + 3);
        if (IN(pb + 4)) {
            CArgs* ap = fresh_args(); unsigned char* ws = ap->ws; Frame F = make_frame(L, wave_s); unsigned char* wl = ws + WS_W + (size_t)l * LW_BYTES;
            pg8::Gemm g{WSP(WS_MG), (const bf16_t*)(wl + LW_OUT), S, DM, DM, DM, DM, 0}; pg8::StaticOrder So; So.init(S, DM, F.G, F.bx);
            pg8::EpiPlain E{WSP(WS_Y), YP};
            for (int rep = 0; rep < REP_SMALLG; ++rep)
            pg8::gemm_phase<pg8::EpiPlain, pg8::StaticOrder, G_ALIGN, G_SP2>(F.lds + RING_OFF, g, So, E, F.tid);
        }
        SEAM(pb + 4);
        if (IN(pb + 5)) {
            CArgs* ap = fresh_args(); unsigned char* ws = ap->ws; Frame F = make_frame(L, wave_s);
            norm_pass(F, l == 0 ? ap->in[0] : nullptr, WSP(WS_X16), WSP(WS_Y), ap->in[9] + (size_t)l * DM, WSP(WS_X16), nullptr, ap->in[10] + (size_t)l * DM, WSP(WS_H));
            if (JIT_CONV) CONVERT(l, CO_GATE, CO_DOWN);
        }
        SEAM(pb + 5);
        if (IN(pb + 6)) {
            CArgs* ap = fresh_args(); unsigned char* ws = ap->ws; Frame F = make_frame(L, wave_s); unsigned char* wl = ws + WS_W + (size_t)l * LW_BYTES;
            pg8::Gemm g{WSP(WS_H), (const bf16_t*)(wl + LW_GU), S, 2 * FF, DM, DM, DM, 0}; pg8::StaticOrder So; So.init(S, 2 * FF, F.G, F.bx);
            pg8::EpiSwiglu E{WSP(WS_F), FF};
            for (int rep = 0; rep < REP_G3; ++rep)
            pg8::gemm_phase<pg8::EpiSwiglu, pg8::StaticOrder, G_ALIGN, G_SP2>(F.lds + RING_OFF, g, So, E, F.tid);
            if (JIT_CONV) convert_range_dyn(ap, ws, L, F.wave, F.lane, l * CI_LAYER + CO_DOWN, l * CI_LAYER + CO_PIN, (unsigned*)(ws + WS_CTL) + CW_QUEUE + 64 * l);
        }
        SEAM(pb + 6);
        if (IN(pb + 7)) {
            CArgs* ap = fresh_args(); unsigned char* ws = ap->ws; Frame F = make_frame(L, wave_s); unsigned char* wl = ws + WS_W + (size_t)l * LW_BYTES;
            pg8::Gemm g{WSP(WS_F), (const bf16_t*)(wl + LW_DOWN), S, DM, FF, FF, FF, 0}; pg8::StaticOrder So; So.init(S, DM, F.G, F.bx);
            pg8::EpiPlain E{WSP(WS_Y), YP};
            pg8::gemm_phase<pg8::EpiPlain, pg8::StaticOrder, G_ALIGN, G_SP2>(F.lds + RING_OFF, g, So, E, F.tid);
#if REP_G4 > 1
            pg8::gemm_phase<pg8::EpiPlain, pg8::StaticOrder, G_ALIGN, G_SP2>(F.lds + RING_OFF, g, So, E, F.tid);
#endif
        }
        SEAM(pb + 7);
        if (IN(pb + 8)) {
            CArgs* ap = fresh_args(); unsigned char* ws = ap->ws; Frame F = make_frame(L, wave_s);
            norm_pass(F, nullptr, WSP(WS_X16), WSP(WS_Y), ap->in[11] + (size_t)l * DM, WSP(WS_X16), nullptr, nullptr, nullptr);
            if (JIT_CONV) CONVERT(l, CO_PIN, CI_LAYER);
        }
        SEAM(pb + 8);
        if (IN(pb + 9)) {
            CArgs* ap = fresh_args(); unsigned char* ws = ap->ws; Frame F = make_frame(L, wave_s); unsigned char* wl = ws + WS_W + (size_t)l * LW_BYTES;
            pg8::Gemm g{WSP(WS_X16), (const bf16_t*)(wl + LW_PG), S, DM, DM, DM, DM, 0}; pg8::StaticOrder So; So.init(S, DM, F.G, F.bx);
            pg8::EpiPle E{WSP(WS_Y), WSP(WS_E) + (size_t)l * S * DM, DM, YP};
            if (JIT_CONV) {
                pg8::Gemm g2{WSP(WS_PB) + (size_t)l * S * DPLE, (const bf16_t*)(wl + LW_PIN), S, DM, DPLE, DPLE, DPLE, 0};
                pg8::EpiPlain E2{WSP(WS_E) + (size_t)l * S * DM, DM};
                pg8::gemm_phase<pg8::EpiPlain, pg8::StaticOrder, G_ALIGN, G_SP2>(F.lds + RING_OFF, g2, So, E2, F.tid);
            }
            for (int rep = 0; rep < REP_SMALLG; ++rep)
            pg8::gemm_phase<pg8::EpiPle, pg8::StaticOrder, G_ALIGN, G_SP2>(F.lds + RING_OFF, g, So, E, F.tid);
        }
        SEAM(pb + 9);
        if (IN(pb + 10)) {
            CArgs* ap = fresh_args(); unsigned char* ws = ap->ws; Frame F = make_frame(L, wave_s);
            if (l + 1 < DEPTH) norm_pass(F, nullptr, WSP(WS_X16), WSP(WS_Y), ap->in[17] + (size_t)l * DM, WSP(WS_X16), nullptr, ap->in[8] + (size_t)(l + 1) * DM, WSP(WS_H));
            else norm_pass(F, nullptr, WSP(WS_X16), WSP(WS_Y), ap->in[17] + (size_t)l * DM, nullptr, ap->out, nullptr, nullptr);
            if (JIT_CONV && l + 1 < DEPTH) CONVERT(l + 1, 0, CI_IN);
        }
        SEAM(pb + 10);
    }
#if SKEW_PROBE
    { unsigned* acc = (unsigned*)(args.ws + WS_CTL) + 64;
      unsigned m_ = ~0u; const bool t0 = (wave_s == 0 && __builtin_amdgcn_mbcnt_hi(m_, __builtin_amdgcn_mbcnt_lo(m_, 0u)) == 0u);
      if (t0) atomicAdd(acc, (unsigned)(wait_ticks / 16));
      xcd_barrier(bar, wave_s);
      if (t0 && blockIdx.x == 0) { const unsigned tot = __hip_atomic_load(acc, __ATOMIC_RELAXED, __HIP_MEMORY_SCOPE_AGENT); args.out[0] += (float)tot * 16.f / 100.f / (float)gridDim.x; } }
#endif
#undef IN
#undef SEAM
#undef GRID_BAR
}

extern "C" void kernel_launch(void* const* d_in, const int* in_sizes, int n_in, void* d_out, int out_size, void* d_ws, size_t ws_size, hipStream_t stream) {
    static int grid = 0;
    if (grid == 0) {
        if (n_in != 18 || in_sizes[0] != S * DM || out_size != S * DM || ws_size < WS_END) { fprintf(stderr, "kernel_launch: shape/workspace mismatch: n_in %d in0 %d out %d ws %zu (need %zu)\n", n_in, n_in > 0 ? in_sizes[0] : -1, out_size, ws_size, (size_t)WS_END); grid = -1; return; }
        int dev = 0, cus = 0, per_cu = 0;
        if (hipGetDevice(&dev) != hipSuccess || hipDeviceGetAttribute(&cus, hipDeviceAttributeMultiprocessorCount, dev) != hipSuccess) { grid = -1; return; }
        if (hipFuncSetAttribute((const void*)fwd_kernel, hipFuncAttributeMaxDynamicSharedMemorySize, LDS_BYTES) != hipSuccess) { fprintf(stderr, "kernel_launch: hipFuncSetAttribute failed\n"); grid = -1; return; }
        if (hipOccupancyMaxActiveBlocksPerMultiprocessor(&per_cu, (const void*)fwd_kernel, NWAVES * 64, LDS_BYTES) != hipSuccess || per_cu < 1) { fprintf(stderr, "kernel_launch: occupancy query says %d blocks per CU\n", per_cu); }
        (void)hipGetLastError();
        grid = cus;
    }
    if (grid < 0) return;
    if (hipMemsetAsync((char*)d_ws + WS_CTL, 0, CTL_ZERO_BYTES, stream) != hipSuccess) return;
    Args a{};
    for (int i = 0; i < 18; ++i) a.in[i] = (const float*)d_in[i];
    a.out = (float*)d_out; a.ws = (unsigned char*)d_ws;
    for (int li = 0; li < N_LAUNCHES; ++li) {
        a.ph_lo = (N_LAUNCHES == 1) ? 0 : li; a.ph_hi = (N_LAUNCHES == 1) ? N_PHASES : li + 1;
        hipLaunchKernelGGL(fwd_kernel, dim3(grid), dim3(NWAVES * 64), LDS_BYTES, stream, a);
        const hipError_t le = hipPeekAtLastError();
        if (le != hipSuccess) { fprintf(stderr, "kernel_launch: launch %d failed: %s\n", li, hipGetErrorName(le)); break; }
    }
}
```
